# Optimizing an MI355X kernel written in HIP

```python
import jax
import jax.numpy as jnp
from jax import lax
import numpy as np

D_MODEL = 1024
BATCH = 4
SEQ = 8192
DEPTH = 4

N_MIXERS = 4
NORM_EPS = 1e-6
ROPE_THETA = 10000.0
ROPE_DIM = 64
NEG_INF = -1e30
PLE_DIM = 256

MLA_HEADS = 8
MLA_Q_LORA = 384
MLA_KV_LORA = 256
MLA_NOPE = 128
MLA_V = 128
Q_BLOCK = 128

FNET_GROUPS = 4

GMLP_HALF = 2 * D_MODEL
GMLP_CHUNK = 128
GMLP_GROUP_DIM = 128
GMLP_GROUPS = GMLP_HALF // GMLP_GROUP_DIM

DIL_PATTERNS = ((128, 1), (512, 4), (2048, 16))
DIL_GROUPS = 3
DIL_HEADS = 8
DIL_HEAD_DIM = ROPE_DIM

MOE_GROUPS = 4
MOE_PER_GROUP = 8
MOE_EXPERTS = MOE_GROUPS * MOE_PER_GROUP
MOE_TOP_K = 2
MOE_HIDDEN = 512
MOE_BLOCK = 256

N_MLA = (DEPTH + 3) // 4
N_FNET = (DEPTH + 2) // 4
N_GMLP = (DEPTH + 1) // 4
N_DIL = DEPTH // 4

kernel_name = 'hybrid_mla_fnet_gmlp_dilated_hmoe'


def rmsnorm(x, g):
    xf = x.astype(jnp.float32)
    y = xf * lax.rsqrt(jnp.mean(xf * xf, axis=-1, keepdims=True) + NORM_EPS)
    return (y * g.astype(jnp.float32)).astype(x.dtype)


def rope_table(seq_len):
    inv = ROPE_THETA ** (-jnp.arange(0, ROPE_DIM, 2, dtype=jnp.float32) / ROPE_DIM)
    ang = jnp.arange(seq_len, dtype=jnp.float32)[:, None] * inv[None, :]
    return jnp.cos(ang), jnp.sin(ang)


def apply_rope(t, cos, sin):
    shp = (cos.shape[0],) + (1,) * (t.ndim - 3) + (cos.shape[1],)
    c, s = cos.reshape(shp), sin.reshape(shp)
    t1, t2 = jnp.split(t.astype(jnp.float32), 2, axis=-1)
    return jnp.concatenate([t1 * c - t2 * s, t2 * c + t1 * s], axis=-1).astype(t.dtype)


def mla_mixer(xn, cos, sin, w_a, norm_q, norm_kv, w_uq, w_ukv, w_o):
    B, S, _ = xn.shape
    a = xn @ w_a
    c_q, c_kv, k_rope = jnp.split(a, [MLA_Q_LORA, MLA_Q_LORA + MLA_KV_LORA], axis=-1)
    q = (rmsnorm(c_q, norm_q) @ w_uq).reshape(B, S, MLA_HEADS, MLA_NOPE + ROPE_DIM)
    q_nope, q_rope = q[..., :MLA_NOPE], apply_rope(q[..., MLA_NOPE:], cos, sin)
    kv = (rmsnorm(c_kv, norm_kv) @ w_ukv).reshape(B, S, MLA_HEADS, MLA_NOPE + MLA_V)
    k_nope, v = kv[..., :MLA_NOPE], kv[..., MLA_NOPE:]
    k_rope = apply_rope(k_rope, cos, sin)
    scale = (MLA_NOPE + ROPE_DIM) ** -0.5
    nq = S // Q_BLOCK
    qn_b = jnp.moveaxis(q_nope.reshape(B, nq, Q_BLOCK, MLA_HEADS, MLA_NOPE), 1, 0)
    qr_b = jnp.moveaxis(q_rope.reshape(B, nq, Q_BLOCK, MLA_HEADS, ROPE_DIM), 1, 0)

    def attend(blk):
        qn, qr = blk
        s = jnp.einsum('bqhd,bkhd->bhqk', qn, k_nope, preferred_element_type=jnp.float32)
        s = s + jnp.einsum('bqhr,bkr->bhqk', qr, k_rope, preferred_element_type=jnp.float32)
        pr = jax.nn.softmax(s * scale, axis=-1).astype(v.dtype)
        return jnp.einsum('bhqk,bkhd->bqhd', pr, v)

    o = lax.map(attend, (qn_b, qr_b))
    o = jnp.moveaxis(o, 0, 1).reshape(B, S, MLA_HEADS * MLA_V)
    return o @ w_o


def fnet_mixer(xn, w_o, b_o):
    B, S, D = xn.shape
    z = xn.astype(jnp.float32).reshape(B, S, FNET_GROUPS, D // FNET_GROUPS)
    f = jnp.fft.fft2(z, axes=(1, 3), norm='ortho').real
    return f.reshape(B, S, D).astype(xn.dtype) @ w_o + b_o


def gmlp_mixer(xn, w_in, norm_v, w_s, b_s, w_o):
    B, S, _ = xn.shape
    z = jax.nn.gelu(xn @ w_in)
    u, v = jnp.split(z, 2, axis=-1)
    v = rmsnorm(v, norm_v).reshape(B, S // GMLP_CHUNK, GMLP_CHUNK, GMLP_GROUPS, GMLP_GROUP_DIM)
    sv = jnp.einsum('gpq,bcqgd->bcpgd', w_s, v) + b_s.T[:, :, None]
    return (u * sv.reshape(B, S, GMLP_HALF)) @ w_o


def local_window_attention(q, k, v, n):
    Bp, L, H, Dh = q.shape
    nb = -(-L // n)
    Lp = nb * n
    qb = jnp.pad(q, ((0, 0), (0, Lp - L), (0, 0), (0, 0))).reshape(Bp, nb, n, H, Dh)

    def band(t):
        tp = jnp.pad(t, ((0, 0), (n, Lp - L + n), (0, 0), (0, 0))).reshape(Bp, nb + 2, n, H, Dh)
        return jnp.concatenate([tp[:, :nb], tp[:, 1:nb + 1], tp[:, 2:]], axis=2)

    kb, vb = band(k), band(v)
    qpos = jnp.arange(Lp).reshape(nb, n)
    kpos = (jnp.arange(nb)[:, None] - 1) * n + jnp.arange(3 * n)[None, :]
    diff = kpos[:, None, :] - qpos[:, :, None]
    valid = (jnp.abs(diff) <= n) & (kpos[:, None, :] >= 0) & (kpos[:, None, :] < L)
    s = jnp.einsum('bcqhd,bckhd->bchqk', qb, kb, preferred_element_type=jnp.float32) * Dh ** -0.5
    s = jnp.where(valid[None, :, None], s, NEG_INF)
    lse = jax.nn.logsumexp(s, axis=-1, keepdims=True)
    o = jnp.einsum('bchqk,bckhd->bcqhd', jnp.exp(s - lse).astype(v.dtype), vb)
    o = o.reshape(Bp, Lp, H, Dh)[:, :L]
    lse = jnp.transpose(lse[..., 0], (0, 1, 3, 2)).reshape(Bp, Lp, H)[:, :L]
    return o, lse


def dilated_group(q, k, v, window, dil):
    B, S, H, Dh = q.shape
    L = S // dil

    def to_cls(t):
        return jnp.transpose(t.reshape(B, L, dil, H, Dh), (0, 2, 1, 3, 4)).reshape(B * dil, L, H, Dh)

    o, lse = local_window_attention(to_cls(q), to_cls(k), to_cls(v), window // (2 * dil))
    o = jnp.transpose(o.reshape(B, dil, L, H, Dh), (0, 2, 1, 3, 4)).reshape(B, S, H, Dh)
    lse = jnp.transpose(lse.reshape(B, dil, L, H), (0, 2, 1, 3)).reshape(B, S, H)
    return o, lse


def dilated_mixer(xn, cos, sin, w_qkv, w_o):
    B, S, _ = xn.shape
    qkv = (xn @ w_qkv).reshape(B, S, DIL_GROUPS, 3, DIL_HEADS, DIL_HEAD_DIM)
    outs, lses = [], []
    for g in range(DIL_GROUPS):
        window, dil = DIL_PATTERNS[g]
        q = apply_rope(qkv[:, :, g, 0], cos, sin)
        k = apply_rope(qkv[:, :, g, 1], cos, sin)
        o, l = dilated_group(q, k, qkv[:, :, g, 2], window, dil)
        outs.append(o)
        lses.append(l)
    alpha = jax.nn.softmax(jnp.stack(lses, axis=0), axis=0)
    o = jnp.sum(alpha[..., None].astype(xn.dtype) * jnp.stack(outs, axis=0), axis=0)
    return o.reshape(B, S, DIL_HEADS * DIL_HEAD_DIM) @ w_o


def hier_moe(xn, w_grp, b_grp, w_exp, b_exp, w_gate, w_up, w_down):
    B, S, D = xn.shape
    N = B * S
    xf = xn.reshape(N, D)
    pg = jax.nn.softmax((xf @ w_grp).astype(jnp.float32) + b_grp.astype(jnp.float32), axis=-1)
    g = jnp.argmax(pg, axis=-1)
    g_gate = jnp.take_along_axis(pg, g[:, None], axis=1)[:, 0]
    le = ((xf @ w_exp).astype(jnp.float32) + b_exp.astype(jnp.float32)).reshape(N, MOE_GROUPS, MOE_PER_GROUP)
    le_g = jnp.take_along_axis(le, g[:, None, None], axis=1)[:, 0]
    top_v, top_i = lax.top_k(le_g, MOE_TOP_K)
    wts = (jax.nn.softmax(top_v, axis=-1) * g_gate[:, None]).reshape(-1)
    eid = (g[:, None] * MOE_PER_GROUP + top_i).reshape(-1).astype(jnp.int32)
    NK = N * MOE_TOP_K
    tok = jnp.arange(NK, dtype=jnp.int32) // MOE_TOP_K
    order = jnp.argsort(eid)
    se, stok, sw = eid[order], tok[order], wts[order]
    counts = jax.ops.segment_sum(jnp.ones((NK,), jnp.int32), eid, num_segments=MOE_EXPERTS)
    padded = ((counts + MOE_BLOCK - 1) // MOE_BLOCK) * MOE_BLOCK
    pad_end = jnp.cumsum(padded)
    pad_start = pad_end - padded
    start = jnp.cumsum(counts) - counts
    dest = pad_start[se] + (jnp.arange(NK, dtype=jnp.int32) - start[se])
    R = ((NK + MOE_EXPERTS * (MOE_BLOCK - 1) + MOE_BLOCK - 1) // MOE_BLOCK) * MOE_BLOCK
    nb = R // MOE_BLOCK
    row_tok = jnp.full((R,), N, jnp.int32).at[dest].set(stok)
    row_w = jnp.zeros((R,), jnp.float32).at[dest].set(sw)
    blk_e = jnp.minimum(jnp.searchsorted(pad_end, jnp.arange(nb) * MOE_BLOCK, side='right'), MOE_EXPERTS - 1)
    x_pad = jnp.concatenate([xf, jnp.zeros((1, D), xf.dtype)], axis=0)

    def run_block(args):
        t, e = args
        xb = x_pad[t]
        hb = jax.nn.silu(xb @ w_gate[e]) * (xb @ w_up[e])
        return hb @ w_down[e]

    y = lax.map(run_block, (row_tok.reshape(nb, MOE_BLOCK), blk_e)).reshape(R, D)
    y = y * row_w[:, None].astype(y.dtype)
    out = jnp.zeros((N + 1, D), y.dtype).at[row_tok].add(y)[:N]
    return out.reshape(B, S, D)


def _dense(key, shape, fan_in):
    return jax.random.normal(key, shape, jnp.float32) * fan_in ** -0.5


def _gain(key, shape):
    return 1.0 + 0.02 * jax.random.normal(key, shape, jnp.float32)


def _small(key, shape):
    return 0.01 * jax.random.normal(key, shape, jnp.float32)


def setup_inputs(seed: int = 0) -> dict:
    key = jax.random.key(seed)
    ks = jax.random.split(key, 36)
    D = D_MODEL
    return {
        'x': jax.random.normal(ks[0], (BATCH, SEQ, D), jnp.float32),
        'p': jax.random.normal(ks[1], (DEPTH, BATCH, SEQ, PLE_DIM), jnp.float32),
        'norm_mix': _gain(ks[2], (DEPTH, D)),
        'norm_moe': _gain(ks[3], (DEPTH, D)),
        'mla_w_a': _dense(ks[4], (N_MLA, D, MLA_Q_LORA + MLA_KV_LORA + ROPE_DIM), D),
        'mla_norm_q': _gain(ks[5], (N_MLA, MLA_Q_LORA)),
        'mla_norm_kv': _gain(ks[6], (N_MLA, MLA_KV_LORA)),
        'mla_w_uq': _dense(ks[7], (N_MLA, MLA_Q_LORA, MLA_HEADS * (MLA_NOPE + ROPE_DIM)), MLA_Q_LORA),
        'mla_w_ukv': _dense(ks[8], (N_MLA, MLA_KV_LORA, MLA_HEADS * (MLA_NOPE + MLA_V)), MLA_KV_LORA),
        'mla_w_o': _dense(ks[9], (N_MLA, MLA_HEADS * MLA_V, D), MLA_HEADS * MLA_V),
        'fnet_w_o': _dense(ks[10], (N_FNET, D, D), D),
        'fnet_b_o': _small(ks[11], (N_FNET, D)),
        'gmlp_w_in': _dense(ks[12], (N_GMLP, D, 2 * GMLP_HALF), D),
        'gmlp_norm_v': _gain(ks[13], (N_GMLP, GMLP_HALF)),
        'gmlp_w_s': _dense(ks[14], (N_GMLP, GMLP_GROUPS, GMLP_CHUNK, GMLP_CHUNK), GMLP_CHUNK),
        'gmlp_b_s': _gain(ks[15], (N_GMLP, GMLP_GROUPS, GMLP_CHUNK)),
        'gmlp_w_o': _dense(ks[16], (N_GMLP, GMLP_HALF, D), GMLP_HALF),
        'dil_w_qkv': _dense(ks[17], (N_DIL, D, DIL_GROUPS * 3 * DIL_HEADS * DIL_HEAD_DIM), D),
        'dil_w_o': _dense(ks[18], (N_DIL, DIL_HEADS * DIL_HEAD_DIM, D), DIL_HEADS * DIL_HEAD_DIM),
        'moe_w_grp': _dense(ks[19], (DEPTH, D, MOE_GROUPS), D),
        'moe_b_grp': _small(ks[20], (DEPTH, MOE_GROUPS)),
        'moe_w_exp': _dense(ks[21], (DEPTH, D, MOE_EXPERTS), D),
        'moe_b_exp': _small(ks[22], (DEPTH, MOE_EXPERTS)),
        'moe_w_gate': _dense(ks[23], (DEPTH, MOE_EXPERTS, D, MOE_HIDDEN), D),
        'moe_w_up': _dense(ks[24], (DEPTH, MOE_EXPERTS, D, MOE_HIDDEN), D),
        'moe_w_down': _dense(ks[25], (DEPTH, MOE_EXPERTS, MOE_HIDDEN, D), MOE_HIDDEN),
        'ple_norm': _gain(ks[26], (DEPTH, D)),
        'ple_w_gate': _dense(ks[27], (DEPTH, D, D), D),
        'ple_w_proj': _dense(ks[28], (DEPTH, PLE_DIM, D), PLE_DIM),
        'norm_final': _gain(ks[29], (D,)),
    }


def reference(x, p, norm_mix, norm_moe, mla_w_a, mla_norm_q, mla_norm_kv, mla_w_uq, mla_w_ukv, mla_w_o,
              fnet_w_o, fnet_b_o, gmlp_w_in, gmlp_norm_v, gmlp_w_s, gmlp_b_s, gmlp_w_o, dil_w_qkv, dil_w_o,
              moe_w_grp, moe_b_grp, moe_w_exp, moe_b_exp, moe_w_gate, moe_w_up, moe_w_down,
              ple_norm, ple_w_gate, ple_w_proj, norm_final):
    S = x.shape[1]
    cos, sin = rope_table(S)
    h = x
    for i in range(DEPTH):
        m, j = i % N_MIXERS, i // N_MIXERS
        hn = rmsnorm(h, norm_mix[i])
        if m == 0:
            y = mla_mixer(hn, cos, sin, mla_w_a[j], mla_norm_q[j], mla_norm_kv[j], mla_w_uq[j], mla_w_ukv[j], mla_w_o[j])
        elif m == 1:
            y = fnet_mixer(hn, fnet_w_o[j], fnet_b_o[j])
        elif m == 2:
            y = gmlp_mixer(hn, gmlp_w_in[j], gmlp_norm_v[j], gmlp_w_s[j], gmlp_b_s[j], gmlp_w_o[j])
        else:
            y = dilated_mixer(hn, cos, sin, dil_w_qkv[j], dil_w_o[j])
        h = h + y
        h = h + hier_moe(rmsnorm(h, norm_moe[i]), moe_w_grp[i], moe_b_grp[i], moe_w_exp[i], moe_b_exp[i],
                         moe_w_gate[i], moe_w_up[i], moe_w_down[i])
        gate = jax.nn.sigmoid(rmsnorm(h, ple_norm[i]) @ ple_w_gate[i])
        h = h + gate * (p[i] @ ple_w_proj[i])
    return rmsnorm(h, norm_final)
```

```cpp
#include <hip/hip_runtime.h>
#include <cstdio>
#include <cstdint>

#define LAS __attribute__((address_space(3)))
#define GAS __attribute__((address_space(1)))
typedef unsigned short bf16;
typedef short bf16x8 __attribute__((ext_vector_type(8)));
typedef short s16x4 __attribute__((ext_vector_type(4)));
typedef float f32x2 __attribute__((ext_vector_type(2)));
typedef float f32x4 __attribute__((ext_vector_type(4)));
typedef float f32x16 __attribute__((ext_vector_type(16)));
typedef unsigned u32x2 __attribute__((ext_vector_type(2)));
typedef unsigned u32x4 __attribute__((ext_vector_type(4)));

constexpr int DM = 1024, BATCH = 4, SEQ = 8192, NTOK = BATCH * SEQ, DEPTH = 4;
constexpr float EPS = 1e-6f;
constexpr int NWAVES = 8, NTHR = 512;
constexpr int MOE_CAP = 32768;
constexpr int HB_ROWS = 65536 + 32 * 256;

constexpr size_t MiB = 1u << 20;
constexpr size_t WS_CTL = 0, CTL_ZERO_BYTES = 1 * MiB;
constexpr size_t WS_COS = 1 * MiB, WS_SIN = 2 * MiB;
constexpr size_t WS_WPERM = 3 * MiB;
constexpr size_t WS_SSQ = 4 * MiB;
constexpr size_t WS_LIST = 6 * MiB;
constexpr size_t WS_WSM = 14 * MiB;
constexpr size_t WA_T = WS_WSM + 0 * MiB, WUQ_T = WS_WSM + 2 * MiB, WUKV_T = WS_WSM + 4 * MiB, WOM_T = WS_WSM + 5 * MiB, FCH_T = WS_WSM + 7 * MiB, WOF_T = WS_WSM + 8 * MiB,
                 WIN_T = WS_WSM + 10 * MiB, WOG_T = WS_WSM + 18 * MiB, WQKV_T = WS_WSM + 22 * MiB, WOD_T = WS_WSM + 31 * MiB, WG_T = WS_WSM + 32 * MiB, WP_T = WS_WSM + 40 * MiB,
                 FW1_T = WS_WSM + 42 * MiB, FW2_T = WS_WSM + 43 * MiB, FTWC = WS_WSM + 44 * MiB, FTWS = WS_WSM + 45 * MiB;
constexpr size_t WS_MOEW1 = 64 * MiB, WS_MOEW2 = 128 * MiB;
constexpr size_t WS_H8 = 160 * MiB;
constexpr size_t WS_HB = 288 * MiB;
constexpr size_t WS_XN = 352 * MiB;
constexpr size_t WS_PP = 416 * MiB;
constexpr size_t WS_PB = 480 * MiB;
constexpr size_t WS_AR = 544 * MiB;
constexpr size_t WS_END = 1010 * MiB;
constexpr size_t AR_YB = WS_AR + 0 * MiB, AR_HBUF = WS_AR + 128 * MiB;
constexpr size_t AR_CQ = WS_AR + 0 * MiB, AR_CKV = WS_AR + 24 * MiB, AR_KR = WS_AR + 40 * MiB, AR_SSQQ = WS_AR + 44 * MiB, AR_SSQKV = WS_AR + 45 * MiB, AR_Q = WS_AR + 46 * MiB, AR_KN = WS_AR + 96 * MiB, AR_VT = WS_AR + 128 * MiB, AR_O = WS_AR + 160 * MiB;
constexpr size_t AR_TT = WS_AR + 0 * MiB, AR_Z = WS_AR + 128 * MiB, AR_F = WS_AR + 256 * MiB;
constexpr size_t AR_U = WS_AR + 0 * MiB, AR_V = WS_AR + 128 * MiB, AR_G = WS_AR + 256 * MiB, AR_SSQV = WS_AR + 384 * MiB;
constexpr size_t AR_QKV = WS_AR + 0 * MiB, AR_OD = WS_AR + 288 * MiB, AR_OG = WS_AR + 320 * MiB, AR_LSE = WS_AR + 416 * MiB;

constexpr int CW_TMO = 0;
constexpr int CW_BAR = 4096;
constexpr int CW_CNT = 8192;

constexpr int LDS_TAB = 131072;
constexpr int LDS_MISC = 131072 + 8192;
constexpr int LDS_PTRS = 131072 + 4096;
constexpr int LDS_BYTES = 147456;

#define LDS_WAIT() asm volatile("s_waitcnt lgkmcnt(0)" ::: "memory")
#define VM_WAIT() asm volatile("s_waitcnt vmcnt(0)" ::: "memory")
#define SBAR() __builtin_amdgcn_sched_barrier(0)
__device__ __forceinline__ unsigned cvt_pk_bf16(float lo, float hi) { unsigned r; asm volatile("v_cvt_pk_bf16_f32 %0, %1, %2" : "=v"(r) : "v"(lo), "v"(hi)); return r; }
constexpr float ATT8_SCALE = 4.f;
constexpr float K8_SCALE = 0.25f, Q8_SCALE = 0.07216878364870322f * 1.4426950408889634f / K8_SCALE;
constexpr float XN8_SCALE = 8.f, HB8_SCALE = 4.f, W8_SCALE = 64.f, G8_SCALE = 4.f, O8_SCALE = 32.f, FN8_SCALE = 16.f, OD8_SCALE = 32.f, YB8_SCALE = 32.f;
__device__ __forceinline__ unsigned pk_fp8x4(float a, float b, float c, float d) { unsigned w = __builtin_amdgcn_cvt_pk_fp8_f32(a, b, __float_as_uint(a), false); return __builtin_amdgcn_cvt_pk_fp8_f32(c, d, w, true); }
__device__ __forceinline__ float bf2f(unsigned short x) { return __uint_as_float(((unsigned)x) << 16); }
__device__ __forceinline__ float bflo(unsigned w) { return __uint_as_float(w << 16); }
__device__ __forceinline__ float bfhi(unsigned w) { return __uint_as_float(w & 0xffff0000u); }
__device__ __forceinline__ u32x2 pack4(f32x4 v) { u32x2 w; w.x = cvt_pk_bf16(v[0], v[1]); w.y = cvt_pk_bf16(v[2], v[3]); return w; }
__device__ __forceinline__ f32x4 unpack4(u32x2 w) { return (f32x4){bflo(w.x), bfhi(w.x), bflo(w.y), bfhi(w.y)}; }
__device__ __forceinline__ float sumsq4(f32x4 v) { return (v[0] * v[0] + v[1] * v[1]) + (v[2] * v[2] + v[3] * v[3]); }
__device__ __forceinline__ float wave_sum(float v) {
#pragma unroll
    for (int o = 1; o < 64; o <<= 1) v += __shfl_xor(v, o);
    return v;
}
__device__ __forceinline__ float fast_exp2(float x) { return __builtin_amdgcn_exp2f(x); }
__device__ __forceinline__ float fast_rcp(float x) { return __builtin_amdgcn_rcpf(x); }

#define XB_TMO      128
#define XB_XCNT(j)  (256  + 64 * (j))
#define XB_XSUB(j)  (1280 + 64 * (j))
#define XB_XGEN(j)  (2304 + 64 * (j))
#define XB_TOP      3328
#define XB_TOPGEN   3392
#define XCD_BAR_WORDS 3456
#define XB_SPIN_CAP (1u << 20)
__device__ __forceinline__ unsigned xb_ld(unsigned* p)              { return __hip_atomic_load(p, __ATOMIC_RELAXED, __HIP_MEMORY_SCOPE_AGENT); }
__device__ __forceinline__ unsigned xb_add(unsigned* p, unsigned v) { return __hip_atomic_fetch_add(p, v, __ATOMIC_RELAXED, __HIP_MEMORY_SCOPE_AGENT); }
__device__ __forceinline__ unsigned xb_xcc_id() { return (unsigned)__builtin_amdgcn_s_getreg((3 << 11) | 20) & 0xFu; }
#define XB_SPIN(cond, bar) do { unsigned _sp = 0; while (cond) { __builtin_amdgcn_s_sleep(1); \
    if ((++_sp & 255u) == 0u) { if (xb_ld(&(bar)[XB_TMO])) break; if (_sp > XB_SPIN_CAP) { atomicAdd(&(bar)[XB_TMO], 1u); break; } } } } while (0)
struct XcdBarrier { unsigned* bar; unsigned x; volatile LAS unsigned* st; };
__device__ __forceinline__ XcdBarrier xcd_barrier_post(unsigned* bar, volatile LAS unsigned* st) {
    XcdBarrier b; b.bar = bar; b.x = xb_xcc_id(); b.st = st;
    if (threadIdx.x == 0) (void)xb_add(&bar[XB_XCNT(b.x)], 1u);
    return b;
}
__device__ __forceinline__ void xcd_barrier_complete(unsigned* bar, unsigned x, unsigned& nloc, unsigned& nx) {
    const unsigned G = gridDim.x * gridDim.y * gridDim.z;
    unsigned sum, cnt, mine, sp = 0u;
    for (;;) {
        sum = 0u; cnt = 0u; mine = 0u;
#pragma unroll
        for (unsigned j = 0; j < 16; ++j) { const unsigned c = xb_ld(&bar[XB_XCNT(j)]); sum += c; cnt += (c > 0u) ? 1u : 0u; mine = (j == x) ? c : mine; }
        if (sum == G) break;
        __builtin_amdgcn_s_sleep(1);
        if ((++sp & 255u) == 0u) { if (xb_ld(&bar[XB_TMO])) break; if (sp > XB_SPIN_CAP) { atomicAdd(&bar[XB_TMO], 1u); break; } }
    }
    nloc = mine > 0u ? mine : 1u; nx = cnt > 0u ? cnt : 1u;
}
__device__ __forceinline__ void xcd_barrier(const XcdBarrier& b, const int tid) {
    asm volatile("s_waitcnt vmcnt(0)" ::: "memory");
    __syncthreads();
    if (tid == 0) {
        unsigned* bar = b.bar;
        __builtin_amdgcn_s_waitcnt(0);
        unsigned nloc = b.st[0], nx = b.st[1];
        if (nloc == 0u) { xcd_barrier_complete(bar, b.x, nloc, nx); b.st[0] = nloc; b.st[1] = nx; }
        const unsigned old = xb_add(&bar[XB_XSUB(b.x)], 1u);
        const unsigned gen = old / nloc;
        if (old + 1u == (gen + 1u) * nloc) {
            __builtin_amdgcn_fence(__ATOMIC_RELEASE, "agent");
            asm volatile("s_waitcnt vmcnt(0)" ::: "memory");
            const unsigned og = xb_add(&bar[XB_TOP], 1u);
            const unsigned tg = og / nx;
            if (og + 1u == (tg + 1u) * nx) xb_add(&bar[XB_TOPGEN], 1u);
            else XB_SPIN(xb_ld(&bar[XB_TOPGEN]) == tg, bar);
            __builtin_amdgcn_fence(__ATOMIC_ACQUIRE, "agent");
            xb_add(&bar[XB_XGEN(b.x)], 1u);
            asm volatile("s_waitcnt vmcnt(0)" ::: "memory");
        } else {
            XB_SPIN(xb_ld(&bar[XB_XGEN(b.x)]) == gen, bar);
            __builtin_amdgcn_fence(__ATOMIC_ACQUIRE, "agent");
            asm volatile("s_waitcnt vmcnt(0)" ::: "memory");
        }
    }
    __syncthreads();
}

namespace pg8 {
constexpr int BM = 256, BK = 64, HALF = 128, HTB = HALF * BK * 2, STAGE_BYTES = 8 * HTB, NXCD = 8, WGM = 8;
__host__ __device__ __forceinline__ int lds_byte(int r, int c) { const int st = (r >> 4) * 2 + (c >> 5), rr = r & 15, cc = c & 31, ob = rr * 64 + cc * 2; return st * 1024 + (ob ^ (((ob >> 9) & 1) << 5)); }
__host__ __device__ __forceinline__ void stage_rc(int b, int& R, int& C) { const int st = b / 1024, sb = b % 1024, swz = sb ^ (((sb >> 9) & 1) << 5); R = (st >> 1) * 16 + swz / 64; C = (st & 1) * 32 + (swz % 64) / 2; }

typedef int v8i32 __attribute__((ext_vector_type(8)));
__device__ __forceinline__ v8i32 cat8(bf16x8 lo, bf16x8 hi) { const u32x4 a = __builtin_bit_cast(u32x4, lo), b = __builtin_bit_cast(u32x4, hi); return (v8i32){(int)a.x, (int)a.y, (int)a.z, (int)a.w, (int)b.x, (int)b.y, (int)b.z, (int)b.w}; }
union Frag { v8i32 v; bf16x8 q[2]; };
struct Unit { const char* a; const char* b; int pm, pn, aux; };

struct TileOrder {
    int nM, nN, nb, G, c;
    __device__ __forceinline__ bool decode(int i, int& bt, int& pm, int& pn) const {
        const int per = nM * nN, total = per * nb; const long L = (long)i * G + c; if (L >= total) return false;
        int wgid = (int)L; { const int q = total / NXCD, r = total % NXCD, xcd = wgid % NXCD, off = wgid / NXCD; wgid = (xcd < r ? xcd * (q + 1) : r * (q + 1) + (xcd - r) * q) + off; }
        bt = wgid / per; const int rem = wgid % per;
        const int nig = WGM * nN, gid = rem / nig, fm = gid * WGM, gsz = (nM - fm) < WGM ? (nM - fm) : WGM;
        pm = fm + ((rem % nig) % gsz); pn = (rem % nig) / gsz; return true;
    }
};

#define PG8_SA(b, h) (((b) * 2 + (h)) * HTB)
#define PG8_SB(b, h) ((4 + (b) * 2 + (h)) * HTB)
#define PG8_WAIT_V(n) asm volatile("s_waitcnt vmcnt(" #n ")" ::: "memory")
#define PG8_WAIT_L(n) asm volatile("s_waitcnt lgkmcnt(" #n ")" ::: "memory")
#define PG8_BAR __builtin_amdgcn_s_barrier()
#define PG8_SCHED __builtin_amdgcn_sched_barrier(0)

template <class Epi, class Sched, bool ALIGN_EPI, bool FP8 = false>
__device__ __forceinline__ void gemm_phase(LAS unsigned char* lds, const int tid, const Sched& S, const Epi& E) {
    const int wid = __builtin_amdgcn_readfirstlane(tid >> 6), lane = tid & 63, wr = wid >> 2, wc = wid & 3, fr = lane & 15, fq = lane >> 4;
    const int K = S.K, nt = K / (FP8 ? 2 * BK : BK);
    int Rs[2], Cs[2]; unsigned voffB[2];
#pragma unroll
    for (int i = 0; i < 2; ++i) { stage_rc(tid * 16 + i * 8192, Rs[i], Cs[i]); voffB[i] = S.boff(Rs[i], Cs[i]); }
    const size_t kstep = (size_t)(BK * 2);
    const size_t hstepB = S.hstepB();
    const unsigned ldsw = (unsigned)wid * 1024u;
    const int aoff = lds_byte(wr * 64 + fr, fq * 8), boff = lds_byte(wc * 32 + fr, fq * 8);
#define PG8_STAGE_B(bufoff, gbase) do { _Pragma("unroll") for (int _i = 0; _i < 2; ++_i) \
        __builtin_amdgcn_global_load_lds((const unsigned*)((const char*)(gbase) + voffB[_i]), (LAS unsigned*)(lds + (bufoff) + ldsw + _i * 8192), 16, 0, 0); } while (0)
#define PG8_STAGE_A(bufoff, gbase, vo) do { _Pragma("unroll") for (int _i = 0; _i < 2; ++_i) \
        __builtin_amdgcn_global_load_lds((const unsigned*)((const char*)(gbase) + (vo)[_i]), (LAS unsigned*)(lds + (bufoff) + ldsw + _i * 8192), 16, 0, 0); } while (0)
#define PG8_LDA(dst, b, h) do { _Pragma("unroll") for (int m = 0; m < 4; ++m) _Pragma("unroll") for (int k = 0; k < 2; ++k) dst[m].q[k] = *(const LAS bf16x8*)(lds + PG8_SA(b, h) + aoff + m * 2048 + k * 1024); } while (0)
#define PG8_LDB(dst, b, h) do { _Pragma("unroll") for (int n = 0; n < 2; ++n) _Pragma("unroll") for (int k = 0; k < 2; ++k) dst[n].q[k] = *(const LAS bf16x8*)(lds + PG8_SB(b, h) + boff + n * 2048 + k * 1024); } while (0)
#define PG8_MMA(ai, bj, At, Bt) do { __builtin_amdgcn_s_setprio(1); if constexpr (FP8) { _Pragma("unroll") for (int m = 0; m < 4; ++m) _Pragma("unroll") for (int n = 0; n < 2; ++n) \
        asm volatile("v_mfma_f32_16x16x128_f8f6f4 %0, %1, %2, %0" : "+v"(acc[ai][bj][m][n]) : "v"(Bt[n].v), "v"(At[m].v)); }     \
        else { _Pragma("unroll") for (int m = 0; m < 4; ++m) _Pragma("unroll") for (int n = 0; n < 2; ++n) _Pragma("unroll") for (int k = 0; k < 2; ++k) \
        acc[ai][bj][m][n] = __builtin_amdgcn_mfma_f32_16x16x32_bf16(Bt[n].q[k], At[m].q[k], acc[ai][bj][m][n], 0, 0, 0); } if constexpr (FP8) asm volatile("s_nop 11"); __builtin_amdgcn_s_setprio(0); } while (0)
    Unit cur, nxt; int ui = 0;
    if (!S.next(0, cur)) return;
    unsigned cv0[2], cv1[2], nv0[2], nv1[2];
#pragma unroll
    for (int i = 0; i < 2; ++i) { cv0[i] = S.aoff(cur, 0, Rs[i], Cs[i]); cv1[i] = S.aoff(cur, 1, Rs[i], Cs[i]); nv0[i] = cv0[i]; nv1[i] = cv1[i]; }
    f32x4 acc[2][2][4][2];
#pragma unroll
    for (int a = 0; a < 2; ++a)
#pragma unroll
        for (int b = 0; b < 2; ++b)
#pragma unroll
            for (int m = 0; m < 4; ++m)
#pragma unroll
                for (int n = 0; n < 2; ++n) acc[a][b][m][n] = (f32x4){0.f, 0.f, 0.f, 0.f};
    Frag At[4], B0[2], B1[2];
    const char* cA = cur.a; const char* cB = cur.b;
    PG8_STAGE_B(PG8_SB(0, 0), cB); PG8_STAGE_B(PG8_SB(0, 1), cB + hstepB); PG8_STAGE_A(PG8_SA(0, 0), cA, cv0); PG8_STAGE_A(PG8_SA(0, 1), cA, cv1);
    if (wr == 1) PG8_BAR;
    PG8_WAIT_V(2); PG8_BAR;
    PG8_STAGE_B(PG8_SB(1, 0), cB + kstep); PG8_STAGE_A(PG8_SA(1, 0), cA + kstep, cv0); PG8_STAGE_B(PG8_SB(1, 1), cB + hstepB + kstep);
    PG8_WAIT_V(6); PG8_BAR;
    for (;;) {
        const bool has_next = S.next(ui + 1, nxt);
        const char* nA = has_next ? nxt.a : cA; const char* nB = has_next ? nxt.b : cB;
        if (has_next) {
#pragma unroll
            for (int i = 0; i < 2; ++i) { nv0[i] = S.aoff(nxt, 0, Rs[i], Cs[i]); nv1[i] = S.aoff(nxt, 1, Rs[i], Cs[i]); }
        } else {
#pragma unroll
            for (int i = 0; i < 2; ++i) { nv0[i] = cv0[i]; nv1[i] = cv1[i]; }
        }
        for (int t = 0; t < nt; t += 2) {
            const bool last = (t == nt - 2);
            const char* a1 = cA + (size_t)(t + 1) * kstep;
            const char* a2 = last ? nA : cA + (size_t)(t + 2) * kstep; const char* b2 = last ? nB : cB + (size_t)(t + 2) * kstep;
            const char* a3 = a2 + kstep; const char* b3 = b2 + kstep;
            unsigned x0[2], x1[2];
#pragma unroll
            for (int i = 0; i < 2; ++i) { x0[i] = last ? nv0[i] : cv0[i]; x1[i] = last ? nv1[i] : cv1[i]; }
            PG8_LDB(B0, 0, 0); PG8_LDB(B1, 0, 1); PG8_SCHED; PG8_LDA(At, 0, 0); PG8_STAGE_A(PG8_SA(1, 1), a1, cv1);
            PG8_WAIT_V(8); PG8_WAIT_L(0); PG8_BAR; PG8_MMA(0, 0, At, B0); PG8_MMA(0, 1, At, B1); PG8_BAR; PG8_SCHED;
            PG8_LDA(At, 0, 1); PG8_STAGE_B(PG8_SB(0, 0), b2); PG8_STAGE_B(PG8_SB(0, 1), b2 + hstepB); PG8_STAGE_A(PG8_SA(0, 0), a2, x0);
            PG8_WAIT_V(8); PG8_WAIT_L(0); PG8_BAR; PG8_MMA(1, 0, At, B0); PG8_MMA(1, 1, At, B1); PG8_BAR; PG8_SCHED;
            PG8_LDB(B0, 1, 0); PG8_LDB(B1, 1, 1); PG8_SCHED; PG8_LDA(At, 1, 0); PG8_STAGE_A(PG8_SA(0, 1), a2, x1);
            PG8_WAIT_V(8); PG8_WAIT_L(0); PG8_BAR; PG8_MMA(0, 0, At, B0); PG8_MMA(0, 1, At, B1); PG8_BAR; PG8_SCHED;
            PG8_LDA(At, 1, 1); PG8_STAGE_B(PG8_SB(1, 0), b3); PG8_STAGE_B(PG8_SB(1, 1), b3 + hstepB); PG8_STAGE_A(PG8_SA(1, 0), a3, x0);
            PG8_WAIT_V(8); PG8_WAIT_L(0); PG8_BAR; PG8_MMA(1, 0, At, B0); PG8_MMA(1, 1, At, B1); PG8_BAR; PG8_SCHED;
        }
        if constexpr (ALIGN_EPI) { if (wr == 0) PG8_BAR; }
        E(acc, cur, wr, wc, fr, fq);
        if (!has_next) break;
#pragma unroll
        for (int a = 0; a < 2; ++a)
#pragma unroll
            for (int b = 0; b < 2; ++b)
#pragma unroll
                for (int m = 0; m < 4; ++m)
#pragma unroll
                    for (int n = 0; n < 2; ++n) acc[a][b][m][n] = (f32x4){0.f, 0.f, 0.f, 0.f};
        cur = nxt; cA = nA; cB = nB; ++ui;
#pragma unroll
        for (int i = 0; i < 2; ++i) { cv0[i] = nv0[i]; cv1[i] = nv1[i]; }
        if constexpr (ALIGN_EPI) { if (wr == 1) PG8_BAR; }
    }
    PG8_WAIT_V(0);
    if constexpr (!ALIGN_EPI) { if (wr == 0) PG8_BAR; }
    PG8_BAR;
#undef PG8_STAGE_A
#undef PG8_STAGE_B
#undef PG8_LDA
#undef PG8_LDB
#undef PG8_MMA
}

struct DenseSched {
    const bf16* A; const bf16* Bt; int K, lda, ldb; TileOrder T; size_t a_bstride, b_bstride;
    __device__ __forceinline__ bool next(int i, Unit& u) const {
        int bt, pm, pn; if (!T.decode(i, bt, pm, pn)) return false;
        u.pm = pm; u.pn = pn; u.aux = bt;
        u.a = (const char*)(A + (size_t)bt * a_bstride + (size_t)pm * BM * lda); u.b = (const char*)(Bt + (size_t)bt * b_bstride + (size_t)pn * BM * ldb); return true;
    }
    __device__ __forceinline__ unsigned aoff(const Unit&, int half, int R, int C) const { return (unsigned)((R + HALF * half) * lda + C) * 2u; }
    __device__ __forceinline__ unsigned boff(int R, int C) const { return (unsigned)(R * ldb + C) * 2u; }
    __device__ __forceinline__ size_t hstepB() const { return (size_t)HALF * ldb * 2; }
};
struct DenseSched8 {
    const unsigned char* A; const unsigned char* Bt; int K, lda, ldb; TileOrder T;
    __device__ __forceinline__ bool next(int i, Unit& u) const {
        int bt, pm, pn; if (!T.decode(i, bt, pm, pn)) return false;
        u.pm = pm; u.pn = pn; u.aux = bt; u.a = (const char*)(A + (size_t)pm * BM * lda); u.b = (const char*)(Bt + (size_t)pn * BM * ldb); return true;
    }
    __device__ __forceinline__ unsigned aoff(const Unit&, int half, int R, int C) const { return (unsigned)((R + HALF * half) * lda + 2 * C); }
    __device__ __forceinline__ unsigned boff(int R, int C) const { return (unsigned)(R * ldb + 2 * C); }
    __device__ __forceinline__ size_t hstepB() const { return (size_t)HALF * ldb; }
};
}

#define EPI_LOOP_BEGIN _Pragma("unroll") for (int ai = 0; ai < 2; ++ai) _Pragma("unroll") for (int m = 0; m < 4; ++m) { const int rowt = ai * 128 + wr * 64 + m * 16 + fr;
#define EPI_LOOP_END }

struct Args {
    const float* in[30];
    float* out; unsigned char* ws; int ph_lo, ph_hi;
};
enum { I_X = 0, I_P, I_NORM_MIX, I_NORM_MOE, I_MLA_WA, I_MLA_NQ, I_MLA_NKV, I_MLA_WUQ, I_MLA_WUKV, I_MLA_WO, I_FN_WO, I_FN_BO, I_GM_WIN, I_GM_NV, I_GM_WS, I_GM_BS, I_GM_WO,
       I_DL_WQKV, I_DL_WO, I_MOE_WGRP, I_MOE_BGRP, I_MOE_WEXP, I_MOE_BEXP, I_MOE_WGATE, I_MOE_WUP, I_MOE_WDOWN, I_PLE_NORM, I_PLE_WGATE, I_PLE_WPROJ, I_NORM_FINAL };

struct Ctx {
    LAS unsigned char* lds; unsigned char* ws; float* out;
    int tid, lane, wave, G, bx;
    struct InTab { LAS unsigned char* lds;
        __device__ __forceinline__ const float* operator[](int i) const {
            const u32x2 w = *(const LAS u32x2*)(lds + LDS_PTRS + 8 * i);
            const unsigned long long p = ((unsigned long long)(unsigned)__builtin_amdgcn_readfirstlane((int)w.y) << 32) | (unsigned)__builtin_amdgcn_readfirstlane((int)w.x);
            return (const float*)p; } } in;
};

__device__ __forceinline__ int rope_phys(int l) { return (((l & 31) >> 4) << 5) + ((l >> 5) << 4) + (l & 15); }
__device__ __forceinline__ int tr_map(int mode, int n) {
    switch (mode) {
        case 1: return n < 640 ? n : 640 + rope_phys(n - 640);
        case 2: { const int h = n / 192, r = n % 192; return h * 192 + (r < 128 ? r : 128 + rope_phys(r - 128)); }
        case 3: { const int blk = n >> 6, l = n & 63, t = (blk >> 3) % 3; return t < 2 ? (blk << 6) + rope_phys(l) : n; }
        case 4: case 5: { const int pn = n >> 7, wc = (n >> 5) & 3, fq = (n >> 3) & 3, bj = (n >> 2) & 1, i = n & 3; return 256 * pn + 128 * bj + 32 * wc + 16 * (mode - 4) + 4 * fq + i; }
        default: return n;
    }
}
__device__ __forceinline__ void transpose_item(const float* W, int K, int N, bf16* WT, int ldt, const float* gain, int mode, LAS float* scr, int item, int lane) {
    const int nblk = N / 64, kb = item / nblk, nb = item % nblk, k0 = 64 * kb, n0 = 64 * nb;
    const int lr = lane >> 4, lc = (lane & 15) * 4;
    f32x4 v[16];
#pragma unroll
    for (int i = 0; i < 16; ++i) v[i] = *(const f32x4*)(W + (size_t)(k0 + 4 * i + lr) * N + n0 + lc);
    if (gain) {
#pragma unroll
        for (int i = 0; i < 16; ++i) v[i] *= gain[k0 + 4 * i + lr];
    }
#pragma unroll
    for (int i = 0; i < 16; ++i) { LAS float* p = scr + (4 * i + lr) * 65 + lc; p[0] = v[i][0]; p[1] = v[i][1]; p[2] = v[i][2]; p[3] = v[i][3]; }
    LDS_WAIT(); asm volatile("" ::: "memory");
    const int c = lane & 7;
#pragma unroll
    for (int j = 0; j < 8; ++j) { const int n = (lane >> 3) + 8 * j; const LAS float* s = scr + (8 * c) * 65 + n;
        u32x4 o; o.x = cvt_pk_bf16(s[0 * 65], s[1 * 65]); o.y = cvt_pk_bf16(s[2 * 65], s[3 * 65]); o.z = cvt_pk_bf16(s[4 * 65], s[5 * 65]); o.w = cvt_pk_bf16(s[6 * 65], s[7 * 65]);
        *(u32x4*)(WT + (size_t)tr_map(mode, n0 + n) * ldt + k0 + 8 * c) = o; }
    LDS_WAIT(); asm volatile("" ::: "memory");
}
__device__ __forceinline__ void transpose_item8(const float* W, int K, int N, unsigned char* WT, int ldt, float scale, int mode, LAS float* scr, int item, int lane, const float* gain = nullptr) {
    const int nblk = N / 64, kb = item / nblk, nb = item % nblk, k0 = 64 * kb, n0 = 64 * nb;
    const int lr = lane >> 4, lc = (lane & 15) * 4;
    f32x4 v[16];
#pragma unroll
    for (int i = 0; i < 16; ++i) v[i] = *(const f32x4*)(W + (size_t)(k0 + 4 * i + lr) * N + n0 + lc);
#pragma unroll
    for (int i = 0; i < 16; ++i) { LAS float* p = scr + (4 * i + lr) * 65 + lc; const float sg = gain ? scale * gain[k0 + 4 * i + lr] : scale; p[0] = v[i][0] * sg; p[1] = v[i][1] * sg; p[2] = v[i][2] * sg; p[3] = v[i][3] * sg; }
    LDS_WAIT(); asm volatile("" ::: "memory");
    const int c = lane & 3;
#pragma unroll
    for (int j = 0; j < 4; ++j) { const int n = (lane >> 2) + 16 * j; const LAS float* s = scr + (16 * c) * 65 + n;
        u32x4 o; o.x = pk_fp8x4(s[0 * 65], s[1 * 65], s[2 * 65], s[3 * 65]); o.y = pk_fp8x4(s[4 * 65], s[5 * 65], s[6 * 65], s[7 * 65]);
        o.z = pk_fp8x4(s[8 * 65], s[9 * 65], s[10 * 65], s[11 * 65]); o.w = pk_fp8x4(s[12 * 65], s[13 * 65], s[14 * 65], s[15 * 65]);
        *(u32x4*)(WT + (size_t)tr_map(mode, n0 + n) * ldt + k0 + 16 * c) = o; }
    LDS_WAIT(); asm volatile("" ::: "memory");
}
__device__ __forceinline__ void transpose_matrix(const Ctx& C, const float* W, int K, int N, bf16* WT, int ldt, const float* gain, int mode) {
    LAS float* scr = (LAS float*)(C.lds + C.wave * 16896);
    const int gw = C.bx * NWAVES + C.wave, NGW = C.G * NWAVES, nitems = (K / 64) * (N / 64);
    for (int it = gw; it < nitems; it += NGW) transpose_item(W, K, N, WT, ldt, gain, mode, scr, it, C.lane);
}
__device__ __forceinline__ void moe_weight_prep(const Ctx& C, int layer, int it_lo = 0, int it_hi = 1 << 30, int gwo = -1, int ngwo = 0) {
    LAS float* scr = (LAS float*)(C.lds + C.wave * 16896);
    const int gw = C.bx * NWAVES + C.wave, NGW = C.G * NWAVES;
    const float* wg = C.in[I_MOE_WGATE] + (size_t)layer * 32 * 1024 * 512; const float* wu = C.in[I_MOE_WUP] + (size_t)layer * 32 * 1024 * 512; const float* wd = C.in[I_MOE_WDOWN] + (size_t)layer * 32 * 512 * 1024;
    unsigned char* w1 = C.ws + WS_MOEW1; unsigned char* w2 = C.ws + WS_MOEW2;
    constexpr int IT1 = (1024 / 64) * (512 / 64), IT2 = (512 / 64) * (1024 / 64);
    const int total = 32 * (2 * IT1 + IT2), hi_ = it_hi < total ? it_hi : total;
    for (int it = it_lo + (gwo >= 0 ? gwo : gw); it < hi_; it += (gwo >= 0 ? ngwo : NGW)) {
        const int e = it / (2 * IT1 + IT2); int r = it % (2 * IT1 + IT2);
        if (r < IT1) { transpose_item8(wg + (size_t)e * 1024 * 512, 1024, 512, w1 + (size_t)e * 1024 * 1024, 1024, 64.f, 4, scr, r, C.lane); continue; } r -= IT1;
        if (r < IT1) { transpose_item8(wu + (size_t)e * 1024 * 512, 1024, 512, w1 + (size_t)e * 1024 * 1024, 1024, 64.f, 5, scr, r, C.lane); continue; } r -= IT1;
        transpose_item8(wd + (size_t)e * 512 * 1024, 512, 1024, w2 + (size_t)e * 1024 * 512, 512, 64.f, 0, scr, r, C.lane);
    }
}

__device__ __forceinline__ void prologue(const Ctx& C) {
    const int gw = C.bx * NWAVES + C.wave, NGW = C.G * NWAVES, gt = C.bx * NTHR + C.tid, NGT = C.G * NTHR;
    unsigned char* ws = C.ws;
    for (int i = gt; i < 64 * 1024 / 8; i += NGT) ((u32x4*)(ws + WA_T + (size_t)704 * 1024 * 2))[i] = (u32x4){0u, 0u, 0u, 0u};
    {
        LAS float* scr = (LAS float*)(C.lds + C.wave * 16896);
        constexpr int N_WA = 16 * 11, N_UQ = 6 * 24, N_UKV = 4 * 32, N_SQ = 16 * 16, N_WIN = 16 * 64, N_GWO = 32 * 16, N_QKV = 16 * 72, N_DWO = 8 * 16, N_PP = 4 * 16;
        constexpr int TOTAL = N_WA + N_UQ + N_UKV + 2 * N_SQ + N_WIN + N_GWO + N_QKV + N_DWO + DEPTH * (N_SQ + N_PP);
        for (int it = gw; it < TOTAL; it += NGW) {
            int r = it;
            if (r < N_WA)  { transpose_item(C.in[I_MLA_WA], 1024, 704, (bf16*)(ws + WA_T), 1024, C.in[I_NORM_MIX] + 0 * 1024, 1, scr, r, C.lane); continue; } r -= N_WA;
            if (r < N_UQ)  { transpose_item(C.in[I_MLA_WUQ], 384, 1536, (bf16*)(ws + WUQ_T), 384, C.in[I_MLA_NQ], 2, scr, r, C.lane); continue; } r -= N_UQ;
            if (r < N_UKV) { transpose_item(C.in[I_MLA_WUKV], 256, 2048, (bf16*)(ws + WUKV_T), 256, C.in[I_MLA_NKV], 0, scr, r, C.lane); continue; } r -= N_UKV;
            if (r < N_SQ)  { transpose_item8(C.in[I_MLA_WO], 1024, 1024, ws + WOM_T, 1024, 64.f, 0, scr, r, C.lane); continue; } r -= N_SQ;
            if (r < N_SQ)  { transpose_item8(C.in[I_FN_WO], 1024, 1024, ws + WOF_T, 1024, 64.f, 0, scr, r, C.lane); continue; } r -= N_SQ;
            if (r < N_WIN) { transpose_item8(C.in[I_GM_WIN], 1024, 4096, ws + WIN_T, 1024, 64.f, 0, scr, r, C.lane, C.in[I_NORM_MIX] + 2 * 1024); continue; } r -= N_WIN;
            if (r < N_GWO) { transpose_item8(C.in[I_GM_WO], 2048, 1024, ws + WOG_T, 2048, 64.f, 0, scr, r, C.lane); continue; } r -= N_GWO;
            if (r < N_QKV) { transpose_item8(C.in[I_DL_WQKV], 1024, 4608, ws + WQKV_T, 1024, 64.f, 3, scr, r, C.lane, C.in[I_NORM_MIX] + 3 * 1024); continue; } r -= N_QKV;
            if (r < N_DWO) { transpose_item8(C.in[I_DL_WO], 512, 1024, ws + WOD_T, 512, 64.f, 0, scr, r, C.lane); continue; } r -= N_DWO;
            const int l = r / (N_SQ + N_PP); r -= l * (N_SQ + N_PP);
            if (r < N_SQ)  { transpose_item8(C.in[I_PLE_WGATE] + (size_t)l * 1024 * 1024, 1024, 1024, ws + WG_T + (size_t)l * 1024 * 1024, 1024, 64.f, 0, scr, r, C.lane); continue; } r -= N_SQ;
            transpose_item(C.in[I_PLE_WPROJ] + (size_t)l * 256 * 1024, 256, 1024, (bf16*)(ws + WP_T) + (size_t)l * 1024 * 256, 256, nullptr, 0, scr, r, C.lane);
        }
    }
    {
        const float* gain = C.in[I_NORM_MIX] + 1 * 1024; bf16* F = (bf16*)(ws + FCH_T);
        for (int i = gt; i < 4 * 512 * 256 / 2; i += NGT) {
            const int e = i * 2, k = e & 255, f = (e >> 8) & 511, g = e >> 17;
            float v[2];
#pragma unroll
            for (int j = 0; j < 2; ++j) { const int kk = k + j, ff = f & 255; const float x = (float)((ff * kk) & 255) * (1.0f / 256.0f);
                const float t = f < 256 ? __builtin_amdgcn_cosf(x) : -__builtin_amdgcn_sinf(x); v[j] = t * gain[g * 256 + kk]; }
            ((unsigned*)F)[i] = cvt_pk_bf16(v[0], v[1]);
        }
    }
    {
        bf16* W1 = (bf16*)(ws + FW1_T); bf16* W2 = (bf16*)(ws + FW2_T); float* twc = (float*)(ws + FTWC); float* tws = (float*)(ws + FTWS);
        for (int i = gt; i < 256 * 256; i += NGT) { const int col = i & 255, row = i >> 8, p = col >> 7, s1 = col & 127, pp = row >> 7, k1 = row & 127;
            const float x = (float)((s1 * k1) & 127) * (1.0f / 128.0f); const float cv = __builtin_amdgcn_cosf(x), sv = __builtin_amdgcn_sinf(x);
            const float v = (pp == p) ? cv : (pp == 0 ? sv : -sv); W1[i] = (bf16)(cvt_pk_bf16(v, 0.f) & 0xffffu); }
        for (int i = gt; i < 256 * 128; i += NGT) { const int col = i & 127, row = i >> 7, p = col >> 6, s2 = col & 63;
            float v = 0.f; if (row < 64) { const float x = (float)((s2 * row) & 63) * (1.0f / 64.0f); v = p == 0 ? __builtin_amdgcn_cosf(x) : __builtin_amdgcn_sinf(x); }
            W2[i] = (bf16)(cvt_pk_bf16(v, 0.f) & 0xffffu); }
        for (int i = gt; i < 128 * 64; i += NGT) { const int s2 = i & 63, k1 = i >> 6; const float x = (float)(s2 * k1) * (1.0f / 8192.0f); twc[i] = __builtin_amdgcn_cosf(x); tws[i] = __builtin_amdgcn_sinf(x); }
    }
    {
        float* ct = (float*)(ws + WS_COS); float* st = (float*)(ws + WS_SIN);
        for (int i = gt; i < SEQ * 32; i += NGT) { const int s = i >> 5, j = i & 31; const float inv = exp2f(-13.287712379549449f * ((float)(2 * j) / 64.0f)); const float ang = (float)s * inv;
            const double rv = (double)ang * 0.15915494309189535; const float fr = (float)(rv - floor(rv));
            ct[i] = __builtin_amdgcn_cosf(fr); st[i] = __builtin_amdgcn_sinf(fr); }
    }
    {
        u32x4* wp = (u32x4*)(ws + WS_WPERM);
        for (int i = gt; i < DEPTH * 32 * 64 * 6; i += NGT) {
            const int q = i % 6, l = (i / 6) & 63, st = (i / (6 * 64)) & 31, layer = i / (6 * 64 * 32);
            const int nb = q >> 1, part = q & 1, c = nb * 16 + (l & 15);
            float v[8];
#pragma unroll
            for (int j = 0; j < 8; ++j) { const int k = 32 * st + 8 * (l >> 4) + j; float w = 0.f;
                if (c < 4) w = C.in[I_MOE_WGRP][((size_t)layer * 1024 + k) * 4 + c]; else if (c < 36) w = C.in[I_MOE_WEXP][((size_t)layer * 1024 + k) * 32 + (c - 4)];
                w *= C.in[I_NORM_MOE][layer * 1024 + k];
                const float hi = bflo(cvt_pk_bf16(w, 0.f)); v[j] = part == 0 ? hi : w - hi; }
            wp[i] = (u32x4){cvt_pk_bf16(v[0], v[1]), cvt_pk_bf16(v[2], v[3]), cvt_pk_bf16(v[4], v[5]), cvt_pk_bf16(v[6], v[7])};
        }
    }
    {
        const f32x4* p = (const f32x4*)C.in[I_P]; u32x2* pb = (u32x2*)(ws + WS_PB);
        static_assert((DEPTH * NTOK * 256 / 4) % (8 * 256 * NTHR) == 0, "p conversion batches");
        for (int i = gt; i < DEPTH * NTOK * 256 / 4; i += 8 * NGT) {
            f32x4 v[8];
#pragma unroll
            for (int k = 0; k < 8; ++k) v[k] = p[i + k * NGT];
#pragma unroll
            for (int k = 0; k < 8; ++k) pb[i + k * NGT] = pack4(v[k]); }
    }
    {
        const float* x = C.in[I_X]; bf16* HB = (bf16*)(ws + WS_HB); float* SSQ = (float*)(ws + WS_SSQ);
        for (int r0 = gw; r0 < NTOK; r0 += 4 * NGW) {
            f32x4 xv[4][4];
#pragma unroll
            for (int q = 0; q < 4; ++q) { const f32x4* xr = (const f32x4*)(x + (size_t)(r0 + q * NGW) * DM) + C.lane;
#pragma unroll
                for (int j = 0; j < 4; ++j) xv[q][j] = xr[64 * j]; }
#pragma unroll
            for (int q = 0; q < 4; ++q) { const int r = r0 + q * NGW; u32x2* br = (u32x2*)(HB + (size_t)r * DM) + C.lane;
                float s = 0.f;
#pragma unroll
                for (int j = 0; j < 4; ++j) { const u32x2 w = pack4(xv[q][j]); br[64 * j] = w; s += sumsq4(unpack4(w)); }
                s = wave_sum(s);
                if (C.lane < 16) SSQ[(size_t)r * 16 + C.lane] = C.lane == 0 ? s : 0.f; }
        }
    }
    moe_weight_prep(C, 0, 0, C.G == 256 ? 8192 : (1 << 30));
}

__device__ __forceinline__ float rstd_from_slots16(const float* SSQ, int row) {
    const f32x4* p = (const f32x4*)(SSQ + (size_t)row * 16); const f32x4 a = p[0], b = p[1], c = p[2], d = p[3];
    const float s = ((a[0] + a[1]) + (a[2] + a[3])) + ((b[0] + b[1]) + (b[2] + b[3])) + ((c[0] + c[1]) + (c[2] + c[3])) + ((d[0] + d[1]) + (d[2] + d[3]));
    return __builtin_amdgcn_rsqf(s * (1.0f / 1024.0f) + EPS);
}
__device__ __forceinline__ float rstd_from_slots8(const float* S8, int row, float invn) {
    const f32x4* p = (const f32x4*)(S8 + (size_t)row * 8); const f32x4 a = p[0], b = p[1];
    const float s = ((a[0] + a[1]) + (a[2] + a[3])) + ((b[0] + b[1]) + (b[2] + b[3]));
    return __builtin_amdgcn_rsqf(s * invn + EPS);
}
__device__ __forceinline__ float slots16_part(const float* SSQ, int row, int fq) { const f32x4 a = ((const f32x4*)(SSQ + (size_t)row * 16))[fq]; return (a[0] + a[1]) + (a[2] + a[3]); }
__device__ __forceinline__ float slots16_finish(float s) { s += __shfl_xor(s, 16); s += __shfl_xor(s, 32); return __builtin_amdgcn_rsqf(s * (1.0f / 1024.0f) + EPS); }
__device__ __forceinline__ float slots8_part(const float* S8, int row, int fq) { const f32x4 a = ((const f32x4*)(S8 + (size_t)row * 8))[fq & 1]; return (a[0] + a[1]) + (a[2] + a[3]); }
__device__ __forceinline__ float slots8_finish(float s, float invn) { s += __shfl_xor(s, 16); return __builtin_amdgcn_rsqf(s * invn + EPS); }
__device__ __forceinline__ void rope4(f32x4& v0, f32x4& v1, const float* ct, const float* st, int pos, int j0) {
    const f32x4 c = *(const f32x4*)(ct + pos * 32 + j0), s = *(const f32x4*)(st + pos * 32 + j0);
    const f32x4 a = v0 * c - v1 * s, b = v1 * c + v0 * s; v0 = a; v1 = b;
}

typedef f32x4 Acc[2][2][4][2];
using pg8::Unit;

struct EpiStoreBf16 {
    bf16* O; int ldc; float scale; size_t bstride;
    __device__ __forceinline__ void operator()(const Acc& acc, const Unit& u, int wr, int wc, int fr, int fq) const {
        bf16* base = O + (size_t)u.aux * bstride;
        EPI_LOOP_BEGIN
            bf16* rp = base + (size_t)(u.pm * 256 + rowt) * ldc + u.pn * 256 + wc * 32 + 4 * fq;
#pragma unroll
            for (int bj = 0; bj < 2; ++bj) { *(u32x2*)(rp + bj * 128) = pack4(acc[ai][bj][m][0] * scale); *(u32x2*)(rp + bj * 128 + 16) = pack4(acc[ai][bj][m][1] * scale); }
        EPI_LOOP_END
    }
};
struct EpiResidual {
    bf16* H; const float* bias; float scale, bsc;
    __device__ __forceinline__ void operator()(const Acc& acc, const Unit& u, int wr, int wc, int fr, int fq) const {
        const int colb = u.pn * 256 + wc * 32 + 4 * fq;
#pragma unroll
        for (int ai = 0; ai < 2; ++ai) {
            u32x2 hv[4][2][2];
#pragma unroll
            for (int m = 0; m < 4; ++m) { const bf16* rp = H + (size_t)(u.pm * 256 + ai * 128 + wr * 64 + m * 16 + fr) * DM + colb;
#pragma unroll
                for (int bj = 0; bj < 2; ++bj)
#pragma unroll
                    for (int n = 0; n < 2; ++n) hv[m][bj][n] = *(const u32x2*)(rp + bj * 128 + n * 16); }
#pragma unroll
            for (int m = 0; m < 4; ++m) { bf16* rp = H + (size_t)(u.pm * 256 + ai * 128 + wr * 64 + m * 16 + fr) * DM + colb;
#pragma unroll
                for (int bj = 0; bj < 2; ++bj)
#pragma unroll
                    for (int n = 0; n < 2; ++n) { f32x4 v = unpack4(hv[m][bj][n]) + acc[ai][bj][m][n] * scale; if (bias) v += *(const f32x4*)(bias + colb + bj * 128 + n * 16) * bsc; *(u32x2*)(rp + bj * 128 + n * 16) = pack4(v); } }
        }
    }
};
struct EpiMlaA {
    const float* SSQ; bf16* CQ; bf16* CKV; bf16* KR; float* SSQQ; float* SSQKV; const float* ct; const float* st;
    __device__ __forceinline__ void operator()(const Acc& acc, const Unit& u, int wr, int wc, int fr, int fq) const {
        float rsv_[2][4];
#pragma unroll
        for (int ai = 0; ai < 2; ++ai)
#pragma unroll
            for (int m = 0; m < 4; ++m) { const int row = u.pm * 256 + ai * 128 + wr * 64 + m * 16 + fr; rsv_[ai][m] = slots16_part(SSQ, row, fq); }
#pragma unroll
        for (int ai = 0; ai < 2; ++ai)
#pragma unroll
            for (int m = 0; m < 4; ++m) rsv_[ai][m] = slots16_finish(rsv_[ai][m]);
        EPI_LOOP_BEGIN
            const int row = u.pm * 256 + rowt; const float rs = rsv_[ai][m];
            float sq = 0.f, skv = 0.f;
#pragma unroll
            for (int bj = 0; bj < 2; ++bj) {
                f32x4 v0 = acc[ai][bj][m][0] * rs, v1 = acc[ai][bj][m][1] * rs; const int col = u.pn * 256 + bj * 128 + wc * 32 + 4 * fq;
                const int seg = u.pn * 2 + bj;
                if (seg < 3) { sq += sumsq4(v0) + sumsq4(v1); bf16* p = CQ + (size_t)row * 384 + col; *(u32x2*)p = pack4(v0); *(u32x2*)(p + 16) = pack4(v1); }
                else if (seg < 5) { skv += sumsq4(v0) + sumsq4(v1); bf16* p = CKV + (size_t)row * 256 + (col - 384); *(u32x2*)p = pack4(v0); *(u32x2*)(p + 16) = pack4(v1); }
                else if (wc < 2) { rope4(v0, v1, ct, st, row & (SEQ - 1), wc * 16 + 4 * fq); unsigned char* p = (unsigned char*)KR + (size_t)row * 64 + wc * 32 + 4 * fq; v0 *= K8_SCALE; v1 *= K8_SCALE;
                    *(unsigned*)p = pk_fp8x4(v0[0], v0[1], v0[2], v0[3]); *(unsigned*)(p + 16) = pk_fp8x4(v1[0], v1[1], v1[2], v1[3]); }
            }
            sq += __shfl_xor(sq, 16); sq += __shfl_xor(sq, 32); skv += __shfl_xor(skv, 16); skv += __shfl_xor(skv, 32);
            if (fq == 0) {
                if (u.pn == 0) SSQQ[(size_t)row * 8 + wc] = sq;
                else if (u.pn == 1) { SSQQ[(size_t)row * 8 + 4 + wc] = sq; SSQKV[(size_t)row * 8 + wc] = skv; }
                else SSQKV[(size_t)row * 8 + 4 + wc] = skv;
            }
        EPI_LOOP_END
    }
};
struct EpiMlaQ {
    const float* SSQQ; bf16* Q; const float* ct; const float* st;
    __device__ __forceinline__ void operator()(const Acc& acc, const Unit& u, int wr, int wc, int fr, int fq) const {
        float rsv_[2][4];
#pragma unroll
        for (int ai = 0; ai < 2; ++ai)
#pragma unroll
            for (int m = 0; m < 4; ++m) { const int row = u.pm * 256 + ai * 128 + wr * 64 + m * 16 + fr; rsv_[ai][m] = slots8_part(SSQQ, row, fq); }
#pragma unroll
        for (int ai = 0; ai < 2; ++ai)
#pragma unroll
            for (int m = 0; m < 4; ++m) rsv_[ai][m] = slots8_finish(rsv_[ai][m], 1.0f / 384.0f);
        EPI_LOOP_BEGIN
            const int row = u.pm * 256 + rowt; const float rs = rsv_[ai][m];
#pragma unroll
            for (int bj = 0; bj < 2; ++bj) {
                f32x4 v0 = acc[ai][bj][m][0] * rs, v1 = acc[ai][bj][m][1] * rs; const int g32 = u.pn * 8 + bj * 4 + wc, gi = g32 % 6;
                if (gi >= 4) rope4(v0, v1, ct, st, row & (SEQ - 1), (gi - 4) * 16 + 4 * fq);
                unsigned char* p = (unsigned char*)Q + (size_t)row * 1536 + g32 * 32 + 4 * fq; v0 *= Q8_SCALE; v1 *= Q8_SCALE;
                *(unsigned*)p = pk_fp8x4(v0[0], v0[1], v0[2], v0[3]); *(unsigned*)(p + 16) = pk_fp8x4(v1[0], v1[1], v1[2], v1[3]);
            }
        EPI_LOOP_END
    }
};
struct MlaKnSched { const bf16* A; const bf16* W; int K, ldb, G, c;
    __device__ __forceinline__ bool next(int i, Unit& u) const { const int L = i * G + c; if (L >= 512) return false;
        u.pn = L & 3; u.pm = L >> 2; u.aux = 0; u.a = (const char*)(A + (size_t)u.pm * 256 * 256); u.b = (const char*)(W + (size_t)(2 * u.pn) * 256 * 256); return true; }
    __device__ __forceinline__ unsigned aoff(const Unit&, int half, int R, int Cc) const { return (unsigned)((R + 128 * half) * 256 + Cc) * 2u; }
    __device__ __forceinline__ unsigned boff(int R, int Cc) const { return (unsigned)(R * 256 + Cc) * 2u; }
    __device__ __forceinline__ size_t hstepB() const { return (size_t)256 * 256 * 2; } };
struct EpiMlaKN {
    const float* SSQKV; unsigned char* KN;
    __device__ __forceinline__ void operator()(const Acc& acc, const Unit& u, int wr, int wc, int fr, int fq) const {
        float rsv_[2][4];
#pragma unroll
        for (int ai = 0; ai < 2; ++ai)
#pragma unroll
            for (int m = 0; m < 4; ++m) { const int row = u.pm * 256 + ai * 128 + wr * 64 + m * 16 + fr; rsv_[ai][m] = slots8_part(SSQKV, row, fq); }
#pragma unroll
        for (int ai = 0; ai < 2; ++ai)
#pragma unroll
            for (int m = 0; m < 4; ++m) rsv_[ai][m] = slots8_finish(rsv_[ai][m], 1.0f / 256.0f) * K8_SCALE;
        EPI_LOOP_BEGIN
            const int row = u.pm * 256 + rowt; const float rs = rsv_[ai][m];
            unsigned char* rp = KN + (size_t)row * 1024 + (2 * u.pn) * 128 + wc * 32 + 4 * fq;
#pragma unroll
            for (int bj = 0; bj < 2; ++bj) { const f32x4 v0 = acc[ai][bj][m][0] * rs, v1 = acc[ai][bj][m][1] * rs;
                *(unsigned*)(rp + bj * 128) = pk_fp8x4(v0[0], v0[1], v0[2], v0[3]); *(unsigned*)(rp + bj * 128 + 16) = pk_fp8x4(v1[0], v1[1], v1[2], v1[3]); }
        EPI_LOOP_END
    }
};
struct MlaVtSched { const bf16* W; const bf16* Bm; int K, ldb, G, c;
    __device__ __forceinline__ bool next(int i, Unit& u) const { const int L = i * G + c; if (L >= 512) return false;
        u.pn = L >> 2; u.pm = L & 3; u.aux = 0; u.a = (const char*)(W + ((size_t)(2 * u.pm) * 256 + 128) * 256); u.b = (const char*)(Bm + (size_t)u.pn * 256 * 256); return true; }
    __device__ __forceinline__ unsigned aoff(const Unit&, int half, int R, int Cc) const { return (unsigned)((R + 256 * half) * 256 + Cc) * 2u; }
    __device__ __forceinline__ unsigned boff(int R, int Cc) const { return (unsigned)(R * 256 + Cc) * 2u; }
    __device__ __forceinline__ size_t hstepB() const { return (size_t)128 * 256 * 2; } };
struct EpiMlaVT {
    const float* SSQKV; unsigned char* VT;
    __device__ __forceinline__ void operator()(const Acc& acc, const Unit& u, int wr, int wc, int fr, int fq) const {
        f32x4 rs[2][2];
#pragma unroll
        for (int bj = 0; bj < 2; ++bj)
#pragma unroll
            for (int n = 0; n < 2; ++n)
#pragma unroll
                for (int i = 0; i < 4; ++i) rs[bj][n][i] = rstd_from_slots8(SSQKV, u.pn * 256 + bj * 128 + wc * 32 + n * 16 + 4 * fq + i, 1.0f / 256.0f) * ATT8_SCALE;
        const int tok0 = u.pn * 256 + wc * 32 + 4 * fq, b = tok0 >> 13, s0 = tok0 & (SEQ - 1);
        EPI_LOOP_BEGIN
            const int head = 2 * u.pm + ai, d = wr * 64 + m * 16 + fr;
            unsigned char* rp = VT + ((size_t)(b * 8 + head) * 128 + d) * SEQ + s0;
#pragma unroll
            for (int bj = 0; bj < 2; ++bj) { const f32x4 v0 = acc[ai][bj][m][0] * rs[bj][0], v1 = acc[ai][bj][m][1] * rs[bj][1];
                *(unsigned*)(rp + bj * 128) = pk_fp8x4(v0[0], v0[1], v0[2], v0[3]); *(unsigned*)(rp + bj * 128 + 16) = pk_fp8x4(v1[0], v1[1], v1[2], v1[3]); }
        EPI_LOOP_END
    }
};
struct FnetTSched { const bf16* Fch; const bf16* HB; int K, ldb, G, c;
    __device__ __forceinline__ bool next(int i, Unit& u) const { const int L = i * G + c; if (L >= 1024) return false;
        const int pn = L & 31, pm = (L >> 5) & 1, g = (L >> 6) & 3, b = L >> 8; u.pm = pm; u.pn = pn; u.aux = b * 4 + g;
        u.a = (const char*)(Fch + (size_t)(g * 512 + pm * 256) * 256); u.b = (const char*)(HB + ((size_t)(b * SEQ + pn * 2)) * 1024 + g * 256); return true; }
    __device__ __forceinline__ unsigned aoff(const Unit&, int half, int R, int Cc) const { return (unsigned)((R + 128 * half) * 256 + Cc) * 2u; }
    __device__ __forceinline__ unsigned boff(int R, int Cc) const { return (unsigned)(R * 64 * 1024 + Cc) * 2u; }
    __device__ __forceinline__ size_t hstepB() const { return (size_t)1024 * 2; } };
struct EpiFnetT {
    const float* SSQ; bf16* TT;
    __device__ __forceinline__ void operator()(const Acc& acc, const Unit& u, int wr, int wc, int fr, int fq) const {
        const int b = u.aux >> 2, g = u.aux & 3;
        f32x4 rs[2][2];
#pragma unroll
        for (int bj = 0; bj < 2; ++bj)
#pragma unroll
            for (int n = 0; n < 2; ++n)
#pragma unroll
                for (int i = 0; i < 4; ++i) rs[bj][n][i] = rstd_from_slots16(SSQ, b * SEQ + (wc * 32 + n * 16 + 4 * fq + i) * 64 + u.pn * 2 + bj);
        EPI_LOOP_BEGIN
            const int f = u.pm * 256 + rowt, part = f >> 8, j = f & 255;
#pragma unroll
            for (int bj = 0; bj < 2; ++bj) {
                bf16* rp = TT + (((size_t)(b * 1024 + g * 256 + j) * 64 + u.pn * 2 + bj) * 2 + part) * 128 + wc * 32 + 4 * fq;
                *(u32x2*)rp = pack4(acc[ai][bj][m][0] * rs[bj][0]); *(u32x2*)(rp + 16) = pack4(acc[ai][bj][m][1] * rs[bj][1]); }
        EPI_LOOP_END
    }
};
struct FnetConstASched { const bf16* W; const bf16* Bm; int K, ldb, nunits, G, c;
    __device__ __forceinline__ bool next(int i, Unit& u) const { const int L = i * G + c; if (L >= nunits) return false;
        u.pm = 0; u.pn = L; u.aux = 0; u.a = (const char*)W; u.b = (const char*)(Bm + (size_t)L * 256 * ldb); return true; }
    __device__ __forceinline__ unsigned aoff(const Unit&, int half, int R, int Cc) const { return (unsigned)((R + 128 * half) * K + Cc) * 2u; }
    __device__ __forceinline__ unsigned boff(int R, int Cc) const { return (unsigned)(R * ldb + Cc) * 2u; }
    __device__ __forceinline__ size_t hstepB() const { return (size_t)128 * ldb * 2; } };
struct EpiFnet1 {
    bf16* Z; const float* twc; const float* tws;
    __device__ __forceinline__ void operator()(const Acc& acc, const Unit& u, int wr, int wc, int fr, int fq) const {
        f32x4 tc_[4][2], tn_[4][2];
#pragma unroll
        for (int m = 0; m < 4; ++m)
#pragma unroll
            for (int n = 0; n < 2; ++n) { const int k1 = wr * 64 + m * 16 + fr, s2 = (wc * 32 + n * 16 + 4 * fq) & 63; tc_[m][n] = *(const f32x4*)(twc + k1 * 64 + s2); tn_[m][n] = *(const f32x4*)(tws + k1 * 64 + s2); }
#pragma unroll
        for (int m = 0; m < 4; ++m) { const int k1 = wr * 64 + m * 16 + fr;
#pragma unroll
            for (int bj = 0; bj < 2; ++bj)
#pragma unroll
                for (int n = 0; n < 2; ++n) {
                    const int nrow = u.pn * 256 + bj * 128 + wc * 32 + n * 16 + 4 * fq, s2 = nrow & 63, c = (nrow >> 6) & 1023, b = nrow >> 16;
                    const f32x4 cs = tc_[m][n], sn = tn_[m][n];
                    const f32x4 zr = acc[0][bj][m][n], zi = acc[1][bj][m][n];
                    const f32x4 orr = zr * cs + zi * sn, oi = zi * cs - zr * sn;
                    bf16* p = Z + ((((size_t)(b * 128 + k1) * 1024 + c) * 2) * 64) + s2;
                    *(u32x2*)p = pack4(orr); *(u32x2*)(p + 64) = pack4(oi); }
        }
    }
};
struct EpiFnet2 {
    unsigned char* F; float scale;
    __device__ __forceinline__ void operator()(const Acc& acc, const Unit& u, int wr, int wc, int fr, int fq) const {
        if (wr != 0) return;
#pragma unroll
        for (int m = 0; m < 4; ++m) { const int k2 = m * 16 + fr;
#pragma unroll
            for (int bj = 0; bj < 2; ++bj)
#pragma unroll
                for (int n = 0; n < 2; ++n) {
                    const int nrow = u.pn * 256 + bj * 128 + wc * 32 + n * 16 + 4 * fq, c = nrow & 1023, k1 = (nrow >> 10) & 127, b = nrow >> 17;
                    const f32x4 v = acc[0][bj][m][n] * scale; *(unsigned*)(F + ((size_t)b * SEQ + k1 + 128 * k2) * 1024 + c) = pk_fp8x4(v[0], v[1], v[2], v[3]); }
        }
    }
};
__device__ __forceinline__ float gelu_tanh(float x) {
    const float u = x * (0.7978845608028654f + 0.035677408136300125f * x * x);
    return x * fast_rcp(1.0f + fast_exp2(-2.8853900817779268f * u));
}
struct EpiGmlpIn {
    const float* SSQ; bf16* U; bf16* V; float* SSQV; float sc;
    __device__ __forceinline__ void operator()(const Acc& acc, const Unit& u, int wr, int wc, int fr, int fq) const {
        const bool isv = u.pn >= 8; bf16* O = isv ? V : U; const int colt = (isv ? u.pn - 8 : u.pn) * 256 + wc * 32 + 4 * fq;
        float rsv_[2][4];
#pragma unroll
        for (int ai = 0; ai < 2; ++ai)
#pragma unroll
            for (int m = 0; m < 4; ++m) { const int row = u.pm * 256 + ai * 128 + wr * 64 + m * 16 + fr; rsv_[ai][m] = slots16_part(SSQ, row, fq); }
#pragma unroll
        for (int ai = 0; ai < 2; ++ai)
#pragma unroll
            for (int m = 0; m < 4; ++m) rsv_[ai][m] = slots16_finish(rsv_[ai][m]) * sc;
        EPI_LOOP_BEGIN
            const int row = u.pm * 256 + rowt; const float rs = rsv_[ai][m]; float sv = 0.f;
            bf16* rp = O + (size_t)row * 2048 + colt;
#pragma unroll
            for (int bj = 0; bj < 2; ++bj)
#pragma unroll
                for (int n = 0; n < 2; ++n) { f32x4 v = acc[ai][bj][m][n] * rs;
#pragma unroll
                    for (int i = 0; i < 4; ++i) v[i] = gelu_tanh(v[i]);
                    sv += sumsq4(v); *(u32x2*)(rp + bj * 128 + n * 16) = pack4(v); }
            if (isv) { sv += __shfl_xor(sv, 16); sv += __shfl_xor(sv, 32); if (fq == 0) SSQV[(size_t)row * 32 + (u.pn - 8) * 4 + wc] = sv; }
        EPI_LOOP_END
    }
};
struct EpiDilQkv {
    const float* SSQ; bf16* QKV; const float* ct; const float* st; float sc;
    __device__ __forceinline__ void operator()(const Acc& acc, const Unit& u, int wr, int wc, int fr, int fq) const {
        float rsv_[2][4];
#pragma unroll
        for (int ai = 0; ai < 2; ++ai)
#pragma unroll
            for (int m = 0; m < 4; ++m) { const int row = u.pm * 256 + ai * 128 + wr * 64 + m * 16 + fr; rsv_[ai][m] = slots16_part(SSQ, row, fq); }
#pragma unroll
        for (int ai = 0; ai < 2; ++ai)
#pragma unroll
            for (int m = 0; m < 4; ++m) rsv_[ai][m] = slots16_finish(rsv_[ai][m]) * sc;
        const int tq = (u.pn >> 1) % 3;
        f32x4 rc_[2][4], rn_[2][4];
        if (tq < 2) {
#pragma unroll
            for (int ai = 0; ai < 2; ++ai)
#pragma unroll
                for (int m = 0; m < 4; ++m) { const int pos = (u.pm * 256 + ai * 128 + wr * 64 + m * 16 + fr) & (SEQ - 1), j0 = (wc & 1) * 16 + 4 * fq; rc_[ai][m] = *(const f32x4*)(ct + pos * 32 + j0); rn_[ai][m] = *(const f32x4*)(st + pos * 32 + j0); }
        }
        EPI_LOOP_BEGIN
            const int row = u.pm * 256 + rowt; const float rs = rsv_[ai][m];
#pragma unroll
            for (int bj = 0; bj < 2; ++bj) {
                f32x4 v0 = acc[ai][bj][m][0] * rs, v1 = acc[ai][bj][m][1] * rs; const int g32 = u.pn * 8 + bj * 4 + wc;
                if (tq < 2) { const f32x4 a_ = v0 * rc_[ai][m] - v1 * rn_[ai][m], b_ = v1 * rc_[ai][m] + v0 * rn_[ai][m]; v0 = a_; v1 = b_; if (tq == 0) { v0 *= 0.125f; v1 *= 0.125f; } }
                bf16* p = QKV + (size_t)row * 4608 + g32 * 32 + 4 * fq; *(u32x2*)p = pack4(v0); *(u32x2*)(p + 16) = pack4(v1);
            }
        EPI_LOOP_END
    }
};
struct EpiPle {
    bf16* H; const bf16* PP; float* SSQ; float scale; unsigned char* H8; float asc;
    __device__ __forceinline__ void operator()(const Acc& acc, const Unit& u, int wr, int wc, int fr, int fq) const {
        const int colb = u.pn * 256 + wc * 32 + 4 * fq;
#pragma unroll
        for (int ai = 0; ai < 2; ++ai) {
            u32x2 hv[4][2][2], pv[4][2][2];
#pragma unroll
            for (int m = 0; m < 4; ++m) { const size_t ro = (size_t)(u.pm * 256 + ai * 128 + wr * 64 + m * 16 + fr) * DM + colb;
#pragma unroll
                for (int bj = 0; bj < 2; ++bj)
#pragma unroll
                    for (int n = 0; n < 2; ++n) { hv[m][bj][n] = *(const u32x2*)(H + ro + bj * 128 + n * 16); pv[m][bj][n] = *(const u32x2*)(PP + ro + bj * 128 + n * 16); } }
#pragma unroll
            for (int m = 0; m < 4; ++m) { const int row = u.pm * 256 + ai * 128 + wr * 64 + m * 16 + fr; float ss = 0.f;
#pragma unroll
                for (int bj = 0; bj < 2; ++bj)
#pragma unroll
                    for (int n = 0; n < 2; ++n) {
                        const size_t o = (size_t)row * DM + colb + bj * 128 + n * 16; const f32x4 a = acc[ai][bj][m][n]; const f32x4 pp = unpack4(pv[m][bj][n]); f32x4 h = unpack4(hv[m][bj][n]);
#pragma unroll
                        for (int i = 0; i < 4; ++i) h[i] += scale * pp[i] * fast_rcp(1.0f + fast_exp2(asc * a[i]));
                        const u32x2 hw = pack4(h); *(u32x2*)(H + o) = hw; ss += sumsq4(unpack4(hw));
                        if (H8) *(unsigned*)(H8 + o) = pk_fp8x4(h[0] * XN8_SCALE, h[1] * XN8_SCALE, h[2] * XN8_SCALE, h[3] * XN8_SCALE);
                    }
                ss += __shfl_xor(ss, 16); ss += __shfl_xor(ss, 32);
                if (fq == 0) SSQ[(size_t)row * 16 + u.pn * 4 + wc] = ss; }
        }
    }
};

__device__ __forceinline__ void moe_tables(const Ctx& C, int layer) {
    LAS int* T = (LAS int*)(C.lds + LDS_TAB);
    if (C.tid < 32) T[C.tid] = (int)__hip_atomic_load((unsigned*)(C.ws + WS_CTL) + CW_CNT + layer * 32 + C.tid, __ATOMIC_RELAXED, __HIP_MEMORY_SCOPE_AGENT);
    __syncthreads();
    if (C.tid == 0) { int s = 0; for (int e = 0; e < 32; ++e) { T[32 + e] = s; s += (T[e] + 255) >> 8; } T[64] = s; }
    __syncthreads();
}
struct MoeSched1 {
    const unsigned char* XN; const unsigned char* W1; const u32x2* LIST; const LAS int* T; int K, ldb, G, c;
    __device__ __forceinline__ bool next(int i, Unit& u) const {
        const int L = i * G + c, ntile = __builtin_amdgcn_readfirstlane(T[64]); if (L >= ntile * 4) return false;
        const int tile = L >> 2; u.pn = L & 3; int e = 0;
#pragma unroll 1
        for (int j = 16; j >= 1; j >>= 1) if (e + j < 32 && T[32 + e + j] <= tile) e += j;
        e = __builtin_amdgcn_readfirstlane(e); const int t0 = __builtin_amdgcn_readfirstlane(T[32 + e]);
        u.aux = e; u.pm = tile - t0; u.a = (const char*)XN; u.b = (const char*)(W1 + (size_t)e * 1024 * 1024 + (size_t)u.pn * 256 * 1024); return true;
    }
    __device__ __forceinline__ unsigned aoff(const Unit& u, int half, int R, int C) const {
        const int r = u.pm * 256 + R + 128 * half; unsigned tok = 0; if (r < T[u.aux]) tok = LIST[(size_t)u.aux * MOE_CAP + r].x >> 1;
        return tok * 1024u + 2u * (unsigned)C;
    }
    __device__ __forceinline__ unsigned boff(int R, int C) const { return (unsigned)(R * 1024 + 2 * C); }
    __device__ __forceinline__ size_t hstepB() const { return (size_t)128 * 1024; }
};
struct EpiMoe1 {
    unsigned char* HBUF; const LAS int* T;
    __device__ __forceinline__ void operator()(const Acc& acc, const Unit& u, int wr, int wc, int fr, int fq) const {
        unsigned char* base = HBUF + (size_t)__builtin_amdgcn_readfirstlane(T[32 + u.aux] + u.pm) * (256 * 512) + 128 * u.pn; constexpr float sc = 1.0f / (XN8_SCALE * W8_SCALE);
        const unsigned lo = (unsigned)(32 * wc + 8 * fq);
        EPI_LOOP_BEGIN
            unsigned w[2];
#pragma unroll
            for (int bj = 0; bj < 2; ++bj) { const f32x4 g = acc[ai][bj][m][0] * sc, up = acc[ai][bj][m][1] * (sc * HB8_SCALE); f32x4 h;
#pragma unroll
                for (int i = 0; i < 4; ++i) h[i] = g[i] * fast_rcp(1.0f + fast_exp2(-1.4426950408889634f * g[i])) * up[i];
                w[bj] = pk_fp8x4(h[0], h[1], h[2], h[3]); }
            *(u32x2*)(base + ((unsigned)rowt * 512u + lo)) = (u32x2){w[0], w[1]};
        EPI_LOOP_END
    }
};
struct MoeSched2 {
    const unsigned char* HBUF; const unsigned char* W2; const LAS int* T; int K, ldb, G, c;
    __device__ __forceinline__ bool next(int i, Unit& u) const {
        const int L = i * G + c, ntile = __builtin_amdgcn_readfirstlane(T[64]); if (L >= ntile * 4) return false;
        const int tile = L >> 2; u.pn = L & 3; int e = 0;
#pragma unroll 1
        for (int j = 16; j >= 1; j >>= 1) if (e + j < 32 && T[32 + e + j] <= tile) e += j;
        e = __builtin_amdgcn_readfirstlane(e); const int t0 = __builtin_amdgcn_readfirstlane(T[32 + e]);
        u.aux = e; u.pm = tile - t0; u.a = (const char*)(HBUF + (size_t)tile * 256 * 512); u.b = (const char*)(W2 + (size_t)e * 1024 * 512 + (size_t)u.pn * 256 * 512); return true;
    }
    __device__ __forceinline__ unsigned aoff(const Unit&, int half, int R, int C) const { return (unsigned)((R + 128 * half) * 512 + 2 * C); }
    __device__ __forceinline__ unsigned boff(int R, int C) const { return (unsigned)(R * 512 + 2 * C); }
    __device__ __forceinline__ size_t hstepB() const { return (size_t)128 * 512; }
};
struct EpiMoe2 {
    bf16* YB; const u32x2* LIST; const LAS int* T;
    __device__ __forceinline__ void operator()(const Acc& acc, const Unit& u, int wr, int wc, int fr, int fq) const {
        const int cnt = T[u.aux];
        u32x2 ents[2][4];
#pragma unroll
        for (int ai = 0; ai < 2; ++ai)
#pragma unroll
            for (int m = 0; m < 4; ++m) { const int r = u.pm * 256 + ai * 128 + wr * 64 + m * 16 + fr; ents[ai][m] = LIST[(size_t)u.aux * MOE_CAP + (r < cnt ? r : 0)]; }
        EPI_LOOP_BEGIN
            const int r = u.pm * 256 + rowt;
            if (r < cnt) {
                const u32x2 ent = ents[ai][m]; const float w = __uint_as_float(ent.y) * (YB8_SCALE / (HB8_SCALE * W8_SCALE));
                unsigned char* rp = (unsigned char*)YB + (size_t)ent.x * 1024 + u.pn * 256 + wc * 32 + 4 * fq;
#pragma unroll
                for (int bj = 0; bj < 2; ++bj) { const f32x4 a0 = acc[ai][bj][m][0] * w, a1 = acc[ai][bj][m][1] * w; *(unsigned*)(rp + bj * 128) = pk_fp8x4(a0[0], a0[1], a0[2], a0[3]); *(unsigned*)(rp + bj * 128 + 16) = pk_fp8x4(a1[0], a1[1], a1[2], a1[3]); }
            }
        EPI_LOOP_END
    }
};

__device__ __forceinline__ void router_phase(const Ctx& C, int layer, const bool dry = false) {
    const bf16* H = (const bf16*)(C.ws + WS_HB); unsigned char* XN = C.ws + WS_XN; const u32x4* wp = (const u32x4*)(C.ws + WS_WPERM) + (size_t)layer * 32 * 64 * 6;
    const float* gain = C.in[I_NORM_MOE] + layer * 1024; const float* bgrp = C.in[I_MOE_BGRP] + layer * 4; const float* bexp = C.in[I_MOE_BEXP] + layer * 32;
    u32x2* LIST = (u32x2*)(C.ws + WS_LIST); unsigned* CNT = (unsigned*)(C.ws + WS_CTL) + CW_CNT + layer * 32;
    LAS float* lg = (LAS float*)(C.lds);
    LAS float* sq = (LAS float*)(C.lds + 32768);
    LAS int* hist = (LAS int*)(C.lds + 36864);
    LAS int* tk = (LAS int*)(C.lds + 40960);
    const int lane = C.lane, wave = C.wave;
    for (int chunk = C.bx; chunk < NTOK / 128; chunk += C.G) {
        const int tok0 = chunk * 128 + wave * 16;
        if (C.tid < 64) hist[C.tid] = 0;
        f32x4 acc0 = {0.f, 0.f, 0.f, 0.f}, acc1 = acc0, acc2 = acc0; float ss = 0.f;
        const bf16* hrow = H + (size_t)(tok0 + (lane & 15)) * DM + 8 * (lane >> 4);
        const u32x4* wl = wp + lane * 6;
#pragma unroll 1
        for (int half = 0; half < 2; ++half) {
            u32x4 hws[16];
#pragma unroll
            for (int s_ = 0; s_ < 16; ++s_) hws[s_] = *(const u32x4*)(hrow + (half * 16 + s_) * 32);
#pragma unroll
            for (int s_ = 0; s_ < 16; ++s_) { const int st = half * 16 + s_;
                const u32x4 hw = hws[s_]; const bf16x8 hv = __builtin_bit_cast(bf16x8, hw);
                ss += (bflo(hw.x) * bflo(hw.x) + bfhi(hw.x) * bfhi(hw.x)) + (bflo(hw.y) * bflo(hw.y) + bfhi(hw.y) * bfhi(hw.y)) + (bflo(hw.z) * bflo(hw.z) + bfhi(hw.z) * bfhi(hw.z)) + (bflo(hw.w) * bflo(hw.w) + bfhi(hw.w) * bfhi(hw.w));
                const u32x4* w6 = wl + st * 384;
                acc0 = __builtin_amdgcn_mfma_f32_16x16x32_bf16(hv, __builtin_bit_cast(bf16x8, w6[0]), acc0, 0, 0, 0); acc0 = __builtin_amdgcn_mfma_f32_16x16x32_bf16(hv, __builtin_bit_cast(bf16x8, w6[1]), acc0, 0, 0, 0);
                acc1 = __builtin_amdgcn_mfma_f32_16x16x32_bf16(hv, __builtin_bit_cast(bf16x8, w6[2]), acc1, 0, 0, 0); acc1 = __builtin_amdgcn_mfma_f32_16x16x32_bf16(hv, __builtin_bit_cast(bf16x8, w6[3]), acc1, 0, 0, 0);
                acc2 = __builtin_amdgcn_mfma_f32_16x16x32_bf16(hv, __builtin_bit_cast(bf16x8, w6[4]), acc2, 0, 0, 0); acc2 = __builtin_amdgcn_mfma_f32_16x16x32_bf16(hv, __builtin_bit_cast(bf16x8, w6[5]), acc2, 0, 0, 0); }
        }
        ss += __shfl_xor(ss, 16); ss += __shfl_xor(ss, 32);
        LAS float* lgw = lg + wave * 16 * 48;
#pragma unroll
        for (int r = 0; r < 4; ++r) { const int t = (lane >> 4) * 4 + r; lgw[t * 48 + (lane & 15)] = acc0[r]; lgw[t * 48 + 16 + (lane & 15)] = acc1[r]; lgw[t * 48 + 32 + (lane & 15)] = acc2[r]; }
        if (lane < 16) sq[wave * 16 + lane] = ss;
        __syncthreads();
        if (lane < 16) {
            const int t = lane; const float rs = __builtin_amdgcn_rsqf(sq[wave * 16 + t] * (1.0f / 1024.0f) + EPS); const LAS float* L = lgw + t * 48;
            float pgv[4]; float mx = -3.0e38f; int g = 0;
#pragma unroll
            for (int j = 0; j < 4; ++j) { pgv[j] = L[j] * rs + bgrp[j]; if (pgv[j] > mx) { mx = pgv[j]; g = j; } }
            float den = 0.f;
#pragma unroll
            for (int j = 0; j < 4; ++j) den += __expf(pgv[j] - mx);
            const float ggate = 1.0f / den;
            float v0 = -3.0e38f, v1 = -3.0e38f; int i0 = 0, i1 = 0;
#pragma unroll
            for (int j = 0; j < 8; ++j) { const float le = L[4 + g * 8 + j] * rs + bexp[g * 8 + j];
                if (le > v0) { v1 = v0; i1 = i0; v0 = le; i0 = j; } else if (le > v1) { v1 = le; i1 = j; } }
            const float e1 = __expf(v1 - v0); const float w0 = ggate / (1.0f + e1), w1 = ggate * e1 / (1.0f + e1);
            const int ex0 = g * 8 + i0, ex1 = g * 8 + i1;
            const int r0 = __hip_atomic_fetch_add(&hist[ex0], 1, __ATOMIC_RELAXED, __HIP_MEMORY_SCOPE_WORKGROUP), r1 = __hip_atomic_fetch_add(&hist[ex1], 1, __ATOMIC_RELAXED, __HIP_MEMORY_SCOPE_WORKGROUP);
            LAS int* T = tk + (wave * 16 + t) * 8; T[0] = ex0; T[1] = ex1; T[2] = r0; T[3] = r1; T[4] = (int)__float_as_uint(w0); T[5] = (int)__float_as_uint(w1);
            sq[wave * 16 + t] = rs;
        }
        __syncthreads();
        if (C.tid < 32) { const int n = hist[C.tid]; hist[32 + C.tid] = (n && !dry) ? (int)__hip_atomic_fetch_add(CNT + C.tid, (unsigned)n, __ATOMIC_RELAXED, __HIP_MEMORY_SCOPE_AGENT) : 0; }
        __syncthreads();
        if (C.tid < 128 && !dry) { const LAS int* T = tk + C.tid * 8; const unsigned tokid = (unsigned)(chunk * 128 + C.tid);
            LIST[(size_t)T[0] * MOE_CAP + hist[32 + T[0]] + T[2]] = (u32x2){tokid * 2u, (unsigned)T[4]};
            LIST[(size_t)T[1] * MOE_CAP + hist[32 + T[1]] + T[3]] = (u32x2){tokid * 2u + 1u, (unsigned)T[5]}; }
        { const f32x4* gr = (const f32x4*)gain + lane; const f32x4 g0 = gr[0], g1 = gr[64], g2 = gr[128], g3 = gr[192];
#pragma unroll 1
          for (int t = 0; t < 16; t += 4) {
            u32x2 hv[4][4];
#pragma unroll
            for (int tt = 0; tt < 4; ++tt) { const u32x2* hr = (const u32x2*)(H + (size_t)(tok0 + t + tt) * DM) + lane;
#pragma unroll
                for (int j = 0; j < 4; ++j) hv[tt][j] = hr[64 * j]; }
#pragma unroll
            for (int tt = 0; tt < 4; ++tt) { const float rs8 = sq[wave * 16 + t + tt] * XN8_SCALE; unsigned* xr = (unsigned*)(XN + (size_t)(tok0 + t + tt) * DM) + lane;
                const f32x4 a = unpack4(hv[tt][0]) * g0 * rs8, b = unpack4(hv[tt][1]) * g1 * rs8, c = unpack4(hv[tt][2]) * g2 * rs8, d = unpack4(hv[tt][3]) * g3 * rs8;
                xr[0] = pk_fp8x4(a[0], a[1], a[2], a[3]); xr[64] = pk_fp8x4(b[0], b[1], b[2], b[3]); xr[128] = pk_fp8x4(c[0], c[1], c[2], c[3]); xr[192] = pk_fp8x4(d[0], d[1], d[2], d[3]); }
          } }
        __syncthreads();
    }
}
__device__ __forceinline__ void combine_phase(const Ctx& C, const float* gain, const float scale) {
    bf16* H = (bf16*)(C.ws + WS_HB); unsigned char* XN = C.ws + WS_XN; const bf16* YB = (const bf16*)(C.ws + AR_YB);
    const int gw = C.bx * NWAVES + C.wave, NGW = C.G * NWAVES;
    const f32x4* gr = (const f32x4*)gain + C.lane; const f32x4 g0 = gr[0], g1 = gr[64], g2 = gr[128], g3 = gr[192];
    for (int row = gw; row < NTOK; row += 2 * NGW) {
        u32x2 hin[2][4]; unsigned ya[2][4], yb[2][4];
#pragma unroll
        for (int q = 0; q < 2; ++q) { const int rw = row + q * NGW; const u32x2* hr = (const u32x2*)(H + (size_t)rw * DM) + C.lane; const unsigned* y0 = (const unsigned*)((const unsigned char*)YB + (size_t)rw * 2048) + C.lane;
#pragma unroll
            for (int j = 0; j < 4; ++j) { hin[q][j] = hr[64 * j]; ya[q][j] = y0[64 * j]; yb[q][j] = y0[256 + 64 * j]; } }
#pragma unroll
        for (int q = 0; q < 2; ++q) { const int rw = row + q * NGW; u32x2* hr = (u32x2*)(H + (size_t)rw * DM) + C.lane; unsigned* xr = (unsigned*)(XN + (size_t)rw * DM) + C.lane;
            f32x4 v[4]; float s = 0.f;
#pragma unroll
            for (int j = 0; j < 4; ++j) { const unsigned a_ = ya[q][j], b_ = yb[q][j]; const f32x4 ys = {__builtin_amdgcn_cvt_f32_fp8(a_, 0) + __builtin_amdgcn_cvt_f32_fp8(b_, 0), __builtin_amdgcn_cvt_f32_fp8(a_, 1) + __builtin_amdgcn_cvt_f32_fp8(b_, 1), __builtin_amdgcn_cvt_f32_fp8(a_, 2) + __builtin_amdgcn_cvt_f32_fp8(b_, 2), __builtin_amdgcn_cvt_f32_fp8(a_, 3) + __builtin_amdgcn_cvt_f32_fp8(b_, 3)};
                const u32x2 hw = pack4(unpack4(hin[q][j]) + ys * (scale / YB8_SCALE)); hr[64 * j] = hw; v[j] = unpack4(hw); s += sumsq4(v[j]); }
            const float rs = __builtin_amdgcn_rsqf(wave_sum(s) * (1.0f / 1024.0f) + EPS) * XN8_SCALE;
            const f32x4 a = v[0] * g0 * rs, b = v[1] * g1 * rs, c = v[2] * g2 * rs, d = v[3] * g3 * rs;
            xr[0] = pk_fp8x4(a[0], a[1], a[2], a[3]); xr[64] = pk_fp8x4(b[0], b[1], b[2], b[3]); xr[128] = pk_fp8x4(c[0], c[1], c[2], c[3]); xr[192] = pk_fp8x4(d[0], d[1], d[2], d[3]); }
    }
}
__device__ __forceinline__ void final_phase(const Ctx& C) {
    const bf16* H = (const bf16*)(C.ws + WS_HB); const float* gain = C.in[I_NORM_FINAL];
    const int gw = C.bx * NWAVES + C.wave, NGW = C.G * NWAVES;
    const f32x4* gr = (const f32x4*)gain + C.lane; const f32x4 g0 = gr[0], g1 = gr[64], g2 = gr[128], g3 = gr[192];
    for (int row0 = gw; row0 < NTOK; row0 += 4 * NGW) {
        u32x2 hv[4][4];
#pragma unroll
        for (int q = 0; q < 4; ++q) { const u32x2* hr = (const u32x2*)(H + (size_t)(row0 + q * NGW) * DM) + C.lane;
#pragma unroll
            for (int j = 0; j < 4; ++j) hv[q][j] = hr[64 * j]; }
#pragma unroll
        for (int q = 0; q < 4; ++q) { f32x4* o = (f32x4*)(C.out + (size_t)(row0 + q * NGW) * DM) + C.lane;
            f32x4 v[4]; float s = 0.f;
#pragma unroll
            for (int j = 0; j < 4; ++j) { v[j] = unpack4(hv[q][j]); s += sumsq4(v[j]); }
            const float rs = __builtin_amdgcn_rsqf(wave_sum(s) * (1.0f / 1024.0f) + EPS);
            o[0] = v[0] * g0 * rs; o[64] = v[1] * g1 * rs; o[128] = v[2] * g2 * rs; o[192] = v[3] * g3 * rs; }
    }
}
template <int OFF> __device__ __forceinline__ s16x4 tr_read_a(int addr) { s16x4 r; asm volatile("ds_read_b64_tr_b16 %0, %1 offset:%2" : "=&v"(r) : "v"(addr), "i"(OFF) : "memory"); return r; }
__device__ __forceinline__ void spatial_phase(const Ctx& C) {
    const bf16* U = (const bf16*)(C.ws + AR_U); const bf16* V = (const bf16*)(C.ws + AR_V); unsigned char* Gt = C.ws + AR_G; const float* SSQV = (const float*)(C.ws + AR_SSQV);
    const float* Ws = C.in[I_GM_WS]; const float* bs = C.in[I_GM_BS]; const float* nv = C.in[I_GM_NV];
    const int g = C.bx & 15, tid = C.tid, lane = C.lane, fr = lane & 15, fq = lane >> 4, wp = C.wave >> 1, wd = C.wave & 1;
    bf16x8 Af[2][4];
#pragma unroll
    for (int m = 0; m < 2; ++m)
#pragma unroll
        for (int ks = 0; ks < 4; ++ks) { const f32x4* src = (const f32x4*)(Ws + (size_t)g * 16384 + (32 * wp + 16 * m + fr) * 128 + 32 * ks + 8 * fq); const f32x4 x = src[0], y = src[1];
            u32x4 w = {cvt_pk_bf16(x[0], x[1]), cvt_pk_bf16(x[2], x[3]), cvt_pk_bf16(y[0], y[1]), cvt_pk_bf16(y[2], y[3])}; Af[m][ks] = *reinterpret_cast<bf16x8*>(&w); }
    f32x4 nvv[4];
#pragma unroll
    for (int n = 0; n < 4; ++n) nvv[n] = *(const f32x4*)(nv + g * 128 + 64 * wd + 16 * fq + 4 * n);
    const float bias0 = bs[g * 128 + 32 * wp + fr], bias1 = bs[g * 128 + 32 * wp + 16 + fr];
    const int qq = fr >> 2, pcol = fr & 3;
    int tra[4];
#pragma unroll
    for (int n = 0; n < 4; ++n) tra[n] = (int)(uintptr_t)C.lds + (8 * fq + qq) * 256 + ((128 * wd + 32 * pcol + 8 * n) ^ ((qq << 3) | ((fq & 1) << 7)));
    const int sq = tid >> 2, sc0 = (tid & 3) * 4, sswz = ((sq & 3) << 3) | (((sq >> 3) & 1) << 7);
    u32x4 vreg[4]; float rsv;
#define SP_LOAD(chunk) do { const int tok_ = (chunk) * 128 + sq; const f32x4* sp_ = (const f32x4*)(SSQV + (size_t)tok_ * 32) + (tid & 3) * 2; const f32x4 a_ = sp_[0], b_ = sp_[1]; \
        float s_ = ((a_[0] + a_[1]) + (a_[2] + a_[3])) + ((b_[0] + b_[1]) + (b_[2] + b_[3])); s_ += __shfl_xor(s_, 1); s_ += __shfl_xor(s_, 2); rsv = __builtin_amdgcn_rsqf(s_ * (1.0f / 2048.0f) + EPS); \
        const u32x4* vp_ = (const u32x4*)(V + (size_t)tok_ * 2048 + g * 128 + sc0 * 8); _Pragma("unroll") for (int j = 0; j < 4; ++j) vreg[j] = vp_[j]; } while (0)
#define SP_WRITE() do { _Pragma("unroll") for (int j = 0; j < 4; ++j) { const u32x4 w_ = vreg[j]; \
        const u32x2 lo_ = {cvt_pk_bf16(bflo(w_.x) * rsv, bfhi(w_.x) * rsv), cvt_pk_bf16(bflo(w_.y) * rsv, bfhi(w_.y) * rsv)}, hi_ = {cvt_pk_bf16(bflo(w_.z) * rsv, bfhi(w_.z) * rsv), cvt_pk_bf16(bflo(w_.w) * rsv, bfhi(w_.w) * rsv)}; \
        const int cb_ = (sc0 + j) * 16; *(LAS u32x2*)(C.lds + sq * 256 + (cb_ ^ sswz)) = lo_; *(LAS u32x2*)(C.lds + sq * 256 + ((cb_ + 8) ^ sswz)) = hi_; } } while (0)
    int chunk = C.bx >> 4; const int cstep = C.G >> 4;
    if (chunk < NTOK / 128) SP_LOAD(chunk);
    for (; chunk < NTOK / 128; chunk += cstep) {
        __syncthreads();
        SP_WRITE();
        __syncthreads();
        if (chunk + cstep < NTOK / 128) SP_LOAD(chunk + cstep);
        f32x4 acc[2][4];
#pragma unroll
        for (int m = 0; m < 2; ++m)
#pragma unroll
            for (int n = 0; n < 4; ++n) acc[m][n] = (f32x4){0.f, 0.f, 0.f, 0.f};
#define SP_KS(KS) do { bf16x8 Bf[4]; _Pragma("unroll") for (int n = 0; n < 4; ++n) { const s16x4 l_ = tr_read_a<(KS) * 8192>(tra[n]), h_ = tr_read_a<(KS) * 8192 + 1024>(tra[n]); \
            Bf[n] = (bf16x8){l_[0], l_[1], l_[2], l_[3], h_[0], h_[1], h_[2], h_[3]}; } \
        asm volatile("s_waitcnt lgkmcnt(0)" ::: "memory"); SBAR(); \
        _Pragma("unroll") for (int m = 0; m < 2; ++m) _Pragma("unroll") for (int n = 0; n < 4; ++n) acc[m][n] = __builtin_amdgcn_mfma_f32_16x16x32_bf16(Bf[n], Af[m][KS], acc[m][n], 0, 0, 0); } while (0)
        SP_KS(0); SP_KS(1); SP_KS(2); SP_KS(3);
#undef SP_KS
#pragma unroll
        for (int m = 0; m < 2; ++m) { const int p = 32 * wp + 16 * m + fr; const float bias = m == 0 ? bias0 : bias1;
            const size_t o = (size_t)(chunk * 128 + p) * 2048 + g * 128 + 64 * wd + 16 * fq;
            const u32x4 u0 = *(const u32x4*)(U + o), u1 = *(const u32x4*)(U + o + 8);
            const f32x4 s0 = (acc[m][0] * nvv[0] + bias) * G8_SCALE, s1 = (acc[m][1] * nvv[1] + bias) * G8_SCALE, s2 = (acc[m][2] * nvv[2] + bias) * G8_SCALE, s3 = (acc[m][3] * nvv[3] + bias) * G8_SCALE;
            const u32x4 o8 = {pk_fp8x4(bflo(u0.x) * s0[0], bfhi(u0.x) * s0[1], bflo(u0.y) * s0[2], bfhi(u0.y) * s0[3]), pk_fp8x4(bflo(u0.z) * s1[0], bfhi(u0.z) * s1[1], bflo(u0.w) * s1[2], bfhi(u0.w) * s1[3]),
                              pk_fp8x4(bflo(u1.x) * s2[0], bfhi(u1.x) * s2[1], bflo(u1.y) * s2[2], bfhi(u1.y) * s2[3]), pk_fp8x4(bflo(u1.z) * s3[0], bfhi(u1.z) * s3[1], bflo(u1.w) * s3[2], bfhi(u1.w) * s3[3])};
            *(u32x4*)(Gt + o) = o8; }
    }
#undef SP_LOAD
#undef SP_WRITE
    __syncthreads();
}

namespace mla {
constexpr int DQK = 192, DV = 128, KVBLK = 64;
constexpr float SCALE = 0.07216878364870322f;
constexpr float THR = 8.f;
constexpr int SHM_V = KVBLK * DV * 2, SHM_K = KVBLK * DQK * 2;
#define KSWZ(row, colB) ((row) * 384 + ((colB) ^ ((((row) >> 1) & 7) << 4)))
__device__ __forceinline__ int crow(int r, int hi) { return (r & 3) + 8 * (r >> 2) + 4 * hi; }
__device__ __forceinline__ void partialSM(f32x16& p0, f32x16& p1, float& m_reg, float& mn, float& alpha) {
    constexpr float Cc = SCALE * 1.4426950408889634f;
    float pmax = p0[0];
#pragma unroll
    for (int r = 1; r < 16; ++r) pmax = fmaxf(pmax, p0[r]);
#pragma unroll
    for (int r = 0; r < 16; ++r) pmax = fmaxf(pmax, p1[r]);
    { auto rr = __builtin_amdgcn_permlane32_swap(__float_as_uint(pmax), __float_as_uint(pmax), false, false); pmax = fmaxf(__uint_as_float(rr[0]), __uint_as_float(rr[1])); }
    if (__builtin_expect(__all(pmax - m_reg <= THR / SCALE), 1)) { mn = m_reg; alpha = 1.f; }
    else { mn = fmaxf(m_reg, pmax); alpha = __builtin_amdgcn_exp2f((m_reg - mn) * Cc); m_reg = mn; }
    const float mnC = -mn * Cc;
#pragma unroll
    for (int r = 0; r < 16; ++r) p0[r] = fmaf(p0[r], Cc, mnC);
#pragma unroll
    for (int r = 0; r < 16; ++r) p1[r] = fmaf(p1[r], Cc, mnC);
#pragma unroll
    for (int r = 0; r < 16; ++r) p0[r] = __builtin_amdgcn_exp2f(p0[r]);
}
__device__ __forceinline__ void finishSM(f32x16& p0, f32x16& p1, float alpha, float& l_reg, bf16x8& pa0, bf16x8& pa1, bf16x8& pa2, bf16x8& pa3) {
#pragma unroll
    for (int r = 0; r < 16; ++r) p1[r] = __builtin_amdgcn_exp2f(p1[r]);
    float ps = 0;
#pragma unroll
    for (int r = 0; r < 16; ++r) ps += p0[r];
#pragma unroll
    for (int r = 0; r < 16; ++r) ps += p1[r];
    { auto rr = __builtin_amdgcn_permlane32_swap(__float_as_uint(ps), __float_as_uint(ps), false, false); ps = __uint_as_float(rr[0]) + __uint_as_float(rr[1]); }
    l_reg = l_reg * alpha + ps;
#define PK4(P, BASE, OUT) do { unsigned a0 = cvt_pk_bf16(P[BASE + 0], P[BASE + 1]), a1 = cvt_pk_bf16(P[BASE + 2], P[BASE + 3]);   \
    unsigned b0 = cvt_pk_bf16(P[BASE + 4], P[BASE + 5]), b1 = cvt_pk_bf16(P[BASE + 6], P[BASE + 7]);                              \
    auto r0 = __builtin_amdgcn_permlane32_swap(a0, b0, false, false); auto r1 = __builtin_amdgcn_permlane32_swap(a1, b1, false, false); \
    u32x4 w = {r0[0], r1[0], r0[1], r1[1]}; OUT = *reinterpret_cast<bf16x8*>(&w); } while (0)
    PK4(p0, 0, pa0); PK4(p0, 8, pa1); PK4(p1, 0, pa2); PK4(p1, 8, pa3);
#undef PK4
}
__device__ __forceinline__ void qkt(f32x16& p0, f32x16& p1, const char* Ks, const bf16x8* qr, int r32, int hi) {
    p0 = f32x16{}; p1 = f32x16{};
#pragma unroll
    for (int d0 = 0; d0 < 12; ++d0) { const int cb = (d0 * 16 + hi * 8) * 2;
        const bf16x8 b0 = *reinterpret_cast<const bf16x8*>(Ks + KSWZ(r32, cb));
        const bf16x8 b1 = *reinterpret_cast<const bf16x8*>(Ks + KSWZ(32 + r32, cb));
        p0 = __builtin_amdgcn_mfma_f32_32x32x16_bf16(b0, qr[d0], p0, 0, 0, 0);
        p1 = __builtin_amdgcn_mfma_f32_32x32x16_bf16(b1, qr[d0], p1, 0, 0, 0); }
}
__device__ __forceinline__ int v_st(int k, int c) { const int kk = (k & ~0xC) | ((k & 4) << 1) | ((k & 8) >> 1); return ((kk >> 3) * 4 + (c >> 5)) * 512 + ((kk & 7) * 32 + (c & 31)) * 2; }
__device__ __forceinline__ int v_rd_base(int lane) { return ((lane & 3) << 3) | (((lane >> 2) & 3) << 6) | (((lane >> 4) & 1) << 5) | (((lane >> 5) & 1) << 8); }
constexpr int v_rd_off(int d0, int ks, int half) { return d0 * 512 + ks * 4096 + half * 2048; }
template <int OFF> __device__ __forceinline__ s16x4 tr_read(int vb) { s16x4 r; asm volatile("ds_read_b64_tr_b16 %0, %1 offset:%2" : "=&v"(r) : "v"(vb), "i"(OFF) : "memory"); return r; }
template <int D0> __device__ __forceinline__ void pv_one(f32x16& od, int vb, bf16x8 pa0, bf16x8 pa1, bf16x8 pa2, bf16x8 pa3) {
    const s16x4 l0 = tr_read<v_rd_off(D0, 0, 0)>(vb), h0 = tr_read<v_rd_off(D0, 0, 1)>(vb), l1 = tr_read<v_rd_off(D0, 1, 0)>(vb), h1 = tr_read<v_rd_off(D0, 1, 1)>(vb);
    const s16x4 l2 = tr_read<v_rd_off(D0, 2, 0)>(vb), h2 = tr_read<v_rd_off(D0, 2, 1)>(vb), l3 = tr_read<v_rd_off(D0, 3, 0)>(vb), h3 = tr_read<v_rd_off(D0, 3, 1)>(vb);
    asm volatile("s_waitcnt lgkmcnt(0)" ::: "memory"); SBAR();
#define PK(L, H) (bf16x8){L[0], L[1], L[2], L[3], H[0], H[1], H[2], H[3]}
    od = __builtin_amdgcn_mfma_f32_32x32x16_bf16(pa0, PK(l0, h0), od, 0, 0, 0);
    od = __builtin_amdgcn_mfma_f32_32x32x16_bf16(pa1, PK(l1, h1), od, 0, 0, 0);
    od = __builtin_amdgcn_mfma_f32_32x32x16_bf16(pa2, PK(l2, h2), od, 0, 0, 0);
    od = __builtin_amdgcn_mfma_f32_32x32x16_bf16(pa3, PK(l3, h3), od, 0, 0, 0);
#undef PK
}
__device__ __forceinline__ void pv_d0(f32x16* o, int vb, bf16x8 pa0, bf16x8 pa1, bf16x8 pa2, bf16x8 pa3) {
    pv_one<0>(o[0], vb, pa0, pa1, pa2, pa3); pv_one<1>(o[1], vb, pa0, pa1, pa2, pa3); pv_one<2>(o[2], vb, pa0, pa1, pa2, pa3); pv_one<3>(o[3], vb, pa0, pa1, pa2, pa3);
}
__device__ __forceinline__ void attn_unit(const int tid, const bf16* Q, const bf16* KV, const bf16* KR, bf16* O, int b, int h, int qb, char* lds) {
    const int wid = tid >> 6, lane = tid & 63, r32 = lane & 31, hi = lane >> 5;
    char* V_lds = lds; char* K_lds = lds + 2 * SHM_V;
    float* ws = (float*)(lds + 2 * SHM_V + 2 * SHM_K) + wid * 64; float* li_l = ws; float* al_l = ws + 32;
    float m_reg = -1e30f, l_reg = 0; f32x16 o[4] = {}; bf16x8 qr[12];
    const size_t tokb = (size_t)b * SEQ;
    { const char* Qw = (const char*)(Q + (tokb + qb * 256 + __builtin_amdgcn_readfirstlane(wid) * 32) * 1536 + h * 192); const unsigned qo = (unsigned)(r32 * 1536 + hi * 8) * 2u;
#pragma unroll
      for (int d0 = 0; d0 < 12; ++d0) qr[d0] = *reinterpret_cast<const bf16x8*>(Qw + qo + d0 * 32); }
    const int sr = tid >> 4, sc = (tid & 15) * 8, vst0 = v_st(sr, sc), vst1 = v_st(32 + sr, sc);
    const int rr = tid >> 3, rc = (tid & 7) * 8;
    const int vb0 = (int)(uintptr_t)V_lds + v_rd_base(lane);
    const char* Kn = (const char*)(KV + tokb * 2048 + h * 256); const char* Kr = (const char*)(KR + tokb * 64);
    const unsigned ko0 = (unsigned)(sr * 2048 + sc) * 2u, ko1 = ko0 + 32u * 2048u * 2u, kro = (unsigned)(rr * 64 + rc) * 2u;
    bf16x8 sv0, sv1, sk0, sk1, skr;
#define SLOAD(k0) do { const char* kb_ = Kn + (size_t)(k0) * 4096; const char* rb_ = Kr + (size_t)(k0) * 128; \
    sv0 = *reinterpret_cast<const bf16x8*>(kb_ + 256 + ko0); sv1 = *reinterpret_cast<const bf16x8*>(kb_ + 256 + ko1); \
    sk0 = *reinterpret_cast<const bf16x8*>(kb_ + ko0); sk1 = *reinterpret_cast<const bf16x8*>(kb_ + ko1); \
    skr = *reinterpret_cast<const bf16x8*>(rb_ + kro); } while (0)
#define SWRITE(bb) do { *(bf16x8*)(V_lds + (bb) * SHM_V + vst0) = sv0; *(bf16x8*)(V_lds + (bb) * SHM_V + vst1) = sv1; const int kc = sc * 2; \
    *(bf16x8*)(K_lds + (bb) * SHM_K + KSWZ(sr, kc)) = sk0; *(bf16x8*)(K_lds + (bb) * SHM_K + KSWZ(32 + sr, kc)) = sk1; \
    *(bf16x8*)(K_lds + (bb) * SHM_K + KSWZ(rr, 256 + rc * 2)) = skr; } while (0)
#define RESC(a) do { if (__any((a) < 1.f)) { if (hi == 0) al_l[r32] = (a); asm volatile("s_waitcnt lgkmcnt(0)" ::: "memory"); \
    _Pragma("unroll") for (int d = 0; d < 4; ++d) _Pragma("unroll") for (int r = 0; r < 16; ++r) o[d][r] *= al_l[crow(r, hi)]; } } while (0)
    f32x16 p0, p1; float mn, al; bf16x8 pa0, pa1, pa2, pa3; constexpr int NT = SEQ / KVBLK;
    SLOAD(0); asm volatile("s_waitcnt vmcnt(0)" ::: "memory"); SWRITE(0); __syncthreads();
#pragma unroll 1
    for (int j = 0; j < NT; j += 2) {
        SLOAD((j + 1) * KVBLK); SBAR();
        qkt(p0, p1, K_lds, qr, r32, hi); partialSM(p0, p1, m_reg, mn, al); RESC(al);
        finishSM(p0, p1, al, l_reg, pa0, pa1, pa2, pa3); SBAR();
        pv_d0(o, vb0, pa0, pa1, pa2, pa3);
        asm volatile("s_waitcnt vmcnt(0)" ::: "memory"); SWRITE(1); __syncthreads();
        if (j + 2 < NT) SLOAD((j + 2) * KVBLK); SBAR();
        qkt(p0, p1, K_lds + SHM_K, qr, r32, hi); partialSM(p0, p1, m_reg, mn, al); RESC(al);
        finishSM(p0, p1, al, l_reg, pa0, pa1, pa2, pa3); SBAR();
        pv_d0(o, vb0 + SHM_V, pa0, pa1, pa2, pa3);
        if (j + 2 < NT) { asm volatile("s_waitcnt vmcnt(0)" ::: "memory"); SWRITE(0); } __syncthreads();
    }
    if (hi == 0) li_l[r32] = l_reg; asm volatile("s_waitcnt lgkmcnt(0)" ::: "memory");
    char* Ow = (char*)(O + (tokb + qb * 256 + __builtin_amdgcn_readfirstlane(wid) * 32) * 1024 + h * 128);
    const unsigned oo = (unsigned)(4 * hi * 1024 + r32) * 2u;
#pragma unroll
    for (int r = 0; r < 16; ++r) { const float rl = __builtin_amdgcn_rcpf(li_l[crow(r, hi)]);
#pragma unroll
        for (int d0 = 0; d0 < 4; ++d0) { const unsigned w = cvt_pk_bf16(o[d0][r] * rl, 0.f); *(bf16*)(Ow + oo + (unsigned)((((r & 3) + 8 * (r >> 2)) * 1024 + d0 * 32) * 2)) = (bf16)(w & 0xffffu); } }
    __syncthreads();
#undef SLOAD
#undef SWRITE
#undef RESC
}
constexpr int SLOT = SHM_K + SHM_V;
__device__ __forceinline__ void qkt_l(f32x16& p0, f32x16& p1, const LAS char* Ks, const bf16x8* qr, int r32, int hi) {
    p0 = f32x16{}; p1 = f32x16{};
#pragma unroll
    for (int d0 = 0; d0 < 12; ++d0) { const int cb = (d0 * 16 + hi * 8) * 2;
        const bf16x8 b0 = *reinterpret_cast<const LAS bf16x8*>(Ks + KSWZ(r32, cb));
        const bf16x8 b1 = *reinterpret_cast<const LAS bf16x8*>(Ks + KSWZ(32 + r32, cb));
        p0 = __builtin_amdgcn_mfma_f32_32x32x16_bf16(b0, qr[d0], p0, 0, 0, 0);
        p1 = __builtin_amdgcn_mfma_f32_32x32x16_bf16(b1, qr[d0], p1, 0, 0, 0); }
}
#define WAITBAR(N) asm volatile("s_waitcnt vmcnt(" #N ") lgkmcnt(0)\n\ts_barrier" ::: "memory")
__device__ __forceinline__ void attn_unit_g(const int tid, const bf16* Q, const bf16* KV, const bf16* KR, bf16* O, int b, int h, int qb, LAS char* lds) {
    const int wid = __builtin_amdgcn_readfirstlane(tid >> 6), lane = tid & 63, r32 = lane & 31, hi = lane >> 5;
    LAS float* wsc = (LAS float*)(lds + 3 * SLOT) + wid * 64; LAS float* li_l = wsc; LAS float* al_l = wsc + 32;
    float m_reg = -1e30f, l_reg = 0; f32x16 o[4] = {}; bf16x8 qr[12];
    const size_t tokb = (size_t)b * SEQ;
    { const char* Qw = (const char*)(Q + (tokb + qb * 256 + wid * 32) * 1536 + h * 192); const unsigned qo = (unsigned)(r32 * 1536 + hi * 8) * 2u;
#pragma unroll
      for (int d0 = 0; d0 < 12; ++d0) qr[d0] = *reinterpret_cast<const bf16x8*>(Qw + qo + d0 * 32); }
    const char* Kn = (const char*)(KV + tokb * 2048 + h * 256); const char* Kr = (const char*)(KR + tokb * 64);
    unsigned koff[3], voff[2]; bool krope[3];
#pragma unroll
    for (int t = 0; t < 3; ++t) { const int p = (wid * 3 + t) * 64 + lane, row = p / 24, cp = p % 24, c = (cp & ~7) | ((cp ^ (row >> 1)) & 7);
        krope[t] = c >= 16; koff[t] = krope[t] ? (unsigned)(row * 128 + (c - 16) * 16) : (unsigned)(row * 4096 + c * 16); }
#pragma unroll
    for (int t = 0; t < 2; ++t) { const int p = (wid * 2 + t) * 64 + lane, sub = p >> 5, w = p & 31, kk = (sub >> 2) * 8 + (w >> 2), c = (sub & 3) * 32 + (w & 3) * 8;
        const int k = (kk & ~0xC) | ((kk & 4) << 1) | ((kk & 8) >> 1); voff[t] = (unsigned)(k * 4096 + 256 + c * 2); }
#define GLDS(k0, slot) do { const char* kb_ = Kn + (size_t)(k0) * 4096; const char* rb_ = Kr + (size_t)(k0) * 128; LAS char* kd_ = lds + (slot) * SLOT + wid * 3072; LAS char* vd_ = lds + (slot) * SLOT + SHM_K + wid * 2048; \
    _Pragma("unroll") for (int t_ = 0; t_ < 3; ++t_) { const char* src_ = (krope[t_] ? rb_ : kb_) + koff[t_]; __builtin_amdgcn_global_load_lds((const unsigned*)src_, (LAS unsigned*)(kd_ + t_ * 1024), 16, 0, 0); } \
    _Pragma("unroll") for (int t_ = 0; t_ < 2; ++t_) __builtin_amdgcn_global_load_lds((const unsigned*)(kb_ + voff[t_]), (LAS unsigned*)(vd_ + t_ * 1024), 16, 0, 0); } while (0)
#define RESC(a) do { if (__any((a) < 1.f)) { if (hi == 0) al_l[r32] = (a); asm volatile("s_waitcnt lgkmcnt(0)" ::: "memory"); \
    _Pragma("unroll") for (int d = 0; d < 4; ++d) _Pragma("unroll") for (int r = 0; r < 16; ++r) o[d][r] *= al_l[crow(r, hi)]; } } while (0)
    f32x16 pA0, pA1, pB0, pB1; float mnA, mnB, alA, alB; bf16x8 pa0, pa1, pa2, pa3; constexpr int NT = SEQ / KVBLK;
    const int vrb = (int)(uintptr_t)lds + SHM_K + v_rd_base(lane);
    int s0 = 0, s1 = 1, s2 = 2;
    GLDS(0, 0); GLDS(KVBLK, 1);
    WAITBAR(5);
    qkt_l(pA0, pA1, lds, qr, r32, hi); partialSM(pA0, pA1, m_reg, mnA, alA);
    WAITBAR(2);
#pragma unroll 1
    for (int j = 0; j < NT; j += 2) {
        const bool more1 = j + 2 < NT;
        if (more1) GLDS((j + 2) * KVBLK, s2);
        SBAR(); qkt_l(pB0, pB1, lds + s1 * SLOT, qr, r32, hi);
        finishSM(pA0, pA1, alA, l_reg, pa0, pa1, pa2, pa3); SBAR();
        pv_d0(o, vrb + s0 * SLOT, pa0, pa1, pa2, pa3); partialSM(pB0, pB1, m_reg, mnB, alB);
        if (more1) WAITBAR(2); else WAITBAR(0);
        RESC(alB);
        { const int t_ = s0; s0 = s1; s1 = s2; s2 = t_; }
        const bool more2 = j + 3 < NT;
        if (more2) GLDS((j + 3) * KVBLK, s2);
        SBAR(); if (more1) qkt_l(pA0, pA1, lds + s1 * SLOT, qr, r32, hi);
        finishSM(pB0, pB1, alB, l_reg, pa0, pa1, pa2, pa3); SBAR();
        pv_d0(o, vrb + s0 * SLOT, pa0, pa1, pa2, pa3); if (more1) partialSM(pA0, pA1, m_reg, mnA, alA);
        if (more2) WAITBAR(2); else WAITBAR(0);
        if (more1) RESC(alA);
        { const int t_ = s0; s0 = s1; s1 = s2; s2 = t_; }
    }
    if (hi == 0) li_l[r32] = l_reg; asm volatile("s_waitcnt lgkmcnt(0)" ::: "memory");
    char* Ow = (char*)(O + (tokb + qb * 256 + wid * 32) * 1024 + h * 128);
    const unsigned oo = (unsigned)(4 * hi * 1024 + r32) * 2u;
#pragma unroll
    for (int r = 0; r < 16; ++r) { const float rl = __builtin_amdgcn_rcpf(li_l[crow(r, hi)]);
#pragma unroll
        for (int d0 = 0; d0 < 4; ++d0) { const unsigned w = cvt_pk_bf16(o[d0][r] * rl, 0.f); *(bf16*)(Ow + oo + (unsigned)((((r & 3) + 8 * (r >> 2)) * 1024 + d0 * 32) * 2)) = (bf16)(w & 0xffffu); } }
    WAITBAR(0);
#undef GLDS
#undef RESC
}
constexpr int F8_SK = 64 * 192, F8_SV = 128 * 64, F8_SLOT = F8_SK + F8_SV;
typedef int v8i32 __attribute__((ext_vector_type(8)));
__device__ __forceinline__ v8i32 ld32(const LAS char* p0, const LAS char* p1) { const u32x4 a = *(const LAS u32x4*)p0, b = *(const LAS u32x4*)p1; return (v8i32){(int)a.x, (int)a.y, (int)a.z, (int)a.w, (int)b.x, (int)b.y, (int)b.z, (int)b.w}; }
__device__ __forceinline__ void attn_unit_f8(const int tid, const unsigned char* Q8, const unsigned char* KN8, const unsigned char* KR8, const unsigned char* VT8, unsigned char* O, int b, int h, int qb, LAS char* lds) {
    const int wid = __builtin_amdgcn_readfirstlane(tid >> 6), lane = tid & 63, r32 = lane & 31, hi = lane >> 5;
    LAS float* wsc = (LAS float*)(lds + 6 * F8_SLOT) + wid * 64; LAS float* al_l = wsc + 32;
    constexpr float TAU = 1.0f;
    f32x16 o[4] = {}, osum = {}, minit = {}; v8i32 qr[3];
    LAS char* const onep = lds + 6 * F8_SLOT + 2048;
    if (tid < 4) ((LAS unsigned*)onep)[tid] = 0x38383838u;
    const size_t tokb = (size_t)b * SEQ;
    { const unsigned char* Qw = Q8 + (tokb + qb * 256 + wid * 32) * 1536 + h * 192; const unsigned qo = (unsigned)(r32 * 1536 + hi * 32);
#pragma unroll
      for (int st = 0; st < 3; ++st) { const u32x4 x = *(const u32x4*)(Qw + qo + st * 64), y = *(const u32x4*)(Qw + qo + st * 64 + 16); qr[st] = (v8i32){(int)x.x, (int)x.y, (int)x.z, (int)x.w, (int)y.x, (int)y.y, (int)y.z, (int)y.w}; } }
    const unsigned char* Knb = KN8 + tokb * 1024 + h * 128; const unsigned char* Krb = KR8 + tokb * 64; const unsigned char* Vtb = VT8 + (size_t)(b * 8 + h) * 128 * SEQ;
    unsigned koff[3], voff; bool krope[3]; int kdst[3];
#pragma unroll
    for (int t = 0; t < 3; ++t) { const int q = wid + 8 * t, tl = q / 12, pc = q % 12, p = pc * 64 + lane, row = p / 12, cp = p % 12, c = (cp & ~3) | ((cp ^ (row >> 2)) & 3);
        krope[t] = c >= 8; koff[t] = krope[t] ? (unsigned)((tl * 64 + row) * 64 + (c - 8) * 16) : (unsigned)((tl * 64 + row) * 1024 + c * 16); kdst[t] = tl * F8_SLOT + pc * 1024; }
    { const int p = wid * 64 + lane, d = p >> 2, cp = p & 3, c = cp ^ ((d >> 2) & 3); voff = (unsigned)(d * SEQ + c * 16); }
#define GLDS8(k0, slot) do { const unsigned char* kb_ = Knb + (size_t)(k0) * 1024; const unsigned char* rb_ = Krb + (size_t)(k0) * 64; LAS char* kd_ = lds + (slot) * (2 * F8_SLOT); \
    _Pragma("unroll") for (int t_ = 0; t_ < 3; ++t_) { const unsigned char* s_ = (krope[t_] ? rb_ : kb_) + koff[t_]; __builtin_amdgcn_global_load_lds((const unsigned*)s_, (LAS unsigned*)(kd_ + kdst[t_]), 16, 0, 0); } \
    _Pragma("unroll") for (int t_ = 0; t_ < 2; ++t_) __builtin_amdgcn_global_load_lds((const unsigned*)(Vtb + (k0) + t_ * 64 + voff), (LAS unsigned*)(kd_ + t_ * F8_SLOT + F8_SK + wid * 1024), 16, 0, 0); } while (0)
    const int krow = 16 * ((r32 >> 2) & 1) + 4 * (r32 >> 3) + (r32 & 3), kx = (krow >> 2) & 3;
    const int ka0 = krow * 192 + 16 * ((2 * hi) ^ kx), ka1 = krow * 192 + 16 * ((2 * hi + 1) ^ kx);
    const int vx = (r32 >> 2) & 3, va0 = F8_SK + r32 * 64 + 16 * (hi ^ vx), va1 = F8_SK + r32 * 64 + 16 * ((2 + hi) ^ vx);
#define QKT8(P0, P1, Ks) do { _Pragma("unroll") for (int st = 0; st < 3; ++st) { \
        const v8i32 k0_ = ld32((Ks) + ka0 + st * 64, (Ks) + ka1 + st * 64), k1_ = ld32((Ks) + ka0 + st * 64 + 32 * 192, (Ks) + ka1 + st * 64 + 32 * 192); \
        P0 = __builtin_amdgcn_mfma_scale_f32_32x32x64_f8f6f4(k0_, qr[st], st == 0 ? minit : P0, 0, 0, 0, 0, 0, 0); P1 = __builtin_amdgcn_mfma_scale_f32_32x32x64_f8f6f4(k1_, qr[st], st == 0 ? minit : P1, 0, 0, 0, 0, 0, 0); } } while (0)
#define PV8_LOAD(Vs) do { vfr[0] = ld32((Vs) + va0, (Vs) + va1); } while (0)
#define PV8_MMA(Vs) do { const v8i32 v1_ = ld32((Vs) + va0 + 1 * 2048, (Vs) + va1 + 1 * 2048), v2_ = ld32((Vs) + va0 + 2 * 2048, (Vs) + va1 + 2 * 2048), v3_ = ld32((Vs) + va0 + 3 * 2048, (Vs) + va1 + 3 * 2048); \
        o[0] = __builtin_amdgcn_mfma_scale_f32_32x32x64_f8f6f4(pa, vfr[0], o[0], 0, 0, 0, 0, 0, 0); o[1] = __builtin_amdgcn_mfma_scale_f32_32x32x64_f8f6f4(pa, v1_, o[1], 0, 0, 0, 0, 0, 0); \
        o[2] = __builtin_amdgcn_mfma_scale_f32_32x32x64_f8f6f4(pa, v2_, o[2], 0, 0, 0, 0, 0, 0); o[3] = __builtin_amdgcn_mfma_scale_f32_32x32x64_f8f6f4(pa, v3_, o[3], 0, 0, 0, 0, 0, 0); \
        osum = __builtin_amdgcn_mfma_scale_f32_32x32x64_f8f6f4(pa, ld32(onep, onep), osum, 0, 0, 0, 0, 0, 0); } while (0)
#define PSM8(P0, P1, PM) do { float pm_ = P0[0]; _Pragma("unroll") for (int r = 1; r < 16; ++r) pm_ = fmaxf(pm_, P0[r]); _Pragma("unroll") for (int r = 0; r < 16; ++r) pm_ = fmaxf(pm_, P1[r]); \
        { auto rr_ = __builtin_amdgcn_permlane32_swap(__float_as_uint(pm_), __float_as_uint(pm_), false, false); PM = fmaxf(__uint_as_float(rr_[0]), __uint_as_float(rr_[1])); } \
        _Pragma("unroll") for (int r = 0; r < 16; ++r) P0[r] = __builtin_amdgcn_exp2f(P0[r]); } while (0)
#define PSM8_FIRST(P0, P1) do { float pm_ = P0[0]; _Pragma("unroll") for (int r = 1; r < 16; ++r) pm_ = fmaxf(pm_, P0[r]); _Pragma("unroll") for (int r = 0; r < 16; ++r) pm_ = fmaxf(pm_, P1[r]); \
        { auto rr_ = __builtin_amdgcn_permlane32_swap(__float_as_uint(pm_), __float_as_uint(pm_), false, false); pm_ = fmaxf(__uint_as_float(rr_[0]), __uint_as_float(rr_[1])); } \
        const float dl_ = pm_ - 7.0f; _Pragma("unroll") for (int r = 0; r < 16; ++r) { P0[r] = __builtin_amdgcn_exp2f(P0[r] - dl_); P1[r] -= dl_; minit[r] = -dl_; } } while (0)
#define FSM8(P0, P1) do { _Pragma("unroll") for (int r = 0; r < 16; ++r) P1[r] = __builtin_amdgcn_exp2f(P1[r]); \
        pa = (v8i32){(int)pk_fp8x4(P0[0], P0[1], P0[2], P0[3]), (int)pk_fp8x4(P0[4], P0[5], P0[6], P0[7]), (int)pk_fp8x4(P0[8], P0[9], P0[10], P0[11]), (int)pk_fp8x4(P0[12], P0[13], P0[14], P0[15]), \
                     (int)pk_fp8x4(P1[0], P1[1], P1[2], P1[3]), (int)pk_fp8x4(P1[4], P1[5], P1[6], P1[7]), (int)pk_fp8x4(P1[8], P1[9], P1[10], P1[11]), (int)pk_fp8x4(P1[12], P1[13], P1[14], P1[15])}; } while (0)
#define RESC(P0, P1, PM) do { if (__any((PM) > 7.0f + TAU)) { const float dl_ = (PM) > 7.0f + TAU ? (PM) - 7.0f : 0.f, a_ = __builtin_amdgcn_exp2f(-dl_); \
    if (hi == 0) al_l[r32] = a_; \
    _Pragma("unroll") for (int r = 0; r < 16; ++r) { P0[r] *= a_; P1[r] -= dl_; minit[r] -= dl_; } \
    asm volatile("s_waitcnt lgkmcnt(0)" ::: "memory"); \
    _Pragma("unroll") for (int r = 0; r < 16; ++r) { const float f_ = al_l[crow(r, hi)]; osum[r] *= f_; _Pragma("unroll") for (int d = 0; d < 4; ++d) o[d][r] *= f_; } } } while (0)
#define SGB_QK() do { _Pragma("unroll") for (int i_ = 0; i_ < 6; ++i_) { __builtin_amdgcn_sched_group_barrier(0x100, 2, 0); __builtin_amdgcn_sched_group_barrier(0x008, 1, 0); __builtin_amdgcn_sched_group_barrier(0x402, 12, 0); } } while (0)
#define SGB_PV() do { _Pragma("unroll") for (int i_ = 0; i_ < 4; ++i_) { __builtin_amdgcn_sched_group_barrier(0x100, 2, 0); __builtin_amdgcn_sched_group_barrier(0x008, 1, 0); __builtin_amdgcn_sched_group_barrier(0x402, 26, 0); } } while (0)
    f32x16 pA0, pA1, pB0, pB1; float pmA, pmB; v8i32 pa, vfr[1]; constexpr int NT = SEQ / KVBLK;
    int s0 = 0, s1 = 1, s2 = 2;
    GLDS8(0, 0); GLDS8(2 * KVBLK, 1);
    WAITBAR(5);
    QKT8(pA0, pA1, lds); PSM8_FIRST(pA0, pA1);
    WAITBAR(2);
#pragma unroll 1
    for (int j = 0; j < NT; j += 2) {
        const bool more = j + 4 < NT;
        if (more) GLDS8((j + 4) * KVBLK, s2);
        LAS char* const t0 = lds + s0 * (2 * F8_SLOT); LAS char* const t1 = t0 + F8_SLOT; LAS char* const t2 = lds + s1 * (2 * F8_SLOT);
        SBAR(); PV8_LOAD(t0); QKT8(pB0, pB1, t1);
        FSM8(pA0, pA1); SBAR();
        PV8_MMA(t0); PSM8(pB0, pB1, pmB); SBAR();
        RESC(pB0, pB1, pmB);
        SBAR(); PV8_LOAD(t1); QKT8(pA0, pA1, t2);
        FSM8(pB0, pB1); SBAR();
        PV8_MMA(t1); PSM8(pA0, pA1, pmA); SBAR();
        if (more) WAITBAR(2); else WAITBAR(0);
        if (j + 2 < NT) RESC(pA0, pA1, pmA);
        { const int t_ = s0; s0 = s1; s1 = s2; s2 = t_; }
    }
    unsigned char* Ow = O + (tokb + qb * 256 + wid * 32) * 1024 + h * 128;
    const unsigned oo = (unsigned)(4 * hi * 1024 + r32);
#pragma unroll
    for (int r = 0; r < 16; ++r) { const float rl = __builtin_amdgcn_rcpf(osum[r] * ATT8_SCALE) * O8_SCALE;
        const unsigned w = pk_fp8x4(o[0][r] * rl, o[1][r] * rl, o[2][r] * rl, o[3][r] * rl);
#pragma unroll
        for (int d0 = 0; d0 < 4; ++d0) Ow[oo + (unsigned)(((r & 3) + 8 * (r >> 2)) * 1024 + d0 * 32)] = (unsigned char)(w >> (8 * d0)); }
    WAITBAR(0);
#undef GLDS8
#undef QKT8
#undef PV8_LOAD
#undef PV8_MMA
#undef PSM8
#undef PSM8_FIRST
#undef FSM8
#undef RESC
}
}

namespace watt {
constexpr float C2 = 1.4426950408889634f;
constexpr int WLDS = 16384 + 256;
__device__ __forceinline__ void unit(const bf16* QKV, bf16* OG, float* LSE, int g, int b, int r, int h, int qb, LAS char* wl, int lane) {
    const int r32 = lane & 31, hi = lane >> 5, sh = 2 * g, L = SEQ >> sh, l0 = qb * 64;
    LAS float* scr = (LAS float*)(wl + 16384);
    const size_t tokb = (size_t)b * SEQ + r;
    const char* base = (const char*)QKV + (size_t)(((g * 3) * 8 + h) * 64) * 2;
    bf16x8 qf[2][4];
#pragma unroll
    for (int qs = 0; qs < 2; ++qs) { const char* p = base + (tokb + ((size_t)(l0 + 32 * qs + r32) << sh)) * 9216 + hi * 16;
#pragma unroll
        for (int d0 = 0; d0 < 4; ++d0) qf[qs][d0] = *reinterpret_cast<const bf16x8*>(p + d0 * 32); }
    f32x16 o[2][2] = {}; float m[2] = {-1e30f, -1e30f}, l[2] = {0.f, 0.f};
    const int vb = (int)(uintptr_t)wl + mla::v_rd_base(lane);
#pragma unroll
    for (int tt = 0; tt < 3; ++tt) {
        const int t = tt == 0 ? 1 : (tt == 1 ? 0 : 2);
        const int lk0 = l0 - 64 + 64 * t;
        bf16x8 kf[2][4];
#pragma unroll
        for (int half = 0; half < 2; ++half) { int lk = lk0 + 32 * half + r32; lk = lk < 0 ? 0 : (lk >= L ? L - 1 : lk);
            const char* p = base + 1024 + (tokb + ((size_t)lk << sh)) * 9216 + hi * 16;
#pragma unroll
            for (int d0 = 0; d0 < 4; ++d0) kf[half][d0] = *reinterpret_cast<const bf16x8*>(p + d0 * 32); }
        bf16x8 vs[8];
#pragma unroll
        for (int i = 0; i < 8; ++i) { int lk = lk0 + i * 8 + (lane >> 3); lk = lk < 0 ? 0 : (lk >= L ? L - 1 : lk);
            vs[i] = *reinterpret_cast<const bf16x8*>(base + 2048 + (tokb + ((size_t)lk << sh)) * 9216 + (lane & 7) * 16); }
#pragma unroll
        for (int i = 0; i < 8; ++i) *(LAS bf16x8*)(wl + mla::v_st(i * 8 + (lane >> 3), (lane & 7) * 8)) = vs[i];
#pragma unroll
        for (int qs = 0; qs < 2; ++qs) {
            f32x16 p0 = {}, p1 = {};
#pragma unroll
            for (int d0 = 0; d0 < 4; ++d0) { p0 = __builtin_amdgcn_mfma_f32_32x32x16_bf16(kf[0][d0], qf[qs][d0], p0, 0, 0, 0); p1 = __builtin_amdgcn_mfma_f32_32x32x16_bf16(kf[1][d0], qf[qs][d0], p1, 0, 0, 0); }
            const int lq = l0 + 32 * qs + r32; float pmax = -INFINITY;
#pragma unroll
            for (int rr = 0; rr < 16; ++rr) { const int k0 = lk0 + mla::crow(rr, hi), k1 = k0 + 32;
                const bool v0 = (k0 >= 0) && (k0 < L) && (k0 - lq <= 64) && (lq - k0 <= 64), v1 = (k1 >= 0) && (k1 < L) && (k1 - lq <= 64) && (lq - k1 <= 64);
                p0[rr] = v0 ? p0[rr] : -INFINITY; p1[rr] = v1 ? p1[rr] : -INFINITY; pmax = fmaxf(pmax, fmaxf(p0[rr], p1[rr])); }
            { auto sw = __builtin_amdgcn_permlane32_swap(__float_as_uint(pmax), __float_as_uint(pmax), false, false); pmax = fmaxf(__uint_as_float(sw[0]), __uint_as_float(sw[1])); }
            const float mn = fmaxf(m[qs], pmax), alpha = __builtin_amdgcn_exp2f((m[qs] - mn) * C2), mnC = -mn * C2; m[qs] = mn;
            float ps = 0.f;
#pragma unroll
            for (int rr = 0; rr < 16; ++rr) { p0[rr] = __builtin_amdgcn_exp2f(fmaf(p0[rr], C2, mnC)); p1[rr] = __builtin_amdgcn_exp2f(fmaf(p1[rr], C2, mnC)); ps += p0[rr] + p1[rr]; }
            { auto sw = __builtin_amdgcn_permlane32_swap(__float_as_uint(ps), __float_as_uint(ps), false, false); ps = __uint_as_float(sw[0]) + __uint_as_float(sw[1]); }
            l[qs] = l[qs] * alpha + ps;
            bf16x8 pa0, pa1, pa2, pa3;
#define PK4(P, BASE, OUT) do { unsigned a0 = cvt_pk_bf16(P[BASE + 0], P[BASE + 1]), a1 = cvt_pk_bf16(P[BASE + 2], P[BASE + 3]);   \
    unsigned b0 = cvt_pk_bf16(P[BASE + 4], P[BASE + 5]), b1 = cvt_pk_bf16(P[BASE + 6], P[BASE + 7]);                              \
    auto r0 = __builtin_amdgcn_permlane32_swap(a0, b0, false, false); auto r1 = __builtin_amdgcn_permlane32_swap(a1, b1, false, false); \
    u32x4 w = {r0[0], r1[0], r0[1], r1[1]}; OUT = *reinterpret_cast<bf16x8*>(&w); } while (0)
            PK4(p0, 0, pa0); PK4(p0, 8, pa1); PK4(p1, 0, pa2); PK4(p1, 8, pa3);
#undef PK4
            if (tt > 0) { if (__any(alpha < 1.f)) { if (hi == 0) scr[r32] = alpha; asm volatile("s_waitcnt lgkmcnt(0)" ::: "memory");
#pragma unroll
                for (int d = 0; d < 2; ++d)
#pragma unroll
                    for (int rr = 0; rr < 16; ++rr) o[qs][d][rr] *= scr[mla::crow(rr, hi)]; } }
            mla::pv_one<0>(o[qs][0], vb, pa0, pa1, pa2, pa3); mla::pv_one<1>(o[qs][1], vb, pa0, pa1, pa2, pa3);
        }
    }
#pragma unroll
    for (int qs = 0; qs < 2; ++qs) {
        if (hi == 0) { scr[r32] = l[qs]; LSE[((size_t)g * NTOK + tokb + ((size_t)(l0 + 32 * qs + r32) << sh)) * 8 + h] = m[qs] + __logf(l[qs]); }
        asm volatile("s_waitcnt lgkmcnt(0)" ::: "memory");
#pragma unroll
        for (int rr = 0; rr < 16; ++rr) { const int qi = mla::crow(rr, hi); const float rl = __builtin_amdgcn_rcpf(scr[qi]);
            bf16* op = OG + ((size_t)g * NTOK + tokb + ((size_t)(l0 + 32 * qs + qi) << sh)) * 512 + h * 64 + r32;
#pragma unroll
            for (int d = 0; d < 2; ++d) { const unsigned w = cvt_pk_bf16(o[qs][d][rr] * rl, 0.f); op[d * 32] = (bf16)(w & 0xffffu); } }
        asm volatile("s_waitcnt lgkmcnt(0)" ::: "memory");
    }
}
}
__device__ __forceinline__ void watt_phase(const Ctx& C) {
    const bf16* QKV = (const bf16*)(C.ws + AR_QKV); bf16* OG = (bf16*)(C.ws + AR_OG); float* LSE = (float*)(C.ws + AR_LSE);
    LAS char* wl = (LAS char*)C.lds + C.wave * watt::WLDS;
    for (int u = C.bx * NWAVES + C.wave; u < 12288; u += C.G * NWAVES) {
        const int g = u >> 12, v = u & 4095, sh = 2 * g, nqb = 128 >> sh, qb = v & (nqb - 1), w2 = v >> (7 - sh), h = w2 & 7, w3 = w2 >> 3, r = w3 & ((1 << sh) - 1), b = w3 >> sh;
        watt::unit(QKV, OG, LSE, g, b, r, h, qb, wl, C.lane);
    }
}
__device__ __forceinline__ void watt_combine(const Ctx& C) {
    const bf16* OG = (const bf16*)(C.ws + AR_OG); const float* LSE = (const float*)(C.ws + AR_LSE); unsigned char* O = C.ws + AR_OD;
    for (int it0 = C.bx * NTHR + C.tid; it0 < NTOK * 64; it0 += 4 * C.G * NTHR) {
      float lq[4][3]; u32x4 oq[4][3];
#pragma unroll
      for (int q = 0; q < 4; ++q) { const int it = it0 + q * C.G * NTHR, tok = it >> 6, c = it & 63, h = c >> 3;
#pragma unroll
          for (int g = 0; g < 3; ++g) { lq[q][g] = LSE[((size_t)g * NTOK + tok) * 8 + h]; oq[q][g] = *(const u32x4*)(OG + ((size_t)g * NTOK + tok) * 512 + c * 8); } }
#pragma unroll
      for (int q = 0; q < 4; ++q) {
        const int it = it0 + q * C.G * NTHR, tok = it >> 6, c = it & 63;
        const float l0 = lq[q][0], l1 = lq[q][1], l2 = lq[q][2];
        const float mx = fmaxf(l0, fmaxf(l1, l2)); float w0 = __expf(l0 - mx), w1 = __expf(l1 - mx), w2 = __expf(l2 - mx); const float inv = 1.0f / (w0 + w1 + w2); w0 *= inv; w1 *= inv; w2 *= inv;
        const u32x4 a = oq[q][0], bq = oq[q][1], cq = oq[q][2];
        w0 *= OD8_SCALE; w1 *= OD8_SCALE; w2 *= OD8_SCALE;
        float e[8];
#pragma unroll
        for (int j = 0; j < 4; ++j) { e[2 * j] = w0 * bflo(a[j]) + w1 * bflo(bq[j]) + w2 * bflo(cq[j]); e[2 * j + 1] = w0 * bfhi(a[j]) + w1 * bfhi(bq[j]) + w2 * bfhi(cq[j]); }
        *(u32x2*)(O + (size_t)tok * 512 + c * 8) = (u32x2){pk_fp8x4(e[0], e[1], e[2], e[3]), pk_fp8x4(e[4], e[5], e[6], e[7])};
      }
    }
}

constexpr int N_PHASES = 64;
constexpr int PP_SPLIT = 100;
__global__ void __launch_bounds__(NTHR, 2) fwd_kernel(Args args) {
    extern __shared__ __attribute__((aligned(16))) unsigned char lds_raw[];
    volatile LAS unsigned* MISC = (volatile LAS unsigned*)((LAS unsigned char*)lds_raw + LDS_MISC);
    if (threadIdx.x < 64) MISC[threadIdx.x] = 0u;
    if (threadIdx.x == 0) {
#pragma unroll
        for (int i = 0; i < 30; ++i) *(LAS unsigned long long*)((LAS unsigned char*)lds_raw + LDS_PTRS + 8 * i) = (unsigned long long)args.in[i];
    }
    __syncthreads();
    XcdBarrier bar = xcd_barrier_post((unsigned*)(args.ws + WS_CTL) + CW_BAR, MISC + 8);
    const int lo = args.ph_lo, hi = args.ph_hi; int ph = 0;
    const int wave_s = __builtin_amdgcn_readfirstlane(threadIdx.x >> 6);
#define FRESH_CTX Ctx C; { unsigned on_ = ~0u; asm volatile("" : "+s"(on_)); int t_ = wave_s * 64 + (int)__builtin_amdgcn_mbcnt_hi(on_, __builtin_amdgcn_mbcnt_lo(on_, 0u)), bx_ = blockIdx.x, g_ = gridDim.x; unsigned char* ws_ = args.ws; float* out_ = args.out; \
        asm volatile("" : "+v"(t_)); asm volatile("" : "+s"(bx_), "+s"(g_), "+s"(ws_), "+s"(out_)); \
        C.lds = (LAS unsigned char*)lds_raw; C.ws = ws_; C.in.lds = C.lds; C.out = out_; C.tid = t_; C.lane = t_ & 63; C.wave = __builtin_amdgcn_readfirstlane(t_ >> 6); C.G = g_; C.bx = bx_; } \
        unsigned char* ws = C.ws; LAS unsigned char* lds = C.lds; const float* SSQ = (const float*)(ws + WS_SSQ); bf16* H = (bf16*)(ws + WS_HB); const bf16* HB = (const bf16*)(ws + WS_HB); \
        const float* ct = (const float*)(ws + WS_COS); const float* st = (const float*)(ws + WS_SIN); (void)SSQ; (void)H; (void)HB; (void)ct; (void)st; (void)lds;
#ifndef PROBE_MASK
#define PROBE_MASK 0ull
#endif
#ifndef PROBE_DRY
#define PROBE_DRY 0ull
#endif
#define PHASE_BEGIN if (lo <= ph && ph < hi) { const int nrep_ = (((PROBE_MASK | PROBE_DRY) >> ph) & 1ull) ? 2 : 1; for (int rep_ = 0; rep_ < nrep_; ++rep_) { const float DRYS = (((PROBE_DRY >> ph) & 1ull) && rep_ == 0) ? 0.0f : 1.0f; (void)DRYS; FRESH_CTX
#define PHASE_END   } if (ph + 1 < hi) { unsigned on_ = ~0u; asm volatile("" : "+s"(on_)); xcd_barrier(bar, wave_s * 64 + (int)__builtin_amdgcn_mbcnt_hi(on_, __builtin_amdgcn_mbcnt_lo(on_, 0u))); } } ++ph;
#define DENSE(name, Aptr, Btptr, Kv, ldav, ldbv, nMv, nNv, nbv, abs_, bbs_) pg8::DenseSched name{Aptr, Btptr, Kv, ldav, ldbv, pg8::TileOrder{nMv, nNv, nbv, C.G, C.bx}, abs_, bbs_}

    PHASE_BEGIN prologue(C); PHASE_END

    PHASE_BEGIN
        DENSE(S, HB, (const bf16*)(ws + WA_T), 1024, 1024, 1024, NTOK / 256, 3, 1, 0, 0);
        EpiMlaA E{SSQ, (bf16*)(ws + AR_CQ), (bf16*)(ws + AR_CKV), (bf16*)(ws + AR_KR), (float*)(ws + AR_SSQQ), (float*)(ws + AR_SSQKV), ct, st};
        pg8::gemm_phase<EpiMlaA, pg8::DenseSched, true>(lds, C.tid, S, E);
        if (C.G == 256 && C.bx >= 128) { __syncthreads(); moe_weight_prep(C, 0, 8192, 1 << 30, (C.bx - 128) * NWAVES + C.wave, 128 * NWAVES); __syncthreads(); }
    PHASE_END
    PHASE_BEGIN
        { DENSE(S, (const bf16*)(ws + AR_CQ), (const bf16*)(ws + WUQ_T), 384, 384, 384, NTOK / 256, 6, 1, 0, 0);
          EpiMlaQ E{(const float*)(ws + AR_SSQQ), (bf16*)(ws + AR_Q), ct, st};
          pg8::gemm_phase<EpiMlaQ, pg8::DenseSched, true>(lds, C.tid, S, E); }
        { FRESH_CTX MlaKnSched S{(const bf16*)(ws + AR_CKV), (const bf16*)(ws + WUKV_T), 256, 256, C.G, C.bx};
          EpiMlaKN E{(const float*)(ws + AR_SSQKV), ws + AR_KN};
          pg8::gemm_phase<EpiMlaKN, MlaKnSched, true>(lds, C.tid, S, E); }
        { FRESH_CTX MlaVtSched S{(const bf16*)(ws + WUKV_T), (const bf16*)(ws + AR_CKV), 256, 256, C.G, C.bx};
          EpiMlaVT E{(const float*)(ws + AR_SSQKV), ws + AR_VT};
          pg8::gemm_phase<EpiMlaVT, MlaVtSched, true>(lds, C.tid, S, E); }
    PHASE_END
    PHASE_BEGIN
        for (int i = 0; ; ++i) { const int bh = i * 8 + (C.bx & 7), qb = C.bx >> 3; if (bh >= 32 || C.G != 256) break;
            mla::attn_unit_f8(C.tid, ws + AR_Q, ws + AR_KN, ws + AR_KR, ws + AR_VT, ws + AR_O, bh >> 3, bh & 7, qb, (LAS char*)lds); }
    PHASE_END
    PHASE_BEGIN
        pg8::DenseSched8 S{ws + AR_O, ws + WOM_T, 1024, 1024, 1024, pg8::TileOrder{NTOK / 256, 4, 1, C.G, C.bx}};
        EpiResidual E{H, nullptr, DRYS / (O8_SCALE * W8_SCALE)};
        pg8::gemm_phase<EpiResidual, pg8::DenseSched8, true, true>(lds, C.tid, S, E);
    PHASE_END

#pragma unroll 1
    for (int layer = 0; layer < DEPTH; ++layer) {
        if (layer == 1) {
            PHASE_BEGIN
                FnetTSched S{(const bf16*)(ws + FCH_T), HB, 256, 1024, C.G, C.bx};
                EpiFnetT E{SSQ, (bf16*)(ws + AR_TT)};
                pg8::gemm_phase<EpiFnetT, FnetTSched, true>(lds, C.tid, S, E);
            PHASE_END
            PHASE_BEGIN
                FnetConstASched S{(const bf16*)(ws + FW1_T), (const bf16*)(ws + AR_TT), 256, 256, 1024, C.G, C.bx};
                EpiFnet1 E{(bf16*)(ws + AR_Z), (const float*)(ws + FTWC), (const float*)(ws + FTWS)};
                pg8::gemm_phase<EpiFnet1, FnetConstASched, true>(lds, C.tid, S, E);
            PHASE_END
            PHASE_BEGIN
                FnetConstASched S{(const bf16*)(ws + FW2_T), (const bf16*)(ws + AR_Z), 128, 128, 2048, C.G, C.bx};
                EpiFnet2 E{ws + AR_F, 6.905339660024878e-4f * FN8_SCALE};
                pg8::gemm_phase<EpiFnet2, FnetConstASched, true>(lds, C.tid, S, E);
            PHASE_END
            PHASE_BEGIN
                pg8::DenseSched8 S{ws + AR_F, ws + WOF_T, 1024, 1024, 1024, pg8::TileOrder{NTOK / 256, 4, 1, C.G, C.bx}};
                EpiResidual E{H, C.in[I_FN_BO], DRYS / (FN8_SCALE * W8_SCALE), DRYS};
                pg8::gemm_phase<EpiResidual, pg8::DenseSched8, true, true>(lds, C.tid, S, E);
            PHASE_END
        } else if (layer == 2) {
            PHASE_BEGIN
                pg8::DenseSched8 S{ws + WS_H8, ws + WIN_T, 1024, 1024, 1024, pg8::TileOrder{NTOK / 256, 16, 1, C.G, C.bx}};
                EpiGmlpIn E{SSQ, (bf16*)(ws + AR_U), (bf16*)(ws + AR_V), (float*)(ws + AR_SSQV), 1.0f / (XN8_SCALE * W8_SCALE)};
                pg8::gemm_phase<EpiGmlpIn, pg8::DenseSched8, true, true>(lds, C.tid, S, E);
            PHASE_END
            PHASE_BEGIN spatial_phase(C); PHASE_END
            PHASE_BEGIN
                pg8::DenseSched8 S{ws + AR_G, ws + WOG_T, 2048, 2048, 2048, pg8::TileOrder{NTOK / 256, 4, 1, C.G, C.bx}};
                EpiResidual E{H, nullptr, DRYS / (G8_SCALE * W8_SCALE)};
                pg8::gemm_phase<EpiResidual, pg8::DenseSched8, true, true>(lds, C.tid, S, E);
            PHASE_END
        } else if (layer == 3) {
            PHASE_BEGIN
                pg8::DenseSched8 S{ws + WS_H8, ws + WQKV_T, 1024, 1024, 1024, pg8::TileOrder{NTOK / 256, 18, 1, C.G, C.bx}};
                EpiDilQkv E{SSQ, (bf16*)(ws + AR_QKV), ct, st, 1.0f / (XN8_SCALE * W8_SCALE)};
                pg8::gemm_phase<EpiDilQkv, pg8::DenseSched8, true, true>(lds, C.tid, S, E);
            PHASE_END
            PHASE_BEGIN watt_phase(C); PHASE_END
            PHASE_BEGIN watt_combine(C); PHASE_END
            PHASE_BEGIN
                pg8::DenseSched8 S{ws + AR_OD, ws + WOD_T, 512, 512, 512, pg8::TileOrder{NTOK / 256, 4, 1, C.G, C.bx}};
                EpiResidual E{H, nullptr, DRYS / (OD8_SCALE * W8_SCALE)};
                pg8::gemm_phase<EpiResidual, pg8::DenseSched8, true, true>(lds, C.tid, S, E);
            PHASE_END
        }
        PHASE_BEGIN
            if (layer > 0) { moe_weight_prep(C, layer); __syncthreads(); }
            router_phase(C, layer);
        PHASE_END
        PHASE_BEGIN
            moe_tables(C, layer);
            const LAS int* T = (const LAS int*)(lds + LDS_TAB);
            MoeSched1 S{ws + WS_XN, ws + WS_MOEW1, (const u32x2*)(ws + WS_LIST), T, 1024, 1024, C.G, C.bx};
            EpiMoe1 E{ws + AR_HBUF, T};
            pg8::gemm_phase<EpiMoe1, MoeSched1, true, true>(lds, C.tid, S, E);
#define PP_TAIL(RT0, NRT) { FRESH_CTX const int U1 = __builtin_amdgcn_readfirstlane(((const LAS int*)(lds + LDS_TAB))[64]) * 4, rem = U1 % C.G; int nl = C.G - rem, li = C.bx - rem; if (2 * nl < C.G) { nl = C.G; li = C.bx; } \
              if (li >= 0) { pg8::DenseSched S2{(const bf16*)(ws + WS_PB) + ((size_t)layer * NTOK + (size_t)(RT0) * 256) * 256, (const bf16*)(ws + WP_T) + (size_t)layer * 1024 * 256, 256, 256, 256, pg8::TileOrder{(NRT), 4, 1, nl, li}, 0, 0}; \
                EpiStoreBf16 E2{(bf16*)(ws + WS_PP) + (size_t)(RT0) * 256 * 1024, 1024, 1.0f, 0}; \
                pg8::gemm_phase<EpiStoreBf16, pg8::DenseSched, true>(lds, C.tid, S2, E2); } }
            PP_TAIL(0, PP_SPLIT)
        PHASE_END
        PHASE_BEGIN
            moe_tables(C, layer);
            const LAS int* T = (const LAS int*)(lds + LDS_TAB);
            MoeSched2 S{ws + AR_HBUF, ws + WS_MOEW2, T, 512, 512, C.G, C.bx};
            EpiMoe2 E{(bf16*)(ws + AR_YB), (const u32x2*)(ws + WS_LIST), T};
            pg8::gemm_phase<EpiMoe2, MoeSched2, true, true>(lds, C.tid, S, E);
            PP_TAIL(PP_SPLIT, NTOK / 256 - PP_SPLIT)
        PHASE_END
        PHASE_BEGIN combine_phase(C, C.in[I_PLE_NORM] + layer * 1024, DRYS); PHASE_END
        PHASE_BEGIN
            pg8::DenseSched8 S{ws + WS_XN, ws + WG_T + (size_t)layer * 1024 * 1024, 1024, 1024, 1024, pg8::TileOrder{NTOK / 256, 4, 1, C.G, C.bx}};
            EpiPle E{H, (const bf16*)(ws + WS_PP), (float*)(ws + WS_SSQ), DRYS, (layer == 1 || layer == 2) ? ws + WS_H8 : nullptr, -1.4426950408889634f / (XN8_SCALE * W8_SCALE)};
            pg8::gemm_phase<EpiPle, pg8::DenseSched8, true, true>(lds, C.tid, S, E);
        PHASE_END
    }
    PHASE_BEGIN final_phase(C); PHASE_END
}

#ifndef MK_SPLIT
#define MK_SPLIT 0
#endif
extern "C" void kernel_launch(void* const* d_in, const int* in_sizes, int n_in, void* d_out, int out_size, void* d_ws, size_t ws_size, hipStream_t stream) {
    static int grid = 0;
    if (grid == 0) {
        if (n_in != 30 || in_sizes[0] != NTOK * DM || out_size != NTOK * DM || ws_size < WS_END) { fprintf(stderr, "kernel_launch: shape/workspace mismatch (n_in %d, ws %zu, need %zu)\n", n_in, ws_size, (size_t)WS_END); grid = -1; return; }
        int dev = 0, cus = 0;
        if (hipGetDevice(&dev) != hipSuccess || hipDeviceGetAttribute(&cus, hipDeviceAttributeMultiprocessorCount, dev) != hipSuccess) { grid = -1; return; }
        if (hipFuncSetAttribute((const void*)fwd_kernel, hipFuncAttributeMaxDynamicSharedMemorySize, LDS_BYTES) != hipSuccess) { grid = -1; return; }
        int per_cu = 0;
        if (hipOccupancyMaxActiveBlocksPerMultiprocessor(&per_cu, (const void*)fwd_kernel, NTHR, LDS_BYTES) != hipSuccess || per_cu < 1) fprintf(stderr, "kernel_launch: occupancy query reports %d\n", per_cu);
        (void)hipGetLastError();
        grid = cus;
    }
    if (grid < 0) return;
    hipMemsetAsync((char*)d_ws + WS_CTL, 0, CTL_ZERO_BYTES, stream);
    Args a{};
    for (int i = 0; i < 30; ++i) a.in[i] = (const float*)d_in[i];
    a.out = (float*)d_out; a.ws = (unsigned char*)d_ws;
#if MK_SPLIT
    for (int p = 0; p < N_PHASES; ++p) { a.ph_lo = p; a.ph_hi = p + 1; hipLaunchKernelGGL(fwd_kernel, dim3(grid), dim3(NTHR), LDS_BYTES, stream, a); }
#else
    a.ph_lo = 0; a.ph_hi = N_PHASES;
    hipLaunchKernelGGL(fwd_kernel, dim3(grid), dim3(NTHR), LDS_BYTES, stream, a);
#endif
}
```

```cpp
#include <hip/hip_runtime.h>
#include <cstdio>
#include <cstdint>

#define LAS __attribute__((address_space(3)))
#define GAS __attribute__((address_space(1)))
typedef unsigned short bf16;
typedef short bf16x8 __attribute__((ext_vector_type(8)));
typedef short s16x4 __attribute__((ext_vector_type(4)));
typedef float f32x2 __attribute__((ext_vector_type(2)));
typedef float f32x4 __attribute__((ext_vector_type(4)));
typedef float f32x16 __attribute__((ext_vector_type(16)));
typedef unsigned u32x2 __attribute__((ext_vector_type(2)));
typedef unsigned u32x4 __attribute__((ext_vector_type(4)));

constexpr int DM = 1024, BATCH = 4, SEQ = 8192, NTOK = BATCH * SEQ, DEPTH = 4;
constexpr float EPS = 1e-6f;
constexpr int NWAVES = 8, NTHR = 512;
constexpr int MOE_CAP = 32768;
constexpr int HB_ROWS = 65536 + 32 * 256;

constexpr size_t MiB = 1u << 20;
constexpr size_t WS_CTL = 0, CTL_ZERO_BYTES = 1 * MiB;
constexpr size_t WS_COS = 1 * MiB, WS_SIN = 2 * MiB;
constexpr size_t WS_WPERM = 3 * MiB;
constexpr size_t WS_SSQ = 4 * MiB;
constexpr size_t WS_LIST = 6 * MiB;
constexpr size_t WS_WSM = 14 * MiB;
constexpr size_t WA_T = WS_WSM + 0 * MiB, WUQ_T = WS_WSM + 2 * MiB, WUKV_T = WS_WSM + 4 * MiB, WOM_T = WS_WSM + 5 * MiB, FCH_T = WS_WSM + 7 * MiB, WOF_T = WS_WSM + 8 * MiB,
                 WIN_T = WS_WSM + 10 * MiB, WOG_T = WS_WSM + 18 * MiB, WQKV_T = WS_WSM + 22 * MiB, WOD_T = WS_WSM + 31 * MiB, WG_T = WS_WSM + 32 * MiB, WP_T = WS_WSM + 40 * MiB,
                 FW1_T = WS_WSM + 42 * MiB, FW2_T = WS_WSM + 43 * MiB, FTWC = WS_WSM + 44 * MiB, FTWS = WS_WSM + 45 * MiB;
constexpr size_t WS_MOEW1 = 64 * MiB, WS_MOEW2 = 128 * MiB;
constexpr size_t WS_H8 = 160 * MiB;
constexpr size_t WS_HB = 288 * MiB;
constexpr size_t WS_XN = 352 * MiB;
constexpr size_t WS_PP = 416 * MiB;
constexpr size_t WS_PB = 480 * MiB;
constexpr size_t WS_AR = 544 * MiB;
constexpr size_t WS_END = 1010 * MiB;
constexpr size_t AR_YB = WS_AR + 0 * MiB, AR_HBUF = WS_AR + 128 * MiB;
constexpr size_t AR_CQ = WS_AR + 0 * MiB, AR_CKV = WS_AR + 24 * MiB, AR_KR = WS_AR + 40 * MiB, AR_SSQQ = WS_AR + 44 * MiB, AR_SSQKV = WS_AR + 45 * MiB, AR_Q = WS_AR + 46 * MiB, AR_KN = WS_AR + 96 * MiB, AR_VT = WS_AR + 128 * MiB, AR_O = WS_AR + 160 * MiB;
constexpr size_t AR_TT = WS_AR + 0 * MiB, AR_Z = WS_AR + 128 * MiB, AR_F = WS_AR + 256 * MiB;
constexpr size_t AR_U = WS_AR + 0 * MiB, AR_V = WS_AR + 128 * MiB, AR_G = WS_AR + 256 * MiB, AR_SSQV = WS_AR + 384 * MiB;
constexpr size_t AR_QKV = WS_AR + 0 * MiB, AR_OD = WS_AR + 288 * MiB, AR_OG = WS_AR + 320 * MiB, AR_LSE = WS_AR + 416 * MiB;

constexpr int CW_TMO = 0;
constexpr int CW_BAR = 4096;
constexpr int CW_CNT = 8192;

constexpr int LDS_TAB = 131072;
constexpr int LDS_MISC = 131072 + 8192;
constexpr int LDS_PTRS = 131072 + 4096;
constexpr int LDS_BYTES = 147456;

#define LDS_WAIT() asm volatile("s_waitcnt lgkmcnt(0)" ::: "memory")
#define VM_WAIT() asm volatile("s_waitcnt vmcnt(0)" ::: "memory")
#define SBAR() __builtin_amdgcn_sched_barrier(0)
__device__ __forceinline__ unsigned cvt_pk_bf16(float lo, float hi) { unsigned r; asm volatile("v_cvt_pk_bf16_f32 %0, %1, %2" : "=v"(r) : "v"(lo), "v"(hi)); return r; }
constexpr float ATT8_SCALE = 4.f;
constexpr float K8_SCALE = 0.25f, Q8_SCALE = 0.07216878364870322f * 1.4426950408889634f / K8_SCALE;
constexpr float XN8_SCALE = 8.f, HB8_SCALE = 4.f, W8_SCALE = 64.f, G8_SCALE = 4.f, O8_SCALE = 32.f, FN8_SCALE = 16.f, OD8_SCALE = 32.f, YB8_SCALE = 32.f;
__device__ __forceinline__ unsigned pk_fp8x4(float a, float b, float c, float d) { unsigned w = __builtin_amdgcn_cvt_pk_fp8_f32(a, b, __float_as_uint(a), false); return __builtin_amdgcn_cvt_pk_fp8_f32(c, d, w, true); }
__device__ __forceinline__ float bf2f(unsigned short x) { return __uint_as_float(((unsigned)x) << 16); }
__device__ __forceinline__ float bflo(unsigned w) { return __uint_as_float(w << 16); }
__device__ __forceinline__ float bfhi(unsigned w) { return __uint_as_float(w & 0xffff0000u); }
__device__ __forceinline__ u32x2 pack4(f32x4 v) { u32x2 w; w.x = cvt_pk_bf16(v[0], v[1]); w.y = cvt_pk_bf16(v[2], v[3]); return w; }
__device__ __forceinline__ f32x4 unpack4(u32x2 w) { return (f32x4){bflo(w.x), bfhi(w.x), bflo(w.y), bfhi(w.y)}; }
__device__ __forceinline__ float sumsq4(f32x4 v) { return (v[0] * v[0] + v[1] * v[1]) + (v[2] * v[2] + v[3] * v[3]); }
__device__ __forceinline__ float wave_sum(float v) {
#pragma unroll
    for (int o = 1; o < 64; o <<= 1) v += __shfl_xor(v, o);
    return v;
}
__device__ __forceinline__ float fast_exp2(float x) { return __builtin_amdgcn_exp2f(x); }
__device__ __forceinline__ float fast_rcp(float x) { return __builtin_amdgcn_rcpf(x); }

#define XB_TMO      128
#define XB_XCNT(j)  (256  + 64 * (j))
#define XB_XSUB(j)  (1280 + 64 * (j))
#define XB_XGEN(j)  (2304 + 64 * (j))
#define XB_TOP      3328
#define XB_TOPGEN   3392
#define XCD_BAR_WORDS 3456
#define XB_SPIN_CAP (1u << 20)
__device__ __forceinline__ unsigned xb_ld(unsigned* p)              { return __hip_atomic_load(p, __ATOMIC_RELAXED, __HIP_MEMORY_SCOPE_AGENT); }
__device__ __forceinline__ unsigned xb_add(unsigned* p, unsigned v) { return __hip_atomic_fetch_add(p, v, __ATOMIC_RELAXED, __HIP_MEMORY_SCOPE_AGENT); }
__device__ __forceinline__ unsigned xb_xcc_id() { return (unsigned)__builtin_amdgcn_s_getreg((3 << 11) | 20) & 0xFu; }
#define XB_SPIN(cond, bar) do { unsigned _sp = 0; while (cond) { __builtin_amdgcn_s_sleep(1); \
    if ((++_sp & 255u) == 0u) { if (xb_ld(&(bar)[XB_TMO])) break; if (_sp > XB_SPIN_CAP) { atomicAdd(&(bar)[XB_TMO], 1u); break; } } } } while (0)
struct XcdBarrier { unsigned* bar; unsigned x; volatile LAS unsigned* st; };
__device__ __forceinline__ XcdBarrier xcd_barrier_post(unsigned* bar, volatile LAS unsigned* st) {
    XcdBarrier b; b.bar = bar; b.x = xb_xcc_id(); b.st = st;
    if (threadIdx.x == 0) (void)xb_add(&bar[XB_XCNT(b.x)], 1u);
    return b;
}
__device__ __forceinline__ void xcd_barrier_complete(unsigned* bar, unsigned x, unsigned& nloc, unsigned& nx) {
    const unsigned G = gridDim.x * gridDim.y * gridDim.z;
    unsigned sum, cnt, mine, sp = 0u;
    for (;;) {
        sum = 0u; cnt = 0u; mine = 0u;
#pragma unroll
        for (unsigned j = 0; j < 16; ++j) { const unsigned c = xb_ld(&bar[XB_XCNT(j)]); sum += c; cnt += (c > 0u) ? 1u : 0u; mine = (j == x) ? c : mine; }
        if (sum == G) break;
        __builtin_amdgcn_s_sleep(1);
        if ((++sp & 255u) == 0u) { if (xb_ld(&bar[XB_TMO])) break; if (sp > XB_SPIN_CAP) { atomicAdd(&bar[XB_TMO], 1u); break; } }
    }
    nloc = mine > 0u ? mine : 1u; nx = cnt > 0u ? cnt : 1u;
}
__device__ __forceinline__ void xcd_barrier(const XcdBarrier& b, const int tid) {
    asm volatile("s_waitcnt vmcnt(0)" ::: "memory");
    __syncthreads();
    if (tid == 0) {
        unsigned* bar = b.bar;
        __builtin_amdgcn_s_waitcnt(0);
        unsigned nloc = b.st[0], nx = b.st[1];
        if (nloc == 0u) { xcd_barrier_complete(bar, b.x, nloc, nx); b.st[0] = nloc; b.st[1] = nx; }
        const unsigned old = xb_add(&bar[XB_XSUB(b.x)], 1u);
        const unsigned gen = old / nloc;
        if (old + 1u == (gen + 1u) * nloc) {
            __builtin_amdgcn_fence(__ATOMIC_RELEASE, "agent");
            asm volatile("s_waitcnt vmcnt(0)" ::: "memory");
            const unsigned og = xb_add(&bar[XB_TOP], 1u);
            const unsigned tg = og / nx;
            if (og + 1u == (tg + 1u) * nx) xb_add(&bar[XB_TOPGEN], 1u);
            else XB_SPIN(xb_ld(&bar[XB_TOPGEN]) == tg, bar);
            __builtin_amdgcn_fence(__ATOMIC_ACQUIRE, "agent");
            xb_add(&bar[XB_XGEN(b.x)], 1u);
            asm volatile("s_waitcnt vmcnt(0)" ::: "memory");
        } else {
            XB_SPIN(xb_ld(&bar[XB_XGEN(b.x)]) == gen, bar);
            __builtin_amdgcn_fence(__ATOMIC_ACQUIRE, "agent");
            asm volatile("s_waitcnt vmcnt(0)" ::: "memory");
        }
    }
    __syncthreads();
}

namespace pg8 {
constexpr int BM = 256, BK = 64, HALF = 128, HTB = HALF * BK * 2, STAGE_BYTES = 8 * HTB, NXCD = 8, WGM = 8;
__host__ __device__ __forceinline__ int lds_byte(int r, int c) { const int st = (r >> 4) * 2 + (c >> 5), rr = r & 15, cc = c & 31, ob = rr * 64 + cc * 2; return st * 1024 + (ob ^ (((ob >> 9) & 1) << 5)); }
__host__ __device__ __forceinline__ void stage_rc(int b, int& R, int& C) { const int st = b / 1024, sb = b % 1024, swz = sb ^ (((sb >> 9) & 1) << 5); R = (st >> 1) * 16 + swz / 64; C = (st & 1) * 32 + (swz % 64) / 2; }

typedef int v8i32 __attribute__((ext_vector_type(8)));
__device__ __forceinline__ v8i32 cat8(bf16x8 lo, bf16x8 hi) { const u32x4 a = __builtin_bit_cast(u32x4, lo), b = __builtin_bit_cast(u32x4, hi); return (v8i32){(int)a.x, (int)a.y, (int)a.z, (int)a.w, (int)b.x, (int)b.y, (int)b.z, (int)b.w}; }
union Frag { v8i32 v; bf16x8 q[2]; };
struct Unit { const char* a; const char* b; int pm, pn, aux; };

struct TileOrder {
    int nM, nN, nb, G, c;
    __device__ __forceinline__ bool decode(int i, int& bt, int& pm, int& pn) const {
        const int per = nM * nN, total = per * nb; const long L = (long)i * G + c; if (L >= total) return false;
        int wgid = (int)L; { const int q = total / NXCD, r = total % NXCD, xcd = wgid % NXCD, off = wgid / NXCD; wgid = (xcd < r ? xcd * (q + 1) : r * (q + 1) + (xcd - r) * q) + off; }
        bt = wgid / per; const int rem = wgid % per;
        const int nig = WGM * nN, gid = rem / nig, fm = gid * WGM, gsz = (nM - fm) < WGM ? (nM - fm) : WGM;
        pm = fm + ((rem % nig) % gsz); pn = (rem % nig) / gsz; return true;
    }
};

#define PG8_SA(b, h) (((b) * 2 + (h)) * HTB)
#define PG8_SB(b, h) ((4 + (b) * 2 + (h)) * HTB)
#define PG8_WAIT_V(n) asm volatile("s_waitcnt vmcnt(" #n ")" ::: "memory")
#define PG8_WAIT_L(n) asm volatile("s_waitcnt lgkmcnt(" #n ")" ::: "memory")
#define PG8_BAR __builtin_amdgcn_s_barrier()
#define PG8_SCHED __builtin_amdgcn_sched_barrier(0)

template <class Epi, class Sched, bool ALIGN_EPI, bool FP8 = false>
__device__ __forceinline__ void gemm_phase(LAS unsigned char* lds, const int tid, const Sched& S, const Epi& E) {
    const int wid = __builtin_amdgcn_readfirstlane(tid >> 6), lane = tid & 63, wr = wid >> 2, wc = wid & 3, fr = lane & 15, fq = lane >> 4;
    const int K = S.K, nt = K / (FP8 ? 2 * BK : BK);
    int Rs[2], Cs[2]; unsigned voffB[2];
#pragma unroll
    for (int i = 0; i < 2; ++i) { stage_rc(tid * 16 + i * 8192, Rs[i], Cs[i]); voffB[i] = S.boff(Rs[i], Cs[i]); }
    const size_t kstep = (size_t)(BK * 2);
    const size_t hstepB = S.hstepB();
    const unsigned ldsw = (unsigned)wid * 1024u;
    const int aoff = lds_byte(wr * 64 + fr, fq * 8), boff = lds_byte(wc * 32 + fr, fq * 8);
#define PG8_STAGE_B(bufoff, gbase) do { _Pragma("unroll") for (int _i = 0; _i < 2; ++_i) \
        __builtin_amdgcn_global_load_lds((const unsigned*)((const char*)(gbase) + voffB[_i]), (LAS unsigned*)(lds + (bufoff) + ldsw + _i * 8192), 16, 0, 0); } while (0)
#define PG8_STAGE_A(bufoff, gbase, vo) do { _Pragma("unroll") for (int _i = 0; _i < 2; ++_i) \
        __builtin_amdgcn_global_load_lds((const unsigned*)((const char*)(gbase) + (vo)[_i]), (LAS unsigned*)(lds + (bufoff) + ldsw + _i * 8192), 16, 0, 0); } while (0)
#define PG8_LDA(dst, b, h) do { _Pragma("unroll") for (int m = 0; m < 4; ++m) _Pragma("unroll") for (int k = 0; k < 2; ++k) dst[m].q[k] = *(const LAS bf16x8*)(lds + PG8_SA(b, h) + aoff + m * 2048 + k * 1024); } while (0)
#define PG8_LDB(dst, b, h) do { _Pragma("unroll") for (int n = 0; n < 2; ++n) _Pragma("unroll") for (int k = 0; k < 2; ++k) dst[n].q[k] = *(const LAS bf16x8*)(lds + PG8_SB(b, h) + boff + n * 2048 + k * 1024); } while (0)
#define PG8_MMA(ai, bj, At, Bt) do { __builtin_amdgcn_s_setprio(1); if constexpr (FP8) { _Pragma("unroll") for (int m = 0; m < 4; ++m) _Pragma("unroll") for (int n = 0; n < 2; ++n) \
        asm volatile("v_mfma_f32_16x16x128_f8f6f4 %0, %1, %2, %0" : "+v"(acc[ai][bj][m][n]) : "v"(Bt[n].v), "v"(At[m].v)); }     \
        else { _Pragma("unroll") for (int m = 0; m < 4; ++m) _Pragma("unroll") for (int n = 0; n < 2; ++n) _Pragma("unroll") for (int k = 0; k < 2; ++k) \
        acc[ai][bj][m][n] = __builtin_amdgcn_mfma_f32_16x16x32_bf16(Bt[n].q[k], At[m].q[k], acc[ai][bj][m][n], 0, 0, 0); } if constexpr (FP8) asm volatile("s_nop 11"); __builtin_amdgcn_s_setprio(0); } while (0)
    Unit cur, nxt; int ui = 0;
    if (!S.next(0, cur)) return;
    unsigned cv0[2], cv1[2], nv0[2], nv1[2];
#pragma unroll
    for (int i = 0; i < 2; ++i) { cv0[i] = S.aoff(cur, 0, Rs[i], Cs[i]); cv1[i] = S.aoff(cur, 1, Rs[i], Cs[i]); nv0[i] = cv0[i]; nv1[i] = cv1[i]; }
    f32x4 acc[2][2][4][2];
#pragma unroll
    for (int a = 0; a < 2; ++a)
#pragma unroll
        for (int b = 0; b < 2; ++b)
#pragma unroll
            for (int m = 0; m < 4; ++m)
#pragma unroll
                for (int n = 0; n < 2; ++n) acc[a][b][m][n] = (f32x4){0.f, 0.f, 0.f, 0.f};
    Frag At[4], B0[2], B1[2];
    const char* cA = cur.a; const char* cB = cur.b;
    PG8_STAGE_B(PG8_SB(0, 0), cB); PG8_STAGE_B(PG8_SB(0, 1), cB + hstepB); PG8_STAGE_A(PG8_SA(0, 0), cA, cv0); PG8_STAGE_A(PG8_SA(0, 1), cA, cv1);
    if (wr == 1) PG8_BAR;
    PG8_WAIT_V(2); PG8_BAR;
    PG8_STAGE_B(PG8_SB(1, 0), cB + kstep); PG8_STAGE_A(PG8_SA(1, 0), cA + kstep, cv0); PG8_STAGE_B(PG8_SB(1, 1), cB + hstepB + kstep);
    PG8_WAIT_V(6); PG8_BAR;
    for (;;) {
        const bool has_next = S.next(ui + 1, nxt);
        const char* nA = has_next ? nxt.a : cA; const char* nB = has_next ? nxt.b : cB;
        if (has_next) {
#pragma unroll
            for (int i = 0; i < 2; ++i) { nv0[i] = S.aoff(nxt, 0, Rs[i], Cs[i]); nv1[i] = S.aoff(nxt, 1, Rs[i], Cs[i]); }
        } else {
#pragma unroll
            for (int i = 0; i < 2; ++i) { nv0[i] = cv0[i]; nv1[i] = cv1[i]; }
        }
        for (int t = 0; t < nt; t += 2) {
            const bool last = (t == nt - 2);
            const char* a1 = cA + (size_t)(t + 1) * kstep;
            const char* a2 = last ? nA : cA + (size_t)(t + 2) * kstep; const char* b2 = last ? nB : cB + (size_t)(t + 2) * kstep;
            const char* a3 = a2 + kstep; const char* b3 = b2 + kstep;
            unsigned x0[2], x1[2];
#pragma unroll
            for (int i = 0; i < 2; ++i) { x0[i] = last ? nv0[i] : cv0[i]; x1[i] = last ? nv1[i] : cv1[i]; }
            PG8_LDB(B0, 0, 0); PG8_LDB(B1, 0, 1); PG8_SCHED; PG8_LDA(At, 0, 0); PG8_STAGE_A(PG8_SA(1, 1), a1, cv1);
            PG8_WAIT_V(8); PG8_WAIT_L(0); PG8_BAR; PG8_MMA(0, 0, At, B0); PG8_MMA(0, 1, At, B1); PG8_BAR; PG8_SCHED;
            PG8_LDA(At, 0, 1); PG8_STAGE_B(PG8_SB(0, 0), b2); PG8_STAGE_B(PG8_SB(0, 1), b2 + hstepB); PG8_STAGE_A(PG8_SA(0, 0), a2, x0);
            PG8_WAIT_V(8); PG8_WAIT_L(0); PG8_BAR; PG8_MMA(1, 0, At, B0); PG8_MMA(1, 1, At, B1); PG8_BAR; PG8_SCHED;
            PG8_LDB(B0, 1, 0); PG8_LDB(B1, 1, 1); PG8_SCHED; PG8_LDA(At, 1, 0); PG8_STAGE_A(PG8_SA(0, 1), a2, x1);
            PG8_WAIT_V(8); PG8_WAIT_L(0); PG8_BAR; PG8_MMA(0, 0, At, B0); PG8_MMA(0, 1, At, B1); PG8_BAR; PG8_SCHED;
            PG8_LDA(At, 1, 1); PG8_STAGE_B(PG8_SB(1, 0), b3); PG8_STAGE_B(PG8_SB(1, 1), b3 + hstepB); PG8_STAGE_A(PG8_SA(1, 0), a3, x0);
            PG8_WAIT_V(8); PG8_WAIT_L(0); PG8_BAR; PG8_MMA(1, 0, At, B0); PG8_MMA(1, 1, At, B1); PG8_BAR; PG8_SCHED;
        }
        if constexpr (ALIGN_EPI) { if (wr == 0) PG8_BAR; }
        E(acc, cur, wr, wc, fr, fq);
        if (!has_next) break;
#pragma unroll
        for (int a = 0; a < 2; ++a)
#pragma unroll
            for (int b = 0; b < 2; ++b)
#pragma unroll
                for (int m = 0; m < 4; ++m)
#pragma unroll
                    for (int n = 0; n < 2; ++n) acc[a][b][m][n] = (f32x4){0.f, 0.f, 0.f, 0.f};
        cur = nxt; cA = nA; cB = nB; ++ui;
#pragma unroll
        for (int i = 0; i < 2; ++i) { cv0[i] = nv0[i]; cv1[i] = nv1[i]; }
        if constexpr (ALIGN_EPI) { if (wr == 1) PG8_BAR; }
    }
    PG8_WAIT_V(0);
    if constexpr (!ALIGN_EPI) { if (wr == 0) PG8_BAR; }
    PG8_BAR;
#undef PG8_STAGE_A
#undef PG8_STAGE_B
#undef PG8_LDA
#undef PG8_LDB
#undef PG8_MMA
}

struct DenseSched {
    const bf16* A; const bf16* Bt; int K, lda, ldb; TileOrder T; size_t a_bstride, b_bstride;
    __device__ __forceinline__ bool next(int i, Unit& u) const {
        int bt, pm, pn; if (!T.decode(i, bt, pm, pn)) return false;
        u.pm = pm; u.pn = pn; u.aux = bt;
        u.a = (const char*)(A + (size_t)bt * a_bstride + (size_t)pm * BM * lda); u.b = (const char*)(Bt + (size_t)bt * b_bstride + (size_t)pn * BM * ldb); return true;
    }
    __device__ __forceinline__ unsigned aoff(const Unit&, int half, int R, int C) const { return (unsigned)((R + HALF * half) * lda + C) * 2u; }
    __device__ __forceinline__ unsigned boff(int R, int C) const { return (unsigned)(R * ldb + C) * 2u; }
    __device__ __forceinline__ size_t hstepB() const { return (size_t)HALF * ldb * 2; }
};
struct DenseSched8 {
    const unsigned char* A; const unsigned char* Bt; int K, lda, ldb; TileOrder T;
    __device__ __forceinline__ bool next(int i, Unit& u) const {
        int bt, pm, pn; if (!T.decode(i, bt, pm, pn)) return false;
        u.pm = pm; u.pn = pn; u.aux = bt; u.a = (const char*)(A + (size_t)pm * BM * lda); u.b = (const char*)(Bt + (size_t)pn * BM * ldb); return true;
    }
    __device__ __forceinline__ unsigned aoff(const Unit&, int half, int R, int C) const { return (unsigned)((R + HALF * half) * lda + 2 * C); }
    __device__ __forceinline__ unsigned boff(int R, int C) const { return (unsigned)(R * ldb + 2 * C); }
    __device__ __forceinline__ size_t hstepB() const { return (size_t)HALF * ldb; }
};
}

#define EPI_LOOP_BEGIN _Pragma("unroll") for (int ai = 0; ai < 2; ++ai) _Pragma("unroll") for (int m = 0; m < 4; ++m) { const int rowt = ai * 128 + wr * 64 + m * 16 + fr;
#define EPI_LOOP_END }

struct Args {
    const float* in[30];
    float* out; unsigned char* ws; int ph_lo, ph_hi;
};
enum { I_X = 0, I_P, I_NORM_MIX, I_NORM_MOE, I_MLA_WA, I_MLA_NQ, I_MLA_NKV, I_MLA_WUQ, I_MLA_WUKV, I_MLA_WO, I_FN_WO, I_FN_BO, I_GM_WIN, I_GM_NV, I_GM_WS, I_GM_BS, I_GM_WO,
       I_DL_WQKV, I_DL_WO, I_MOE_WGRP, I_MOE_BGRP, I_MOE_WEXP, I_MOE_BEXP, I_MOE_WGATE, I_MOE_WUP, I_MOE_WDOWN, I_PLE_NORM, I_PLE_WGATE, I_PLE_WPROJ, I_NORM_FINAL };

struct Ctx {
    LAS unsigned char* lds; unsigned char* ws; float* out;
    int tid, lane, wave, G, bx;
    struct InTab { LAS unsigned char* lds;
        __device__ __forceinline__ const float* operator[](int i) const {
            const u32x2 w = *(const LAS u32x2*)(lds + LDS_PTRS + 8 * i);
            const unsigned long long p = ((unsigned long long)(unsigned)__builtin_amdgcn_readfirstlane((int)w.y) << 32) | (unsigned)__builtin_amdgcn_readfirstlane((int)w.x);
            return (const float*)(GAS const float*)p; } } in;
};

__device__ __forceinline__ int rope_phys(int l) { return (((l & 31) >> 4) << 5) + ((l >> 5) << 4) + (l & 15); }
__device__ __forceinline__ int tr_map(int mode, int n) {
    switch (mode) {
        case 1: return n < 640 ? n : 640 + rope_phys(n - 640);
        case 2: { const int h = n / 192, r = n % 192; return h * 192 + (r < 128 ? r : 128 + rope_phys(r - 128)); }
        case 3: { const int blk = n >> 6, l = n & 63, t = (blk >> 3) % 3; return t < 2 ? (blk << 6) + rope_phys(l) : n; }
        case 4: case 5: { const int pn = n >> 7, wc = (n >> 5) & 3, fq = (n >> 3) & 3, bj = (n >> 2) & 1, i = n & 3; return 256 * pn + 128 * bj + 32 * wc + 16 * (mode - 4) + 4 * fq + i; }
        default: return n;
    }
}
__device__ __forceinline__ void transpose_item(const float* W, int K, int N, bf16* WT, int ldt, const float* gain, int mode, LAS float* scr, int item, int lane) {
    const int nblk = N / 64, kb = item / nblk, nb = item % nblk, k0 = 64 * kb, n0 = 64 * nb;
    const int lr = lane >> 4, lc = (lane & 15) * 4;
    f32x4 v[16];
#pragma unroll
    for (int i = 0; i < 16; ++i) v[i] = *(const f32x4*)(W + (size_t)(k0 + 4 * i + lr) * N + n0 + lc);
    if (gain) {
#pragma unroll
        for (int i = 0; i < 16; ++i) v[i] *= gain[k0 + 4 * i + lr];
    }
#pragma unroll
    for (int i = 0; i < 16; ++i) { LAS float* p = scr + (4 * i + lr) * 65 + lc; p[0] = v[i][0]; p[1] = v[i][1]; p[2] = v[i][2]; p[3] = v[i][3]; }
    LDS_WAIT(); asm volatile("" ::: "memory");
    const int c = lane & 7;
#pragma unroll
    for (int j = 0; j < 8; ++j) { const int n = (lane >> 3) + 8 * j; const LAS float* s = scr + (8 * c) * 65 + n;
        u32x4 o; o.x = cvt_pk_bf16(s[0 * 65], s[1 * 65]); o.y = cvt_pk_bf16(s[2 * 65], s[3 * 65]); o.z = cvt_pk_bf16(s[4 * 65], s[5 * 65]); o.w = cvt_pk_bf16(s[6 * 65], s[7 * 65]);
        *(u32x4*)(WT + (size_t)tr_map(mode, n0 + n) * ldt + k0 + 8 * c) = o; }
    LDS_WAIT(); asm volatile("" ::: "memory");
}
__device__ __forceinline__ void transpose_item8(const float* W, int K, int N, unsigned char* WT, int ldt, float scale, int mode, LAS float* scr, int item, int lane, const float* gain = nullptr) {
    const int nblk = N / 64, kb = item / nblk, nb = item % nblk, k0 = 64 * kb, n0 = 64 * nb;
    const int lr = lane >> 4, lc = (lane & 15) * 4;
    f32x4 v[16];
#pragma unroll
    for (int i = 0; i < 16; ++i) v[i] = *(const f32x4*)(W + (size_t)(k0 + 4 * i + lr) * N + n0 + lc);
#pragma unroll
    for (int i = 0; i < 16; ++i) { LAS float* p = scr + (4 * i + lr) * 65 + lc; const float sg = gain ? scale * gain[k0 + 4 * i + lr] : scale; p[0] = v[i][0] * sg; p[1] = v[i][1] * sg; p[2] = v[i][2] * sg; p[3] = v[i][3] * sg; }
    LDS_WAIT(); asm volatile("" ::: "memory");
    const int c = lane & 3;
#pragma unroll
    for (int j = 0; j < 4; ++j) { const int n = (lane >> 2) + 16 * j; const LAS float* s = scr + (16 * c) * 65 + n;
        u32x4 o; o.x = pk_fp8x4(s[0 * 65], s[1 * 65], s[2 * 65], s[3 * 65]); o.y = pk_fp8x4(s[4 * 65], s[5 * 65], s[6 * 65], s[7 * 65]);
        o.z = pk_fp8x4(s[8 * 65], s[9 * 65], s[10 * 65], s[11 * 65]); o.w = pk_fp8x4(s[12 * 65], s[13 * 65], s[14 * 65], s[15 * 65]);
        *(u32x4*)(WT + (size_t)tr_map(mode, n0 + n) * ldt + k0 + 16 * c) = o; }
    LDS_WAIT(); asm volatile("" ::: "memory");
}
__device__ __forceinline__ void transpose_matrix(const Ctx& C, const float* W, int K, int N, bf16* WT, int ldt, const float* gain, int mode) {
    LAS float* scr = (LAS float*)(C.lds + C.wave * 16896);
    const int gw = C.bx * NWAVES + C.wave, NGW = C.G * NWAVES, nitems = (K / 64) * (N / 64);
    for (int it = gw; it < nitems; it += NGW) transpose_item(W, K, N, WT, ldt, gain, mode, scr, it, C.lane);
}
__device__ __forceinline__ void moe_weight_prep(const Ctx& C, int layer, int it_lo = 0, int it_hi = 1 << 30, int gwo = -1, int ngwo = 0) {
    LAS float* scr = (LAS float*)(C.lds + C.wave * 16896);
    const int gw = C.bx * NWAVES + C.wave, NGW = C.G * NWAVES;
    const float* wg = C.in[I_MOE_WGATE] + (size_t)layer * 32 * 1024 * 512; const float* wu = C.in[I_MOE_WUP] + (size_t)layer * 32 * 1024 * 512; const float* wd = C.in[I_MOE_WDOWN] + (size_t)layer * 32 * 512 * 1024;
    unsigned char* w1 = C.ws + WS_MOEW1; unsigned char* w2 = C.ws + WS_MOEW2;
    constexpr int IT1 = (1024 / 64) * (512 / 64), IT2 = (512 / 64) * (1024 / 64);
    const int total = 32 * (2 * IT1 + IT2), hi_ = it_hi < total ? it_hi : total;
    for (int it = it_lo + (gwo >= 0 ? gwo : gw); it < hi_; it += (gwo >= 0 ? ngwo : NGW)) {
        const int e = it / (2 * IT1 + IT2); int r = it % (2 * IT1 + IT2);
        if (r < IT1) { transpose_item8(wg + (size_t)e * 1024 * 512, 1024, 512, w1 + (size_t)e * 1024 * 1024, 1024, 64.f, 4, scr, r, C.lane); continue; } r -= IT1;
        if (r < IT1) { transpose_item8(wu + (size_t)e * 1024 * 512, 1024, 512, w1 + (size_t)e * 1024 * 1024, 1024, 64.f, 5, scr, r, C.lane); continue; } r -= IT1;
        transpose_item8(wd + (size_t)e * 512 * 1024, 512, 1024, w2 + (size_t)e * 1024 * 512, 512, 64.f, 0, scr, r, C.lane);
    }
}

__device__ __forceinline__ void prologue(const Ctx& C) {
    const int gw = C.bx * NWAVES + C.wave, NGW = C.G * NWAVES, gt = C.bx * NTHR + C.tid, NGT = C.G * NTHR;
    unsigned char* ws = C.ws;
    for (int i = gt; i < 64 * 1024 / 8; i += NGT) ((u32x4*)(ws + WA_T + (size_t)704 * 1024 * 2))[i] = (u32x4){0u, 0u, 0u, 0u};
    {
        LAS float* scr = (LAS float*)(C.lds + C.wave * 16896);
        constexpr int N_WA = 16 * 11, N_UQ = 6 * 24, N_UKV = 4 * 32, N_SQ = 16 * 16, N_WIN = 16 * 64, N_GWO = 32 * 16, N_QKV = 16 * 72, N_DWO = 8 * 16, N_PP = 4 * 16;
        constexpr int TOTAL = N_WA + N_UQ + N_UKV + 2 * N_SQ + N_WIN + N_GWO + N_QKV + N_DWO + DEPTH * (N_SQ + N_PP);
        for (int it = gw; it < TOTAL; it += NGW) {
            int r = it;
            if (r < N_WA)  { transpose_item(C.in[I_MLA_WA], 1024, 704, (bf16*)(ws + WA_T), 1024, C.in[I_NORM_MIX] + 0 * 1024, 1, scr, r, C.lane); continue; } r -= N_WA;
            if (r < N_UQ)  { transpose_item(C.in[I_MLA_WUQ], 384, 1536, (bf16*)(ws + WUQ_T), 384, C.in[I_MLA_NQ], 2, scr, r, C.lane); continue; } r -= N_UQ;
            if (r < N_UKV) { transpose_item(C.in[I_MLA_WUKV], 256, 2048, (bf16*)(ws + WUKV_T), 256, C.in[I_MLA_NKV], 0, scr, r, C.lane); continue; } r -= N_UKV;
            if (r < N_SQ)  { transpose_item8(C.in[I_MLA_WO], 1024, 1024, ws + WOM_T, 1024, 64.f, 0, scr, r, C.lane); continue; } r -= N_SQ;
            if (r < N_SQ)  { transpose_item8(C.in[I_FN_WO], 1024, 1024, ws + WOF_T, 1024, 64.f, 0, scr, r, C.lane); continue; } r -= N_SQ;
            if (r < N_WIN) { transpose_item8(C.in[I_GM_WIN], 1024, 4096, ws + WIN_T, 1024, 64.f, 0, scr, r, C.lane, C.in[I_NORM_MIX] + 2 * 1024); continue; } r -= N_WIN;
            if (r < N_GWO) { transpose_item8(C.in[I_GM_WO], 2048, 1024, ws + WOG_T, 2048, 64.f, 0, scr, r, C.lane); continue; } r -= N_GWO;
            if (r < N_QKV) { transpose_item8(C.in[I_DL_WQKV], 1024, 4608, ws + WQKV_T, 1024, 64.f, 3, scr, r, C.lane, C.in[I_NORM_MIX] + 3 * 1024); continue; } r -= N_QKV;
            if (r < N_DWO) { transpose_item8(C.in[I_DL_WO], 512, 1024, ws + WOD_T, 512, 64.f, 0, scr, r, C.lane); continue; } r -= N_DWO;
            const int l = r / (N_SQ + N_PP); r -= l * (N_SQ + N_PP);
            if (r < N_SQ)  { transpose_item8(C.in[I_PLE_WGATE] + (size_t)l * 1024 * 1024, 1024, 1024, ws + WG_T + (size_t)l * 1024 * 1024, 1024, 64.f, 0, scr, r, C.lane); continue; } r -= N_SQ;
            transpose_item(C.in[I_PLE_WPROJ] + (size_t)l * 256 * 1024, 256, 1024, (bf16*)(ws + WP_T) + (size_t)l * 1024 * 256, 256, nullptr, 0, scr, r, C.lane);
        }
    }
    {
        const float* gain = C.in[I_NORM_MIX] + 1 * 1024; bf16* F = (bf16*)(ws + FCH_T);
        for (int i = gt; i < 4 * 512 * 256 / 2; i += NGT) {
            const int e = i * 2, k = e & 255, f = (e >> 8) & 511, g = e >> 17;
            float v[2];
#pragma unroll
            for (int j = 0; j < 2; ++j) { const int kk = k + j, ff = f & 255; const float x = (float)((ff * kk) & 255) * (1.0f / 256.0f);
                const float t = f < 256 ? __builtin_amdgcn_cosf(x) : -__builtin_amdgcn_sinf(x); v[j] = t * gain[g * 256 + kk]; }
            ((unsigned*)F)[i] = cvt_pk_bf16(v[0], v[1]);
        }
    }
    {
        bf16* W1 = (bf16*)(ws + FW1_T); bf16* W2 = (bf16*)(ws + FW2_T); float* twc = (float*)(ws + FTWC); float* tws = (float*)(ws + FTWS);
        for (int i = gt; i < 256 * 256; i += NGT) { const int col = i & 255, row = i >> 8, p = col >> 7, s1 = col & 127, pp = row >> 7, k1 = row & 127;
            const float x = (float)((s1 * k1) & 127) * (1.0f / 128.0f); const float cv = __builtin_amdgcn_cosf(x), sv = __builtin_amdgcn_sinf(x);
            const float v = (pp == p) ? cv : (pp == 0 ? sv : -sv); W1[i] = (bf16)(cvt_pk_bf16(v, 0.f) & 0xffffu); }
        for (int i = gt; i < 256 * 128; i += NGT) { const int col = i & 127, row = i >> 7, p = col >> 6, s2 = col & 63;
            float v = 0.f; if (row < 64) { const float x = (float)((s2 * row) & 63) * (1.0f / 64.0f); v = p == 0 ? __builtin_amdgcn_cosf(x) : __builtin_amdgcn_sinf(x); }
            W2[i] = (bf16)(cvt_pk_bf16(v, 0.f) & 0xffffu); }
        for (int i = gt; i < 128 * 64; i += NGT) { const int s2 = i & 63, k1 = i >> 6; const float x = (float)(s2 * k1) * (1.0f / 8192.0f); twc[i] = __builtin_amdgcn_cosf(x); tws[i] = __builtin_amdgcn_sinf(x); }
    }
    {
        float* ct = (float*)(ws + WS_COS); float* st = (float*)(ws + WS_SIN);
        for (int i = gt; i < SEQ * 32; i += NGT) { const int s = i >> 5, j = i & 31; const float inv = exp2f(-13.287712379549449f * ((float)(2 * j) / 64.0f)); const float ang = (float)s * inv;
            const double rv = (double)ang * 0.15915494309189535; const float fr = (float)(rv - floor(rv));
            ct[i] = __builtin_amdgcn_cosf(fr); st[i] = __builtin_amdgcn_sinf(fr); }
    }
    {
        u32x4* wp = (u32x4*)(ws + WS_WPERM);
        for (int i = gt; i < DEPTH * 32 * 64 * 6; i += NGT) {
            const int q = i % 6, l = (i / 6) & 63, st = (i / (6 * 64)) & 31, layer = i / (6 * 64 * 32);
            const int nb = q >> 1, part = q & 1, c = nb * 16 + (l & 15);
            float v[8];
#pragma unroll
            for (int j = 0; j < 8; ++j) { const int k = 32 * st + 8 * (l >> 4) + j; float w = 0.f;
                if (c < 4) w = C.in[I_MOE_WGRP][((size_t)layer * 1024 + k) * 4 + c]; else if (c < 36) w = C.in[I_MOE_WEXP][((size_t)layer * 1024 + k) * 32 + (c - 4)];
                w *= C.in[I_NORM_MOE][layer * 1024 + k];
                const float hi = bflo(cvt_pk_bf16(w, 0.f)); v[j] = part == 0 ? hi : w - hi; }
            wp[i] = (u32x4){cvt_pk_bf16(v[0], v[1]), cvt_pk_bf16(v[2], v[3]), cvt_pk_bf16(v[4], v[5]), cvt_pk_bf16(v[6], v[7])};
        }
    }
    {
        const f32x4* p = (const f32x4*)C.in[I_P]; u32x2* pb = (u32x2*)(ws + WS_PB);
        static_assert((DEPTH * NTOK * 256 / 4) % (8 * 256 * NTHR) == 0, "p conversion batches");
        for (int i = gt; i < DEPTH * NTOK * 256 / 4; i += 8 * NGT) {
            f32x4 v[8];
#pragma unroll
            for (int k = 0; k < 8; ++k) v[k] = p[i + k * NGT];
#pragma unroll
            for (int k = 0; k < 8; ++k) pb[i + k * NGT] = pack4(v[k]); }
    }
    {
        const float* x = C.in[I_X]; bf16* HB = (bf16*)(ws + WS_HB); float* SSQ = (float*)(ws + WS_SSQ);
        for (int r0 = gw; r0 < NTOK; r0 += 4 * NGW) {
            f32x4 xv[4][4];
#pragma unroll
            for (int q = 0; q < 4; ++q) { const f32x4* xr = (const f32x4*)(x + (size_t)(r0 + q * NGW) * DM) + C.lane;
#pragma unroll
                for (int j = 0; j < 4; ++j) xv[q][j] = xr[64 * j]; }
#pragma unroll
            for (int q = 0; q < 4; ++q) { const int r = r0 + q * NGW; u32x2* br = (u32x2*)(HB + (size_t)r * DM) + C.lane;
                float s = 0.f;
#pragma unroll
                for (int j = 0; j < 4; ++j) { const u32x2 w = pack4(xv[q][j]); br[64 * j] = w; s += sumsq4(unpack4(w)); }
                s = wave_sum(s);
                if (C.lane < 16) SSQ[(size_t)r * 16 + C.lane] = C.lane == 0 ? s : 0.f; }
        }
    }
    moe_weight_prep(C, 0, 0, C.G == 256 ? 8192 : (1 << 30));
}

__device__ __forceinline__ float rstd_from_slots16(const float* SSQ, int row) {
    const f32x4* p = (const f32x4*)(SSQ + (size_t)row * 16); const f32x4 a = p[0], b = p[1], c = p[2], d = p[3];
    const float s = ((a[0] + a[1]) + (a[2] + a[3])) + ((b[0] + b[1]) + (b[2] + b[3])) + ((c[0] + c[1]) + (c[2] + c[3])) + ((d[0] + d[1]) + (d[2] + d[3]));
    return __builtin_amdgcn_rsqf(s * (1.0f / 1024.0f) + EPS);
}
__device__ __forceinline__ float rstd_from_slots8(const float* S8, int row, float invn) {
    const f32x4* p = (const f32x4*)(S8 + (size_t)row * 8); const f32x4 a = p[0], b = p[1];
    const float s = ((a[0] + a[1]) + (a[2] + a[3])) + ((b[0] + b[1]) + (b[2] + b[3]));
    return __builtin_amdgcn_rsqf(s * invn + EPS);
}
__device__ __forceinline__ float slots16_part(const float* SSQ, int row, int fq) { const f32x4 a = ((const f32x4*)(SSQ + (size_t)row * 16))[fq]; return (a[0] + a[1]) + (a[2] + a[3]); }
__device__ __forceinline__ float slots16_finish(float s) { s += __shfl_xor(s, 16); s += __shfl_xor(s, 32); return __builtin_amdgcn_rsqf(s * (1.0f / 1024.0f) + EPS); }
__device__ __forceinline__ float slots8_part(const float* S8, int row, int fq) { const f32x4 a = ((const f32x4*)(S8 + (size_t)row * 8))[fq & 1]; return (a[0] + a[1]) + (a[2] + a[3]); }
__device__ __forceinline__ float slots8_finish(float s, float invn) { s += __shfl_xor(s, 16); return __builtin_amdgcn_rsqf(s * invn + EPS); }
__device__ __forceinline__ void rope4(f32x4& v0, f32x4& v1, const float* ct, const float* st, int pos, int j0) {
    const f32x4 c = *(const f32x4*)(ct + pos * 32 + j0), s = *(const f32x4*)(st + pos * 32 + j0);
    const f32x4 a = v0 * c - v1 * s, b = v1 * c + v0 * s; v0 = a; v1 = b;
}

typedef f32x4 Acc[2][2][4][2];
using pg8::Unit;

struct EpiStoreBf16 {
    bf16* O; int ldc; float scale; size_t bstride;
    __device__ __forceinline__ void operator()(const Acc& acc, const Unit& u, int wr, int wc, int fr, int fq) const {
        bf16* base = O + (size_t)u.aux * bstride;
        EPI_LOOP_BEGIN
            bf16* rp = base + (size_t)(u.pm * 256 + rowt) * ldc + u.pn * 256 + wc * 32 + 4 * fq;
#pragma unroll
            for (int bj = 0; bj < 2; ++bj) { *(u32x2*)(rp + bj * 128) = pack4(acc[ai][bj][m][0] * scale); *(u32x2*)(rp + bj * 128 + 16) = pack4(acc[ai][bj][m][1] * scale); }
        EPI_LOOP_END
    }
};
struct EpiResidual {
    bf16* H; const float* bias; float scale, bsc;
    __device__ __forceinline__ void operator()(const Acc& acc, const Unit& u, int wr, int wc, int fr, int fq) const {
        const int colb = u.pn * 256 + wc * 32 + 4 * fq;
#pragma unroll
        for (int ai = 0; ai < 2; ++ai) {
            u32x2 hv[4][2][2];
#pragma unroll
            for (int m = 0; m < 4; ++m) { const bf16* rp = H + (size_t)(u.pm * 256 + ai * 128 + wr * 64 + m * 16 + fr) * DM + colb;
#pragma unroll
                for (int bj = 0; bj < 2; ++bj)
#pragma unroll
                    for (int n = 0; n < 2; ++n) hv[m][bj][n] = *(const u32x2*)(rp + bj * 128 + n * 16); }
#pragma unroll
            for (int m = 0; m < 4; ++m) { bf16* rp = H + (size_t)(u.pm * 256 + ai * 128 + wr * 64 + m * 16 + fr) * DM + colb;
#pragma unroll
                for (int bj = 0; bj < 2; ++bj)
#pragma unroll
                    for (int n = 0; n < 2; ++n) { f32x4 v = unpack4(hv[m][bj][n]) + acc[ai][bj][m][n] * scale; if (bias) v += *(const f32x4*)(bias + colb + bj * 128 + n * 16) * bsc; *(u32x2*)(rp + bj * 128 + n * 16) = pack4(v); } }
        }
    }
};
struct EpiMlaA {
    const float* SSQ; bf16* CQ; bf16* CKV; bf16* KR; float* SSQQ; float* SSQKV; const float* ct; const float* st;
    __device__ __forceinline__ void operator()(const Acc& acc, const Unit& u, int wr, int wc, int fr, int fq) const {
        float rsv_[2][4];
#pragma unroll
        for (int ai = 0; ai < 2; ++ai)
#pragma unroll
            for (int m = 0; m < 4; ++m) { const int row = u.pm * 256 + ai * 128 + wr * 64 + m * 16 + fr; rsv_[ai][m] = slots16_part(SSQ, row, fq); }
#pragma unroll
        for (int ai = 0; ai < 2; ++ai)
#pragma unroll
            for (int m = 0; m < 4; ++m) rsv_[ai][m] = slots16_finish(rsv_[ai][m]);
        EPI_LOOP_BEGIN
            const int row = u.pm * 256 + rowt; const float rs = rsv_[ai][m];
            float sq = 0.f, skv = 0.f;
#pragma unroll
            for (int bj = 0; bj < 2; ++bj) {
                f32x4 v0 = acc[ai][bj][m][0] * rs, v1 = acc[ai][bj][m][1] * rs; const int col = u.pn * 256 + bj * 128 + wc * 32 + 4 * fq;
                const int seg = u.pn * 2 + bj;
                if (seg < 3) { sq += sumsq4(v0) + sumsq4(v1); bf16* p = CQ + (size_t)row * 384 + col; *(u32x2*)p = pack4(v0); *(u32x2*)(p + 16) = pack4(v1); }
                else if (seg < 5) { skv += sumsq4(v0) + sumsq4(v1); bf16* p = CKV + (size_t)row * 256 + (col - 384); *(u32x2*)p = pack4(v0); *(u32x2*)(p + 16) = pack4(v1); }
                else if (wc < 2) { rope4(v0, v1, ct, st, row & (SEQ - 1), wc * 16 + 4 * fq); unsigned char* p = (unsigned char*)KR + (size_t)row * 64 + wc * 32 + 4 * fq; v0 *= K8_SCALE; v1 *= K8_SCALE;
                    *(unsigned*)p = pk_fp8x4(v0[0], v0[1], v0[2], v0[3]); *(unsigned*)(p + 16) = pk_fp8x4(v1[0], v1[1], v1[2], v1[3]); }
            }
            sq += __shfl_xor(sq, 16); sq += __shfl_xor(sq, 32); skv += __shfl_xor(skv, 16); skv += __shfl_xor(skv, 32);
            if (fq == 0) {
                if (u.pn == 0) SSQQ[(size_t)row * 8 + wc] = sq;
                else if (u.pn == 1) { SSQQ[(size_t)row * 8 + 4 + wc] = sq; SSQKV[(size_t)row * 8 + wc] = skv; }
                else SSQKV[(size_t)row * 8 + 4 + wc] = skv;
            }
        EPI_LOOP_END
    }
};
struct EpiMlaQ {
    const float* SSQQ; bf16* Q; const float* ct; const float* st;
    __device__ __forceinline__ void operator()(const Acc& acc, const Unit& u, int wr, int wc, int fr, int fq) const {
        float rsv_[2][4];
#pragma unroll
        for (int ai = 0; ai < 2; ++ai)
#pragma unroll
            for (int m = 0; m < 4; ++m) { const int row = u.pm * 256 + ai * 128 + wr * 64 + m * 16 + fr; rsv_[ai][m] = slots8_part(SSQQ, row, fq); }
#pragma unroll
        for (int ai = 0; ai < 2; ++ai)
#pragma unroll
            for (int m = 0; m < 4; ++m) rsv_[ai][m] = slots8_finish(rsv_[ai][m], 1.0f / 384.0f);
        EPI_LOOP_BEGIN
            const int row = u.pm * 256 + rowt; const float rs = rsv_[ai][m];
#pragma unroll
            for (int bj = 0; bj < 2; ++bj) {
                f32x4 v0 = acc[ai][bj][m][0] * rs, v1 = acc[ai][bj][m][1] * rs; const int g32 = u.pn * 8 + bj * 4 + wc, gi = g32 % 6;
                if (gi >= 4) rope4(v0, v1, ct, st, row & (SEQ - 1), (gi - 4) * 16 + 4 * fq);
                unsigned char* p = (unsigned char*)Q + (size_t)row * 1536 + g32 * 32 + 4 * fq; v0 *= Q8_SCALE; v1 *= Q8_SCALE;
                *(unsigned*)p = pk_fp8x4(v0[0], v0[1], v0[2], v0[3]); *(unsigned*)(p + 16) = pk_fp8x4(v1[0], v1[1], v1[2], v1[3]);
            }
        EPI_LOOP_END
    }
};
struct MlaKnSched { const bf16* A; const bf16* W; int K, ldb, G, c;
    __device__ __forceinline__ bool next(int i, Unit& u) const { const int L = i * G + c; if (L >= 512) return false;
        u.pn = L & 3; u.pm = L >> 2; u.aux = 0; u.a = (const char*)(A + (size_t)u.pm * 256 * 256); u.b = (const char*)(W + (size_t)(2 * u.pn) * 256 * 256); return true; }
    __device__ __forceinline__ unsigned aoff(const Unit&, int half, int R, int Cc) const { return (unsigned)((R + 128 * half) * 256 + Cc) * 2u; }
    __device__ __forceinline__ unsigned boff(int R, int Cc) const { return (unsigned)(R * 256 + Cc) * 2u; }
    __device__ __forceinline__ size_t hstepB() const { return (size_t)256 * 256 * 2; } };
struct EpiMlaKN {
    const float* SSQKV; unsigned char* KN;
    __device__ __forceinline__ void operator()(const Acc& acc, const Unit& u, int wr, int wc, int fr, int fq) const {
        float rsv_[2][4];
#pragma unroll
        for (int ai = 0; ai < 2; ++ai)
#pragma unroll
            for (int m = 0; m < 4; ++m) { const int row = u.pm * 256 + ai * 128 + wr * 64 + m * 16 + fr; rsv_[ai][m] = slots8_part(SSQKV, row, fq); }
#pragma unroll
        for (int ai = 0; ai < 2; ++ai)
#pragma unroll
            for (int m = 0; m < 4; ++m) rsv_[ai][m] = slots8_finish(rsv_[ai][m], 1.0f / 256.0f) * K8_SCALE;
        EPI_LOOP_BEGIN
            const int row = u.pm * 256 + rowt; const float rs = rsv_[ai][m];
            unsigned char* rp = KN + (size_t)row * 1024 + (2 * u.pn) * 128 + wc * 32 + 4 * fq;
#pragma unroll
            for (int bj = 0; bj < 2; ++bj) { const f32x4 v0 = acc[ai][bj][m][0] * rs, v1 = acc[ai][bj][m][1] * rs;
                *(unsigned*)(rp + bj * 128) = pk_fp8x4(v0[0], v0[1], v0[2], v0[3]); *(unsigned*)(rp + bj * 128 + 16) = pk_fp8x4(v1[0], v1[1], v1[2], v1[3]); }
        EPI_LOOP_END
    }
};
struct MlaVtSched { const bf16* W; const bf16* Bm; int K, ldb, G, c;
    __device__ __forceinline__ bool next(int i, Unit& u) const { const int L = i * G + c; if (L >= 512) return false;
        u.pn = L >> 2; u.pm = L & 3; u.aux = 0; u.a = (const char*)(W + ((size_t)(2 * u.pm) * 256 + 128) * 256); u.b = (const char*)(Bm + (size_t)u.pn * 256 * 256); return true; }
    __device__ __forceinline__ unsigned aoff(const Unit&, int half, int R, int Cc) const { return (unsigned)((R + 256 * half) * 256 + Cc) * 2u; }
    __device__ __forceinline__ unsigned boff(int R, int Cc) const { return (unsigned)(R * 256 + Cc) * 2u; }
    __device__ __forceinline__ size_t hstepB() const { return (size_t)128 * 256 * 2; } };
struct EpiMlaVT {
    const float* SSQKV; unsigned char* VT;
    __device__ __forceinline__ void operator()(const Acc& acc, const Unit& u, int wr, int wc, int fr, int fq) const {
        f32x4 rs[2][2];
#pragma unroll
        for (int bj = 0; bj < 2; ++bj)
#pragma unroll
            for (int n = 0; n < 2; ++n)
#pragma unroll
                for (int i = 0; i < 4; ++i) rs[bj][n][i] = rstd_from_slots8(SSQKV, u.pn * 256 + bj * 128 + wc * 32 + n * 16 + 4 * fq + i, 1.0f / 256.0f) * ATT8_SCALE;
        const int tok0 = u.pn * 256 + wc * 32 + 4 * fq, b = tok0 >> 13, s0 = tok0 & (SEQ - 1);
        EPI_LOOP_BEGIN
            const int head = 2 * u.pm + ai, d = wr * 64 + m * 16 + fr;
            unsigned char* rp = VT + ((size_t)(b * 8 + head) * 128 + d) * SEQ + s0;
#pragma unroll
            for (int bj = 0; bj < 2; ++bj) { const f32x4 v0 = acc[ai][bj][m][0] * rs[bj][0], v1 = acc[ai][bj][m][1] * rs[bj][1];
                *(unsigned*)(rp + bj * 128) = pk_fp8x4(v0[0], v0[1], v0[2], v0[3]); *(unsigned*)(rp + bj * 128 + 16) = pk_fp8x4(v1[0], v1[1], v1[2], v1[3]); }
        EPI_LOOP_END
    }
};
struct FnetTSched { const bf16* Fch; const bf16* HB; int K, ldb, G, c;
    __device__ __forceinline__ bool next(int i, Unit& u) const { const int L = i * G + c; if (L >= 1024) return false;
        const int pn = L & 31, pm = (L >> 5) & 1, g = (L >> 6) & 3, b = L >> 8; u.pm = pm; u.pn = pn; u.aux = b * 4 + g;
        u.a = (const char*)(Fch + (size_t)(g * 512 + pm * 256) * 256); u.b = (const char*)(HB + ((size_t)(b * SEQ + pn * 2)) * 1024 + g * 256); return true; }
    __device__ __forceinline__ unsigned aoff(const Unit&, int half, int R, int Cc) const { return (unsigned)((R + 128 * half) * 256 + Cc) * 2u; }
    __device__ __forceinline__ unsigned boff(int R, int Cc) const { return (unsigned)(R * 64 * 1024 + Cc) * 2u; }
    __device__ __forceinline__ size_t hstepB() const { return (size_t)1024 * 2; } };
struct EpiFnetT {
    const float* SSQ; bf16* TT;
    __device__ __forceinline__ void operator()(const Acc& acc, const Unit& u, int wr, int wc, int fr, int fq) const {
        const int b = u.aux >> 2, g = u.aux & 3;
        f32x4 rs[2][2];
#pragma unroll
        for (int bj = 0; bj < 2; ++bj)
#pragma unroll
            for (int n = 0; n < 2; ++n)
#pragma unroll
                for (int i = 0; i < 4; ++i) rs[bj][n][i] = rstd_from_slots16(SSQ, b * SEQ + (wc * 32 + n * 16 + 4 * fq + i) * 64 + u.pn * 2 + bj);
        EPI_LOOP_BEGIN
            const int f = u.pm * 256 + rowt, part = f >> 8, j = f & 255;
#pragma unroll
            for (int bj = 0; bj < 2; ++bj) {
                bf16* rp = TT + (((size_t)(b * 1024 + g * 256 + j) * 64 + u.pn * 2 + bj) * 2 + part) * 128 + wc * 32 + 4 * fq;
                *(u32x2*)rp = pack4(acc[ai][bj][m][0] * rs[bj][0]); *(u32x2*)(rp + 16) = pack4(acc[ai][bj][m][1] * rs[bj][1]); }
        EPI_LOOP_END
    }
};
struct FnetConstASched { const bf16* W; const bf16* Bm; int K, ldb, nunits, G, c;
    __device__ __forceinline__ bool next(int i, Unit& u) const { const int L = i * G + c; if (L >= nunits) return false;
        u.pm = 0; u.pn = L; u.aux = 0; u.a = (const char*)W; u.b = (const char*)(Bm + (size_t)L * 256 * ldb); return true; }
    __device__ __forceinline__ unsigned aoff(const Unit&, int half, int R, int Cc) const { return (unsigned)((R + 128 * half) * K + Cc) * 2u; }
    __device__ __forceinline__ unsigned boff(int R, int Cc) const { return (unsigned)(R * ldb + Cc) * 2u; }
    __device__ __forceinline__ size_t hstepB() const { return (size_t)128 * ldb * 2; } };
struct EpiFnet1 {
    bf16* Z; const float* twc; const float* tws;
    __device__ __forceinline__ void operator()(const Acc& acc, const Unit& u, int wr, int wc, int fr, int fq) const {
        f32x4 tc_[4][2], tn_[4][2];
#pragma unroll
        for (int m = 0; m < 4; ++m)
#pragma unroll
            for (int n = 0; n < 2; ++n) { const int k1 = wr * 64 + m * 16 + fr, s2 = (wc * 32 + n * 16 + 4 * fq) & 63; tc_[m][n] = *(const f32x4*)(twc + k1 * 64 + s2); tn_[m][n] = *(const f32x4*)(tws + k1 * 64 + s2); }
#pragma unroll
        for (int m = 0; m < 4; ++m) { const int k1 = wr * 64 + m * 16 + fr;
#pragma unroll
            for (int bj = 0; bj < 2; ++bj)
#pragma unroll
                for (int n = 0; n < 2; ++n) {
                    const int nrow = u.pn * 256 + bj * 128 + wc * 32 + n * 16 + 4 * fq, s2 = nrow & 63, c = (nrow >> 6) & 1023, b = nrow >> 16;
                    const f32x4 cs = tc_[m][n], sn = tn_[m][n];
                    const f32x4 zr = acc[0][bj][m][n], zi = acc[1][bj][m][n];
                    const f32x4 orr = zr * cs + zi * sn, oi = zi * cs - zr * sn;
                    bf16* p = Z + ((((size_t)(b * 128 + k1) * 1024 + c) * 2) * 64) + s2;
                    *(u32x2*)p = pack4(orr); *(u32x2*)(p + 64) = pack4(oi); }
        }
    }
};
struct EpiFnet2 {
    unsigned char* F; float scale;
    __device__ __forceinline__ void operator()(const Acc& acc, const Unit& u, int wr, int wc, int fr, int fq) const {
        if (wr != 0) return;
#pragma unroll
        for (int m = 0; m < 4; ++m) { const int k2 = m * 16 + fr;
#pragma unroll
            for (int bj = 0; bj < 2; ++bj)
#pragma unroll
                for (int n = 0; n < 2; ++n) {
                    const int nrow = u.pn * 256 + bj * 128 + wc * 32 + n * 16 + 4 * fq, c = nrow & 1023, k1 = (nrow >> 10) & 127, b = nrow >> 17;
                    const f32x4 v = acc[0][bj][m][n] * scale; *(unsigned*)(F + ((size_t)b * SEQ + k1 + 128 * k2) * 1024 + c) = pk_fp8x4(v[0], v[1], v[2], v[3]); }
        }
    }
};
__device__ __forceinline__ float gelu_tanh(float x) {
    const float u = x * (0.7978845608028654f + 0.035677408136300125f * x * x);
    return x * fast_rcp(1.0f + fast_exp2(-2.8853900817779268f * u));
}
struct EpiGmlpIn {
    const float* SSQ; bf16* U; bf16* V; float* SSQV; float sc;
    __device__ __forceinline__ void operator()(const Acc& acc, const Unit& u, int wr, int wc, int fr, int fq) const {
        const bool isv = u.pn >= 8; bf16* O = isv ? V : U; const int colt = (isv ? u.pn - 8 : u.pn) * 256 + wc * 32 + 4 * fq;
        float rsv_[2][4];
#pragma unroll
        for (int ai = 0; ai < 2; ++ai)
#pragma unroll
            for (int m = 0; m < 4; ++m) { const int row = u.pm * 256 + ai * 128 + wr * 64 + m * 16 + fr; rsv_[ai][m] = slots16_part(SSQ, row, fq); }
#pragma unroll
        for (int ai = 0; ai < 2; ++ai)
#pragma unroll
            for (int m = 0; m < 4; ++m) rsv_[ai][m] = slots16_finish(rsv_[ai][m]) * sc;
        EPI_LOOP_BEGIN
            const int row = u.pm * 256 + rowt; const float rs = rsv_[ai][m]; float sv = 0.f;
            bf16* rp = O + (size_t)row * 2048 + colt;
#pragma unroll
            for (int bj = 0; bj < 2; ++bj)
#pragma unroll
                for (int n = 0; n < 2; ++n) { f32x4 v = acc[ai][bj][m][n] * rs;
#pragma unroll
                    for (int i = 0; i < 4; ++i) v[i] = gelu_tanh(v[i]);
                    sv += sumsq4(v); *(u32x2*)(rp + bj * 128 + n * 16) = pack4(v); }
            if (isv) { sv += __shfl_xor(sv, 16); sv += __shfl_xor(sv, 32); if (fq == 0) SSQV[(size_t)row * 32 + (u.pn - 8) * 4 + wc] = sv; }
        EPI_LOOP_END
    }
};
struct EpiDilQkv {
    const float* SSQ; bf16* QKV; const float* ct; const float* st; float sc;
    __device__ __forceinline__ void operator()(const Acc& acc, const Unit& u, int wr, int wc, int fr, int fq) const {
        float rsv_[2][4];
#pragma unroll
        for (int ai = 0; ai < 2; ++ai)
#pragma unroll
            for (int m = 0; m < 4; ++m) { const int row = u.pm * 256 + ai * 128 + wr * 64 + m * 16 + fr; rsv_[ai][m] = slots16_part(SSQ, row, fq); }
#pragma unroll
        for (int ai = 0; ai < 2; ++ai)
#pragma unroll
            for (int m = 0; m < 4; ++m) rsv_[ai][m] = slots16_finish(rsv_[ai][m]) * sc;
        const int tq = (u.pn >> 1) % 3;
        f32x4 rc_[2][4], rn_[2][4];
        if (tq < 2) {
#pragma unroll
            for (int ai = 0; ai < 2; ++ai)
#pragma unroll
                for (int m = 0; m < 4; ++m) { const int pos = (u.pm * 256 + ai * 128 + wr * 64 + m * 16 + fr) & (SEQ - 1), j0 = (wc & 1) * 16 + 4 * fq; rc_[ai][m] = *(const f32x4*)(ct + pos * 32 + j0); rn_[ai][m] = *(const f32x4*)(st + pos * 32 + j0); }
        }
        EPI_LOOP_BEGIN
            const int row = u.pm * 256 + rowt; const float rs = rsv_[ai][m];
#pragma unroll
            for (int bj = 0; bj < 2; ++bj) {
                f32x4 v0 = acc[ai][bj][m][0] * rs, v1 = acc[ai][bj][m][1] * rs; const int g32 = u.pn * 8 + bj * 4 + wc;
                if (tq < 2) { const f32x4 a_ = v0 * rc_[ai][m] - v1 * rn_[ai][m], b_ = v1 * rc_[ai][m] + v0 * rn_[ai][m]; v0 = a_; v1 = b_; if (tq == 0) { v0 *= 0.125f; v1 *= 0.125f; } }
                bf16* p = QKV + (size_t)row * 4608 + g32 * 32 + 4 * fq; *(u32x2*)p = pack4(v0); *(u32x2*)(p + 16) = pack4(v1);
            }
        EPI_LOOP_END
    }
};
struct EpiPle {
    bf16* H; const bf16* PP; float* SSQ; float scale; unsigned char* H8; float asc;
    __device__ __forceinline__ void operator()(const Acc& acc, const Unit& u, int wr, int wc, int fr, int fq) const {
        const int colb = u.pn * 256 + wc * 32 + 4 * fq;
#pragma unroll
        for (int ai = 0; ai < 2; ++ai) {
            u32x2 hv[4][2][2], pv[4][2][2];
#pragma unroll
            for (int m = 0; m < 4; ++m) { const size_t ro = (size_t)(u.pm * 256 + ai * 128 + wr * 64 + m * 16 + fr) * DM + colb;
#pragma unroll
                for (int bj = 0; bj < 2; ++bj)
#pragma unroll
                    for (int n = 0; n < 2; ++n) { hv[m][bj][n] = *(const u32x2*)(H + ro + bj * 128 + n * 16); pv[m][bj][n] = *(const u32x2*)(PP + ro + bj * 128 + n * 16); } }
#pragma unroll
            for (int m = 0; m < 4; ++m) { const int row = u.pm * 256 + ai * 128 + wr * 64 + m * 16 + fr; float ss = 0.f;
#pragma unroll
                for (int bj = 0; bj < 2; ++bj)
#pragma unroll
                    for (int n = 0; n < 2; ++n) {
                        const size_t o = (size_t)row * DM + colb + bj * 128 + n * 16; const f32x4 a = acc[ai][bj][m][n]; const f32x4 pp = unpack4(pv[m][bj][n]); f32x4 h = unpack4(hv[m][bj][n]);
#pragma unroll
                        for (int i = 0; i < 4; ++i) h[i] += scale * pp[i] * fast_rcp(1.0f + fast_exp2(asc * a[i]));
                        const u32x2 hw = pack4(h); *(u32x2*)(H + o) = hw; ss += sumsq4(unpack4(hw));
                        if (H8) *(unsigned*)(H8 + o) = pk_fp8x4(h[0] * XN8_SCALE, h[1] * XN8_SCALE, h[2] * XN8_SCALE, h[3] * XN8_SCALE);
                    }
                ss += __shfl_xor(ss, 16); ss += __shfl_xor(ss, 32);
                if (fq == 0) SSQ[(size_t)row * 16 + u.pn * 4 + wc] = ss; }
        }
    }
};

__device__ __forceinline__ void moe_tables(const Ctx& C, int layer) {
    LAS int* T = (LAS int*)(C.lds + LDS_TAB);
    if (C.tid < 32) T[C.tid] = (int)__hip_atomic_load((unsigned*)(C.ws + WS_CTL) + CW_CNT + layer * 32 + C.tid, __ATOMIC_RELAXED, __HIP_MEMORY_SCOPE_AGENT);
    __syncthreads();
    if (C.tid == 0) { int s = 0; for (int e = 0; e < 32; ++e) { T[32 + e] = s; s += (T[e] + 255) >> 8; } T[64] = s; }
    __syncthreads();
}
struct MoeSched1 {
    const unsigned char* XN; const unsigned char* W1; const u32x2* LIST; const LAS int* T; int K, ldb, G, c;
    __device__ __forceinline__ bool next(int i, Unit& u) const {
        const int L = i * G + c, ntile = __builtin_amdgcn_readfirstlane(T[64]); if (L >= ntile * 4) return false;
        const int tile = L >> 2; u.pn = L & 3; int e = 0;
#pragma unroll 1
        for (int j = 16; j >= 1; j >>= 1) if (e + j < 32 && T[32 + e + j] <= tile) e += j;
        e = __builtin_amdgcn_readfirstlane(e); const int t0 = __builtin_amdgcn_readfirstlane(T[32 + e]);
        u.aux = e; u.pm = tile - t0; u.a = (const char*)XN; u.b = (const char*)(W1 + (size_t)e * 1024 * 1024 + (size_t)u.pn * 256 * 1024); return true;
    }
    __device__ __forceinline__ unsigned aoff(const Unit& u, int half, int R, int C) const {
        const int r = u.pm * 256 + R + 128 * half; unsigned tok = 0; if (r < T[u.aux]) tok = LIST[(size_t)u.aux * MOE_CAP + r].x >> 1;
        return tok * 1024u + 2u * (unsigned)C;
    }
    __device__ __forceinline__ unsigned boff(int R, int C) const { return (unsigned)(R * 1024 + 2 * C); }
    __device__ __forceinline__ size_t hstepB() const { return (size_t)128 * 1024; }
};
struct EpiMoe1 {
    unsigned char* HBUF; const LAS int* T;
    __device__ __forceinline__ void operator()(const Acc& acc, const Unit& u, int wr, int wc, int fr, int fq) const {
        unsigned char* base = HBUF + (size_t)__builtin_amdgcn_readfirstlane(T[32 + u.aux] + u.pm) * (256 * 512) + 128 * u.pn; constexpr float sc = 1.0f / (XN8_SCALE * W8_SCALE);
        const unsigned lo = (unsigned)(32 * wc + 8 * fq);
        EPI_LOOP_BEGIN
            unsigned w[2];
#pragma unroll
            for (int bj = 0; bj < 2; ++bj) { const f32x4 g = acc[ai][bj][m][0] * sc, up = acc[ai][bj][m][1] * (sc * HB8_SCALE); f32x4 h;
#pragma unroll
                for (int i = 0; i < 4; ++i) h[i] = g[i] * fast_rcp(1.0f + fast_exp2(-1.4426950408889634f * g[i])) * up[i];
                w[bj] = pk_fp8x4(h[0], h[1], h[2], h[3]); }
            *(u32x2*)(base + ((unsigned)rowt * 512u + lo)) = (u32x2){w[0], w[1]};
        EPI_LOOP_END
    }
};
struct MoeSched2 {
    const unsigned char* HBUF; const unsigned char* W2; const LAS int* T; int K, ldb, G, c;
    __device__ __forceinline__ bool next(int i, Unit& u) const {
        const int L = i * G + c, ntile = __builtin_amdgcn_readfirstlane(T[64]); if (L >= ntile * 4) return false;
        const int tile = L >> 2; u.pn = L & 3; int e = 0;
#pragma unroll 1
        for (int j = 16; j >= 1; j >>= 1) if (e + j < 32 && T[32 + e + j] <= tile) e += j;
        e = __builtin_amdgcn_readfirstlane(e); const int t0 = __builtin_amdgcn_readfirstlane(T[32 + e]);
        u.aux = e; u.pm = tile - t0; u.a = (const char*)(HBUF + (size_t)tile * 256 * 512); u.b = (const char*)(W2 + (size_t)e * 1024 * 512 + (size_t)u.pn * 256 * 512); return true;
    }
    __device__ __forceinline__ unsigned aoff(const Unit&, int half, int R, int C) const { return (unsigned)((R + 128 * half) * 512 + 2 * C); }
    __device__ __forceinline__ unsigned boff(int R, int C) const { return (unsigned)(R * 512 + 2 * C); }
    __device__ __forceinline__ size_t hstepB() const { return (size_t)128 * 512; }
};
struct EpiMoe2 {
    bf16* YB; const u32x2* LIST; const LAS int* T;
    __device__ __forceinline__ void operator()(const Acc& acc, const Unit& u, int wr, int wc, int fr, int fq) const {
        const int cnt = T[u.aux];
        u32x2 ents[2][4];
#pragma unroll
        for (int ai = 0; ai < 2; ++ai)
#pragma unroll
            for (int m = 0; m < 4; ++m) { const int r = u.pm * 256 + ai * 128 + wr * 64 + m * 16 + fr; ents[ai][m] = LIST[(size_t)u.aux * MOE_CAP + (r < cnt ? r : 0)]; }
        EPI_LOOP_BEGIN
            const int r = u.pm * 256 + rowt;
            if (r < cnt) {
                const u32x2 ent = ents[ai][m]; const float w = __uint_as_float(ent.y) * (YB8_SCALE / (HB8_SCALE * W8_SCALE));
                unsigned char* rp = (unsigned char*)YB + (size_t)ent.x * 1024 + u.pn * 256 + wc * 32 + 4 * fq;
#pragma unroll
                for (int bj = 0; bj < 2; ++bj) { const f32x4 a0 = acc[ai][bj][m][0] * w, a1 = acc[ai][bj][m][1] * w; *(unsigned*)(rp + bj * 128) = pk_fp8x4(a0[0], a0[1], a0[2], a0[3]); *(unsigned*)(rp + bj * 128 + 16) = pk_fp8x4(a1[0], a1[1], a1[2], a1[3]); }
            }
        EPI_LOOP_END
    }
};

__device__ __forceinline__ void router_phase(const Ctx& C, int layer, const bool dry = false) {
    const bf16* H = (const bf16*)(C.ws + WS_HB); unsigned char* XN = C.ws + WS_XN; const u32x4* wp = (const u32x4*)(C.ws + WS_WPERM) + (size_t)layer * 32 * 64 * 6;
    const float* gain = C.in[I_NORM_MOE] + layer * 1024; const float* bgrp = C.in[I_MOE_BGRP] + layer * 4; const float* bexp = C.in[I_MOE_BEXP] + layer * 32;
    u32x2* LIST = (u32x2*)(C.ws + WS_LIST); unsigned* CNT = (unsigned*)(C.ws + WS_CTL) + CW_CNT + layer * 32;
    LAS float* lg = (LAS float*)(C.lds);
    LAS float* sq = (LAS float*)(C.lds + 32768);
    LAS int* hist = (LAS int*)(C.lds + 36864);
    LAS int* tk = (LAS int*)(C.lds + 40960);
    const int lane = C.lane, wave = C.wave;
    for (int chunk = C.bx; chunk < NTOK / 128; chunk += C.G) {
        const int tok0 = chunk * 128 + wave * 16;
        if (C.tid < 64) hist[C.tid] = 0;
        f32x4 acc0 = {0.f, 0.f, 0.f, 0.f}, acc1 = acc0, acc2 = acc0; float ss = 0.f;
        const bf16* hrow = H + (size_t)(tok0 + (lane & 15)) * DM + 8 * (lane >> 4);
        const u32x4* wl = wp + lane * 6;
#pragma unroll 1
        for (int half = 0; half < 2; ++half) {
            u32x4 hws[16];
#pragma unroll
            for (int s_ = 0; s_ < 16; ++s_) hws[s_] = *(const u32x4*)(hrow + (half * 16 + s_) * 32);
#pragma unroll
            for (int s_ = 0; s_ < 16; ++s_) { const int st = half * 16 + s_;
                const u32x4 hw = hws[s_]; const bf16x8 hv = __builtin_bit_cast(bf16x8, hw);
                ss += (bflo(hw.x) * bflo(hw.x) + bfhi(hw.x) * bfhi(hw.x)) + (bflo(hw.y) * bflo(hw.y) + bfhi(hw.y) * bfhi(hw.y)) + (bflo(hw.z) * bflo(hw.z) + bfhi(hw.z) * bfhi(hw.z)) + (bflo(hw.w) * bflo(hw.w) + bfhi(hw.w) * bfhi(hw.w));
                const u32x4* w6 = wl + st * 384;
                acc0 = __builtin_amdgcn_mfma_f32_16x16x32_bf16(hv, __builtin_bit_cast(bf16x8, w6[0]), acc0, 0, 0, 0); acc0 = __builtin_amdgcn_mfma_f32_16x16x32_bf16(hv, __builtin_bit_cast(bf16x8, w6[1]), acc0, 0, 0, 0);
                acc1 = __builtin_amdgcn_mfma_f32_16x16x32_bf16(hv, __builtin_bit_cast(bf16x8, w6[2]), acc1, 0, 0, 0); acc1 = __builtin_amdgcn_mfma_f32_16x16x32_bf16(hv, __builtin_bit_cast(bf16x8, w6[3]), acc1, 0, 0, 0);
                acc2 = __builtin_amdgcn_mfma_f32_16x16x32_bf16(hv, __builtin_bit_cast(bf16x8, w6[4]), acc2, 0, 0, 0); acc2 = __builtin_amdgcn_mfma_f32_16x16x32_bf16(hv, __builtin_bit_cast(bf16x8, w6[5]), acc2, 0, 0, 0); }
        }
        ss += __shfl_xor(ss, 16); ss += __shfl_xor(ss, 32);
        LAS float* lgw = lg + wave * 16 * 48;
#pragma unroll
        for (int r = 0; r < 4; ++r) { const int t = (lane >> 4) * 4 + r; lgw[t * 48 + (lane & 15)] = acc0[r]; lgw[t * 48 + 16 + (lane & 15)] = acc1[r]; lgw[t * 48 + 32 + (lane & 15)] = acc2[r]; }
        if (lane < 16) sq[wave * 16 + lane] = ss;
        __syncthreads();
        if (lane < 16) {
            const int t = lane; const float rs = __builtin_amdgcn_rsqf(sq[wave * 16 + t] * (1.0f / 1024.0f) + EPS); const LAS float* L = lgw + t * 48;
            float pgv[4]; float mx = -3.0e38f; int g = 0;
#pragma unroll
            for (int j = 0; j < 4; ++j) { pgv[j] = L[j] * rs + bgrp[j]; if (pgv[j] > mx) { mx = pgv[j]; g = j; } }
            float den = 0.f;
#pragma unroll
            for (int j = 0; j < 4; ++j) den += __expf(pgv[j] - mx);
            const float ggate = 1.0f / den;
            float v0 = -3.0e38f, v1 = -3.0e38f; int i0 = 0, i1 = 0;
#pragma unroll
            for (int j = 0; j < 8; ++j) { const float le = L[4 + g * 8 + j] * rs + bexp[g * 8 + j];
                if (le > v0) { v1 = v0; i1 = i0; v0 = le; i0 = j; } else if (le > v1) { v1 = le; i1 = j; } }
            const float e1 = __expf(v1 - v0); const float w0 = ggate / (1.0f + e1), w1 = ggate * e1 / (1.0f + e1);
            const int ex0 = g * 8 + i0, ex1 = g * 8 + i1;
            const int r0 = __hip_atomic_fetch_add(&hist[ex0], 1, __ATOMIC_RELAXED, __HIP_MEMORY_SCOPE_WORKGROUP), r1 = __hip_atomic_fetch_add(&hist[ex1], 1, __ATOMIC_RELAXED, __HIP_MEMORY_SCOPE_WORKGROUP);
            LAS int* T = tk + (wave * 16 + t) * 8; T[0] = ex0; T[1] = ex1; T[2] = r0; T[3] = r1; T[4] = (int)__float_as_uint(w0); T[5] = (int)__float_as_uint(w1);
            sq[wave * 16 + t] = rs;
        }
        __syncthreads();
        if (C.tid < 32) { const int n = hist[C.tid]; hist[32 + C.tid] = (n && !dry) ? (int)__hip_atomic_fetch_add(CNT + C.tid, (unsigned)n, __ATOMIC_RELAXED, __HIP_MEMORY_SCOPE_AGENT) : 0; }
        __syncthreads();
        if (C.tid < 128 && !dry) { const LAS int* T = tk + C.tid * 8; const unsigned tokid = (unsigned)(chunk * 128 + C.tid);
            LIST[(size_t)T[0] * MOE_CAP + hist[32 + T[0]] + T[2]] = (u32x2){tokid * 2u, (unsigned)T[4]};
            LIST[(size_t)T[1] * MOE_CAP + hist[32 + T[1]] + T[3]] = (u32x2){tokid * 2u + 1u, (unsigned)T[5]}; }
        { const f32x4* gr = (const f32x4*)gain + lane; const f32x4 g0 = gr[0], g1 = gr[64], g2 = gr[128], g3 = gr[192];
#pragma unroll 1
          for (int t = 0; t < 16; t += 4) {
            u32x2 hv[4][4];
#pragma unroll
            for (int tt = 0; tt < 4; ++tt) { const u32x2* hr = (const u32x2*)(H + (size_t)(tok0 + t + tt) * DM) + lane;
#pragma unroll
                for (int j = 0; j < 4; ++j) hv[tt][j] = hr[64 * j]; }
#pragma unroll
            for (int tt = 0; tt < 4; ++tt) { const float rs8 = sq[wave * 16 + t + tt] * XN8_SCALE; unsigned* xr = (unsigned*)(XN + (size_t)(tok0 + t + tt) * DM) + lane;
                const f32x4 a = unpack4(hv[tt][0]) * g0 * rs8, b = unpack4(hv[tt][1]) * g1 * rs8, c = unpack4(hv[tt][2]) * g2 * rs8, d = unpack4(hv[tt][3]) * g3 * rs8;
                xr[0] = pk_fp8x4(a[0], a[1], a[2], a[3]); xr[64] = pk_fp8x4(b[0], b[1], b[2], b[3]); xr[128] = pk_fp8x4(c[0], c[1], c[2], c[3]); xr[192] = pk_fp8x4(d[0], d[1], d[2], d[3]); }
          } }
        __syncthreads();
    }
}
__device__ __forceinline__ void combine_phase(const Ctx& C, const float* gain, const float scale) {
    bf16* H = (bf16*)(C.ws + WS_HB); unsigned char* XN = C.ws + WS_XN; const bf16* YB = (const bf16*)(C.ws + AR_YB);
    const int gw = C.bx * NWAVES + C.wave, NGW = C.G * NWAVES;
    const f32x4* gr = (const f32x4*)gain + C.lane; const f32x4 g0 = gr[0], g1 = gr[64], g2 = gr[128], g3 = gr[192];
    for (int row = gw; row < NTOK; row += 2 * NGW) {
        u32x2 hin[2][4]; unsigned ya[2][4], yb[2][4];
#pragma unroll
        for (int q = 0; q < 2; ++q) { const int rw = row + q * NGW; const u32x2* hr = (const u32x2*)(H + (size_t)rw * DM) + C.lane; const unsigned* y0 = (const unsigned*)((const unsigned char*)YB + (size_t)rw * 2048) + C.lane;
#pragma unroll
            for (int j = 0; j < 4; ++j) { hin[q][j] = hr[64 * j]; ya[q][j] = y0[64 * j]; yb[q][j] = y0[256 + 64 * j]; } }
#pragma unroll
        for (int q = 0; q < 2; ++q) { const int rw = row + q * NGW; u32x2* hr = (u32x2*)(H + (size_t)rw * DM) + C.lane; unsigned* xr = (unsigned*)(XN + (size_t)rw * DM) + C.lane;
            f32x4 v[4]; float s = 0.f;
#pragma unroll
            for (int j = 0; j < 4; ++j) { const unsigned a_ = ya[q][j], b_ = yb[q][j]; const f32x4 ys = {__builtin_amdgcn_cvt_f32_fp8(a_, 0) + __builtin_amdgcn_cvt_f32_fp8(b_, 0), __builtin_amdgcn_cvt_f32_fp8(a_, 1) + __builtin_amdgcn_cvt_f32_fp8(b_, 1), __builtin_amdgcn_cvt_f32_fp8(a_, 2) + __builtin_amdgcn_cvt_f32_fp8(b_, 2), __builtin_amdgcn_cvt_f32_fp8(a_, 3) + __builtin_amdgcn_cvt_f32_fp8(b_, 3)};
                const u32x2 hw = pack4(unpack4(hin[q][j]) + ys * (scale / YB8_SCALE)); hr[64 * j] = hw; v[j] = unpack4(hw); s += sumsq4(v[j]); }
            const float rs = __builtin_amdgcn_rsqf(wave_sum(s) * (1.0f / 1024.0f) + EPS) * XN8_SCALE;
            const f32x4 a = v[0] * g0 * rs, b = v[1] * g1 * rs, c = v[2] * g2 * rs, d = v[3] * g3 * rs;
            xr[0] = pk_fp8x4(a[0], a[1], a[2], a[3]); xr[64] = pk_fp8x4(b[0], b[1], b[2], b[3]); xr[128] = pk_fp8x4(c[0], c[1], c[2], c[3]); xr[192] = pk_fp8x4(d[0], d[1], d[2], d[3]); }
    }
}
__device__ __forceinline__ void final_phase(const Ctx& C) {
    const bf16* H = (const bf16*)(C.ws + WS_HB); const float* gain = C.in[I_NORM_FINAL];
    const int gw = C.bx * NWAVES + C.wave, NGW = C.G * NWAVES;
    const f32x4* gr = (const f32x4*)gain + C.lane; const f32x4 g0 = gr[0], g1 = gr[64], g2 = gr[128], g3 = gr[192];
    for (int row0 = gw; row0 < NTOK; row0 += 4 * NGW) {
        u32x2 hv[4][4];
#pragma unroll
        for (int q = 0; q < 4; ++q) { const u32x2* hr = (const u32x2*)(H + (size_t)(row0 + q * NGW) * DM) + C.lane;
#pragma unroll
            for (int j = 0; j < 4; ++j) hv[q][j] = hr[64 * j]; }
#pragma unroll
        for (int q = 0; q < 4; ++q) { f32x4* o = (f32x4*)(C.out + (size_t)(row0 + q * NGW) * DM) + C.lane;
            f32x4 v[4]; float s = 0.f;
#pragma unroll
            for (int j = 0; j < 4; ++j) { v[j] = unpack4(hv[q][j]); s += sumsq4(v[j]); }
            const float rs = __builtin_amdgcn_rsqf(wave_sum(s) * (1.0f / 1024.0f) + EPS);
            o[0] = v[0] * g0 * rs; o[64] = v[1] * g1 * rs; o[128] = v[2] * g2 * rs; o[192] = v[3] * g3 * rs; }
    }
}
template <int OFF> __device__ __forceinline__ s16x4 tr_read_a(int addr) { s16x4 r; asm volatile("ds_read_b64_tr_b16 %0, %1 offset:%2" : "=&v"(r) : "v"(addr), "i"(OFF) : "memory"); return r; }
__device__ __forceinline__ void spatial_phase(const Ctx& C) {
    const bf16* U = (const bf16*)(C.ws + AR_U); const bf16* V = (const bf16*)(C.ws + AR_V); unsigned char* Gt = C.ws + AR_G; const float* SSQV = (const float*)(C.ws + AR_SSQV);
    const float* Ws = C.in[I_GM_WS]; const float* bs = C.in[I_GM_BS]; const float* nv = C.in[I_GM_NV];
    const int g = C.bx & 15, tid = C.tid, lane = C.lane, fr = lane & 15, fq = lane >> 4, wp = C.wave >> 1, wd = C.wave & 1;
    bf16x8 Af[2][4];
#pragma unroll
    for (int m = 0; m < 2; ++m)
#pragma unroll
        for (int ks = 0; ks < 4; ++ks) { const f32x4* src = (const f32x4*)(Ws + (size_t)g * 16384 + (32 * wp + 16 * m + fr) * 128 + 32 * ks + 8 * fq); const f32x4 x = src[0], y = src[1];
            u32x4 w = {cvt_pk_bf16(x[0], x[1]), cvt_pk_bf16(x[2], x[3]), cvt_pk_bf16(y[0], y[1]), cvt_pk_bf16(y[2], y[3])}; Af[m][ks] = *reinterpret_cast<bf16x8*>(&w); }
    f32x4 nvv[4];
#pragma unroll
    for (int n = 0; n < 4; ++n) nvv[n] = *(const f32x4*)(nv + g * 128 + 64 * wd + 16 * fq + 4 * n);
    const float bias0 = bs[g * 128 + 32 * wp + fr], bias1 = bs[g * 128 + 32 * wp + 16 + fr];
    const int qq = fr >> 2, pcol = fr & 3;
    int tra[4];
#pragma unroll
    for (int n = 0; n < 4; ++n) tra[n] = (int)(uintptr_t)C.lds + (8 * fq + qq) * 256 + ((128 * wd + 32 * pcol + 8 * n) ^ ((qq << 3) | ((fq & 1) << 7)));
    const int sq = tid >> 2, sc0 = (tid & 3) * 4, sswz = ((sq & 3) << 3) | (((sq >> 3) & 1) << 7);
    u32x4 vreg[4]; float rsv;
#define SP_LOAD(chunk) do { const int tok_ = (chunk) * 128 + sq; const f32x4* sp_ = (const f32x4*)(SSQV + (size_t)tok_ * 32) + (tid & 3) * 2; const f32x4 a_ = sp_[0], b_ = sp_[1]; \
        float s_ = ((a_[0] + a_[1]) + (a_[2] + a_[3])) + ((b_[0] + b_[1]) + (b_[2] + b_[3])); s_ += __shfl_xor(s_, 1); s_ += __shfl_xor(s_, 2); rsv = __builtin_amdgcn_rsqf(s_ * (1.0f / 2048.0f) + EPS); \
        const u32x4* vp_ = (const u32x4*)(V + (size_t)tok_ * 2048 + g * 128 + sc0 * 8); _Pragma("unroll") for (int j = 0; j < 4; ++j) vreg[j] = vp_[j]; } while (0)
#define SP_WRITE() do { _Pragma("unroll") for (int j = 0; j < 4; ++j) { const u32x4 w_ = vreg[j]; \
        const u32x2 lo_ = {cvt_pk_bf16(bflo(w_.x) * rsv, bfhi(w_.x) * rsv), cvt_pk_bf16(bflo(w_.y) * rsv, bfhi(w_.y) * rsv)}, hi_ = {cvt_pk_bf16(bflo(w_.z) * rsv, bfhi(w_.z) * rsv), cvt_pk_bf16(bflo(w_.w) * rsv, bfhi(w_.w) * rsv)}; \
        const int cb_ = (sc0 + j) * 16; *(LAS u32x2*)(C.lds + sq * 256 + (cb_ ^ sswz)) = lo_; *(LAS u32x2*)(C.lds + sq * 256 + ((cb_ + 8) ^ sswz)) = hi_; } } while (0)
    int chunk = C.bx >> 4; const int cstep = C.G >> 4;
    if (chunk < NTOK / 128) SP_LOAD(chunk);
    for (; chunk < NTOK / 128; chunk += cstep) {
        __syncthreads();
        SP_WRITE();
        __syncthreads();
        if (chunk + cstep < NTOK / 128) SP_LOAD(chunk + cstep);
        f32x4 acc[2][4];
#pragma unroll
        for (int m = 0; m < 2; ++m)
#pragma unroll
            for (int n = 0; n < 4; ++n) acc[m][n] = (f32x4){0.f, 0.f, 0.f, 0.f};
#define SP_KS(KS) do { bf16x8 Bf[4]; _Pragma("unroll") for (int n = 0; n < 4; ++n) { const s16x4 l_ = tr_read_a<(KS) * 8192>(tra[n]), h_ = tr_read_a<(KS) * 8192 + 1024>(tra[n]); \
            Bf[n] = (bf16x8){l_[0], l_[1], l_[2], l_[3], h_[0], h_[1], h_[2], h_[3]}; } \
        asm volatile("s_waitcnt lgkmcnt(0)" ::: "memory"); SBAR(); \
        _Pragma("unroll") for (int m = 0; m < 2; ++m) _Pragma("unroll") for (int n = 0; n < 4; ++n) acc[m][n] = __builtin_amdgcn_mfma_f32_16x16x32_bf16(Bf[n], Af[m][KS], acc[m][n], 0, 0, 0); } while (0)
        SP_KS(0); SP_KS(1); SP_KS(2); SP_KS(3);
#undef SP_KS
#pragma unroll
        for (int m = 0; m < 2; ++m) { const int p = 32 * wp + 16 * m + fr; const float bias = m == 0 ? bias0 : bias1;
            const size_t o = (size_t)(chunk * 128 + p) * 2048 + g * 128 + 64 * wd + 16 * fq;
            const u32x4 u0 = *(const u32x4*)(U + o), u1 = *(const u32x4*)(U + o + 8);
            const f32x4 s0 = (acc[m][0] * nvv[0] + bias) * G8_SCALE, s1 = (acc[m][1] * nvv[1] + bias) * G8_SCALE, s2 = (acc[m][2] * nvv[2] + bias) * G8_SCALE, s3 = (acc[m][3] * nvv[3] + bias) * G8_SCALE;
            const u32x4 o8 = {pk_fp8x4(bflo(u0.x) * s0[0], bfhi(u0.x) * s0[1], bflo(u0.y) * s0[2], bfhi(u0.y) * s0[3]), pk_fp8x4(bflo(u0.z) * s1[0], bfhi(u0.z) * s1[1], bflo(u0.w) * s1[2], bfhi(u0.w) * s1[3]),
                              pk_fp8x4(bflo(u1.x) * s2[0], bfhi(u1.x) * s2[1], bflo(u1.y) * s2[2], bfhi(u1.y) * s2[3]), pk_fp8x4(bflo(u1.z) * s3[0], bfhi(u1.z) * s3[1], bflo(u1.w) * s3[2], bfhi(u1.w) * s3[3])};
            *(u32x4*)(Gt + o) = o8; }
    }
#undef SP_LOAD
#undef SP_WRITE
    __syncthreads();
}

namespace mla {
constexpr int DQK = 192, DV = 128, KVBLK = 64;
constexpr float SCALE = 0.07216878364870322f;
constexpr float THR = 8.f;
constexpr int SHM_V = KVBLK * DV * 2, SHM_K = KVBLK * DQK * 2;
#define KSWZ(row, colB) ((row) * 384 + ((colB) ^ ((((row) >> 1) & 7) << 4)))
__device__ __forceinline__ int crow(int r, int hi) { return (r & 3) + 8 * (r >> 2) + 4 * hi; }
__device__ __forceinline__ void partialSM(f32x16& p0, f32x16& p1, float& m_reg, float& mn, float& alpha) {
    constexpr float Cc = SCALE * 1.4426950408889634f;
    float pmax = p0[0];
#pragma unroll
    for (int r = 1; r < 16; ++r) pmax = fmaxf(pmax, p0[r]);
#pragma unroll
    for (int r = 0; r < 16; ++r) pmax = fmaxf(pmax, p1[r]);
    { auto rr = __builtin_amdgcn_permlane32_swap(__float_as_uint(pmax), __float_as_uint(pmax), false, false); pmax = fmaxf(__uint_as_float(rr[0]), __uint_as_float(rr[1])); }
    if (__builtin_expect(__all(pmax - m_reg <= THR / SCALE), 1)) { mn = m_reg; alpha = 1.f; }
    else { mn = fmaxf(m_reg, pmax); alpha = __builtin_amdgcn_exp2f((m_reg - mn) * Cc); m_reg = mn; }
    const float mnC = -mn * Cc;
#pragma unroll
    for (int r = 0; r < 16; ++r) p0[r] = fmaf(p0[r], Cc, mnC);
#pragma unroll
    for (int r = 0; r < 16; ++r) p1[r] = fmaf(p1[r], Cc, mnC);
#pragma unroll
    for (int r = 0; r < 16; ++r) p0[r] = __builtin_amdgcn_exp2f(p0[r]);
}
__device__ __forceinline__ void finishSM(f32x16& p0, f32x16& p1, float alpha, float& l_reg, bf16x8& pa0, bf16x8& pa1, bf16x8& pa2, bf16x8& pa3) {
#pragma unroll
    for (int r = 0; r < 16; ++r) p1[r] = __builtin_amdgcn_exp2f(p1[r]);
    float ps = 0;
#pragma unroll
    for (int r = 0; r < 16; ++r) ps += p0[r];
#pragma unroll
    for (int r = 0; r < 16; ++r) ps += p1[r];
    { auto rr = __builtin_amdgcn_permlane32_swap(__float_as_uint(ps), __float_as_uint(ps), false, false); ps = __uint_as_float(rr[0]) + __uint_as_float(rr[1]); }
    l_reg = l_reg * alpha + ps;
#define PK4(P, BASE, OUT) do { unsigned a0 = cvt_pk_bf16(P[BASE + 0], P[BASE + 1]), a1 = cvt_pk_bf16(P[BASE + 2], P[BASE + 3]);   \
    unsigned b0 = cvt_pk_bf16(P[BASE + 4], P[BASE + 5]), b1 = cvt_pk_bf16(P[BASE + 6], P[BASE + 7]);                              \
    auto r0 = __builtin_amdgcn_permlane32_swap(a0, b0, false, false); auto r1 = __builtin_amdgcn_permlane32_swap(a1, b1, false, false); \
    u32x4 w = {r0[0], r1[0], r0[1], r1[1]}; OUT = *reinterpret_cast<bf16x8*>(&w); } while (0)
    PK4(p0, 0, pa0); PK4(p0, 8, pa1); PK4(p1, 0, pa2); PK4(p1, 8, pa3);
#undef PK4
}
__device__ __forceinline__ void qkt(f32x16& p0, f32x16& p1, const char* Ks, const bf16x8* qr, int r32, int hi) {
    p0 = f32x16{}; p1 = f32x16{};
#pragma unroll
    for (int d0 = 0; d0 < 12; ++d0) { const int cb = (d0 * 16 + hi * 8) * 2;
        const bf16x8 b0 = *reinterpret_cast<const bf16x8*>(Ks + KSWZ(r32, cb));
        const bf16x8 b1 = *reinterpret_cast<const bf16x8*>(Ks + KSWZ(32 + r32, cb));
        p0 = __builtin_amdgcn_mfma_f32_32x32x16_bf16(b0, qr[d0], p0, 0, 0, 0);
        p1 = __builtin_amdgcn_mfma_f32_32x32x16_bf16(b1, qr[d0], p1, 0, 0, 0); }
}
__device__ __forceinline__ int v_st(int k, int c) { const int kk = (k & ~0xC) | ((k & 4) << 1) | ((k & 8) >> 1); return ((kk >> 3) * 4 + (c >> 5)) * 512 + ((kk & 7) * 32 + (c & 31)) * 2; }
__device__ __forceinline__ int v_rd_base(int lane) { return ((lane & 3) << 3) | (((lane >> 2) & 3) << 6) | (((lane >> 4) & 1) << 5) | (((lane >> 5) & 1) << 8); }
constexpr int v_rd_off(int d0, int ks, int half) { return d0 * 512 + ks * 4096 + half * 2048; }
template <int OFF> __device__ __forceinline__ s16x4 tr_read(int vb) { s16x4 r; asm volatile("ds_read_b64_tr_b16 %0, %1 offset:%2" : "=&v"(r) : "v"(vb), "i"(OFF) : "memory"); return r; }
template <int D0> __device__ __forceinline__ void pv_one(f32x16& od, int vb, bf16x8 pa0, bf16x8 pa1, bf16x8 pa2, bf16x8 pa3) {
    const s16x4 l0 = tr_read<v_rd_off(D0, 0, 0)>(vb), h0 = tr_read<v_rd_off(D0, 0, 1)>(vb), l1 = tr_read<v_rd_off(D0, 1, 0)>(vb), h1 = tr_read<v_rd_off(D0, 1, 1)>(vb);
    const s16x4 l2 = tr_read<v_rd_off(D0, 2, 0)>(vb), h2 = tr_read<v_rd_off(D0, 2, 1)>(vb), l3 = tr_read<v_rd_off(D0, 3, 0)>(vb), h3 = tr_read<v_rd_off(D0, 3, 1)>(vb);
    asm volatile("s_waitcnt lgkmcnt(0)" ::: "memory"); SBAR();
#define PK(L, H) (bf16x8){L[0], L[1], L[2], L[3], H[0], H[1], H[2], H[3]}
    od = __builtin_amdgcn_mfma_f32_32x32x16_bf16(pa0, PK(l0, h0), od, 0, 0, 0);
    od = __builtin_amdgcn_mfma_f32_32x32x16_bf16(pa1, PK(l1, h1), od, 0, 0, 0);
    od = __builtin_amdgcn_mfma_f32_32x32x16_bf16(pa2, PK(l2, h2), od, 0, 0, 0);
    od = __builtin_amdgcn_mfma_f32_32x32x16_bf16(pa3, PK(l3, h3), od, 0, 0, 0);
#undef PK
}
__device__ __forceinline__ void pv_d0(f32x16* o, int vb, bf16x8 pa0, bf16x8 pa1, bf16x8 pa2, bf16x8 pa3) {
    pv_one<0>(o[0], vb, pa0, pa1, pa2, pa3); pv_one<1>(o[1], vb, pa0, pa1, pa2, pa3); pv_one<2>(o[2], vb, pa0, pa1, pa2, pa3); pv_one<3>(o[3], vb, pa0, pa1, pa2, pa3);
}
__device__ __forceinline__ void attn_unit(const int tid, const bf16* Q, const bf16* KV, const bf16* KR, bf16* O, int b, int h, int qb, char* lds) {
    const int wid = tid >> 6, lane = tid & 63, r32 = lane & 31, hi = lane >> 5;
    char* V_lds = lds; char* K_lds = lds + 2 * SHM_V;
    float* ws = (float*)(lds + 2 * SHM_V + 2 * SHM_K) + wid * 64; float* li_l = ws; float* al_l = ws + 32;
    float m_reg = -1e30f, l_reg = 0; f32x16 o[4] = {}; bf16x8 qr[12];
    const size_t tokb = (size_t)b * SEQ;
    { const char* Qw = (const char*)(Q + (tokb + qb * 256 + __builtin_amdgcn_readfirstlane(wid) * 32) * 1536 + h * 192); const unsigned qo = (unsigned)(r32 * 1536 + hi * 8) * 2u;
#pragma unroll
      for (int d0 = 0; d0 < 12; ++d0) qr[d0] = *reinterpret_cast<const bf16x8*>(Qw + qo + d0 * 32); }
    const int sr = tid >> 4, sc = (tid & 15) * 8, vst0 = v_st(sr, sc), vst1 = v_st(32 + sr, sc);
    const int rr = tid >> 3, rc = (tid & 7) * 8;
    const int vb0 = (int)(uintptr_t)V_lds + v_rd_base(lane);
    const char* Kn = (const char*)(KV + tokb * 2048 + h * 256); const char* Kr = (const char*)(KR + tokb * 64);
    const unsigned ko0 = (unsigned)(sr * 2048 + sc) * 2u, ko1 = ko0 + 32u * 2048u * 2u, kro = (unsigned)(rr * 64 + rc) * 2u;
    bf16x8 sv0, sv1, sk0, sk1, skr;
#define SLOAD(k0) do { const char* kb_ = Kn + (size_t)(k0) * 4096; const char* rb_ = Kr + (size_t)(k0) * 128; \
    sv0 = *reinterpret_cast<const bf16x8*>(kb_ + 256 + ko0); sv1 = *reinterpret_cast<const bf16x8*>(kb_ + 256 + ko1); \
    sk0 = *reinterpret_cast<const bf16x8*>(kb_ + ko0); sk1 = *reinterpret_cast<const bf16x8*>(kb_ + ko1); \
    skr = *reinterpret_cast<const bf16x8*>(rb_ + kro); } while (0)
#define SWRITE(bb) do { *(bf16x8*)(V_lds + (bb) * SHM_V + vst0) = sv0; *(bf16x8*)(V_lds + (bb) * SHM_V + vst1) = sv1; const int kc = sc * 2; \
    *(bf16x8*)(K_lds + (bb) * SHM_K + KSWZ(sr, kc)) = sk0; *(bf16x8*)(K_lds + (bb) * SHM_K + KSWZ(32 + sr, kc)) = sk1; \
    *(bf16x8*)(K_lds + (bb) * SHM_K + KSWZ(rr, 256 + rc * 2)) = skr; } while (0)
#define RESC(a) do { if (__any((a) < 1.f)) { if (hi == 0) al_l[r32] = (a); asm volatile("s_waitcnt lgkmcnt(0)" ::: "memory"); \
    _Pragma("unroll") for (int d = 0; d < 4; ++d) _Pragma("unroll") for (int r = 0; r < 16; ++r) o[d][r] *= al_l[crow(r, hi)]; } } while (0)
    f32x16 p0, p1; float mn, al; bf16x8 pa0, pa1, pa2, pa3; constexpr int NT = SEQ / KVBLK;
    SLOAD(0); asm volatile("s_waitcnt vmcnt(0)" ::: "memory"); SWRITE(0); __syncthreads();
#pragma unroll 1
    for (int j = 0; j < NT; j += 2) {
        SLOAD((j + 1) * KVBLK); SBAR();
        qkt(p0, p1, K_lds, qr, r32, hi); partialSM(p0, p1, m_reg, mn, al); RESC(al);
        finishSM(p0, p1, al, l_reg, pa0, pa1, pa2, pa3); SBAR();
        pv_d0(o, vb0, pa0, pa1, pa2, pa3);
        asm volatile("s_waitcnt vmcnt(0)" ::: "memory"); SWRITE(1); __syncthreads();
        if (j + 2 < NT) SLOAD((j + 2) * KVBLK); SBAR();
        qkt(p0, p1, K_lds + SHM_K, qr, r32, hi); partialSM(p0, p1, m_reg, mn, al); RESC(al);
        finishSM(p0, p1, al, l_reg, pa0, pa1, pa2, pa3); SBAR();
        pv_d0(o, vb0 + SHM_V, pa0, pa1, pa2, pa3);
        if (j + 2 < NT) { asm volatile("s_waitcnt vmcnt(0)" ::: "memory"); SWRITE(0); } __syncthreads();
    }
    if (hi == 0) li_l[r32] = l_reg; asm volatile("s_waitcnt lgkmcnt(0)" ::: "memory");
    char* Ow = (char*)(O + (tokb + qb * 256 + __builtin_amdgcn_readfirstlane(wid) * 32) * 1024 + h * 128);
    const unsigned oo = (unsigned)(4 * hi * 1024 + r32) * 2u;
#pragma unroll
    for (int r = 0; r < 16; ++r) { const float rl = __builtin_amdgcn_rcpf(li_l[crow(r, hi)]);
#pragma unroll
        for (int d0 = 0; d0 < 4; ++d0) { const unsigned w = cvt_pk_bf16(o[d0][r] * rl, 0.f); *(bf16*)(Ow + oo + (unsigned)((((r & 3) + 8 * (r >> 2)) * 1024 + d0 * 32) * 2)) = (bf16)(w & 0xffffu); } }
    __syncthreads();
#undef SLOAD
#undef SWRITE
#undef RESC
}
constexpr int SLOT = SHM_K + SHM_V;
__device__ __forceinline__ void qkt_l(f32x16& p0, f32x16& p1, const LAS char* Ks, const bf16x8* qr, int r32, int hi) {
    p0 = f32x16{}; p1 = f32x16{};
#pragma unroll
    for (int d0 = 0; d0 < 12; ++d0) { const int cb = (d0 * 16 + hi * 8) * 2;
        const bf16x8 b0 = *reinterpret_cast<const LAS bf16x8*>(Ks + KSWZ(r32, cb));
        const bf16x8 b1 = *reinterpret_cast<const LAS bf16x8*>(Ks + KSWZ(32 + r32, cb));
        p0 = __builtin_amdgcn_mfma_f32_32x32x16_bf16(b0, qr[d0], p0, 0, 0, 0);
        p1 = __builtin_amdgcn_mfma_f32_32x32x16_bf16(b1, qr[d0], p1, 0, 0, 0); }
}
#define WAITBAR(N) asm volatile("s_waitcnt vmcnt(" #N ") lgkmcnt(0)\n\ts_barrier" ::: "memory")
__device__ __forceinline__ void attn_unit_g(const int tid, const bf16* Q, const bf16* KV, const bf16* KR, bf16* O, int b, int h, int qb, LAS char* lds) {
    const int wid = __builtin_amdgcn_readfirstlane(tid >> 6), lane = tid & 63, r32 = lane & 31, hi = lane >> 5;
    LAS float* wsc = (LAS float*)(lds + 3 * SLOT) + wid * 64; LAS float* li_l = wsc; LAS float* al_l = wsc + 32;
    float m_reg = -1e30f, l_reg = 0; f32x16 o[4] = {}; bf16x8 qr[12];
    const size_t tokb = (size_t)b * SEQ;
    { const char* Qw = (const char*)(Q + (tokb + qb * 256 + wid * 32) * 1536 + h * 192); const unsigned qo = (unsigned)(r32 * 1536 + hi * 8) * 2u;
#pragma unroll
      for (int d0 = 0; d0 < 12; ++d0) qr[d0] = *reinterpret_cast<const bf16x8*>(Qw + qo + d0 * 32); }
    const char* Kn = (const char*)(KV + tokb * 2048 + h * 256); const char* Kr = (const char*)(KR + tokb * 64);
    unsigned koff[3], voff[2]; bool krope[3];
#pragma unroll
    for (int t = 0; t < 3; ++t) { const int p = (wid * 3 + t) * 64 + lane, row = p / 24, cp = p % 24, c = (cp & ~7) | ((cp ^ (row >> 1)) & 7);
        krope[t] = c >= 16; koff[t] = krope[t] ? (unsigned)(row * 128 + (c - 16) * 16) : (unsigned)(row * 4096 + c * 16); }
#pragma unroll
    for (int t = 0; t < 2; ++t) { const int p = (wid * 2 + t) * 64 + lane, sub = p >> 5, w = p & 31, kk = (sub >> 2) * 8 + (w >> 2), c = (sub & 3) * 32 + (w & 3) * 8;
        const int k = (kk & ~0xC) | ((kk & 4) << 1) | ((kk & 8) >> 1); voff[t] = (unsigned)(k * 4096 + 256 + c * 2); }
#define GLDS(k0, slot) do { const char* kb_ = Kn + (size_t)(k0) * 4096; const char* rb_ = Kr + (size_t)(k0) * 128; LAS char* kd_ = lds + (slot) * SLOT + wid * 3072; LAS char* vd_ = lds + (slot) * SLOT + SHM_K + wid * 2048; \
    _Pragma("unroll") for (int t_ = 0; t_ < 3; ++t_) { const char* src_ = (krope[t_] ? rb_ : kb_) + koff[t_]; __builtin_amdgcn_global_load_lds((const unsigned*)src_, (LAS unsigned*)(kd_ + t_ * 1024), 16, 0, 0); } \
    _Pragma("unroll") for (int t_ = 0; t_ < 2; ++t_) __builtin_amdgcn_global_load_lds((const unsigned*)(kb_ + voff[t_]), (LAS unsigned*)(vd_ + t_ * 1024), 16, 0, 0); } while (0)
#define RESC(a) do { if (__any((a) < 1.f)) { if (hi == 0) al_l[r32] = (a); asm volatile("s_waitcnt lgkmcnt(0)" ::: "memory"); \
    _Pragma("unroll") for (int d = 0; d < 4; ++d) _Pragma("unroll") for (int r = 0; r < 16; ++r) o[d][r] *= al_l[crow(r, hi)]; } } while (0)
    f32x16 pA0, pA1, pB0, pB1; float mnA, mnB, alA, alB; bf16x8 pa0, pa1, pa2, pa3; constexpr int NT = SEQ / KVBLK;
    const int vrb = (int)(uintptr_t)lds + SHM_K + v_rd_base(lane);
    int s0 = 0, s1 = 1, s2 = 2;
    GLDS(0, 0); GLDS(KVBLK, 1);
    WAITBAR(5);
    qkt_l(pA0, pA1, lds, qr, r32, hi); partialSM(pA0, pA1, m_reg, mnA, alA);
    WAITBAR(2);
#pragma unroll 1
    for (int j = 0; j < NT; j += 2) {
        const bool more1 = j + 2 < NT;
        if (more1) GLDS((j + 2) * KVBLK, s2);
        SBAR(); qkt_l(pB0, pB1, lds + s1 * SLOT, qr, r32, hi);
        finishSM(pA0, pA1, alA, l_reg, pa0, pa1, pa2, pa3); SBAR();
        pv_d0(o, vrb + s0 * SLOT, pa0, pa1, pa2, pa3); partialSM(pB0, pB1, m_reg, mnB, alB);
        if (more1) WAITBAR(2); else WAITBAR(0);
        RESC(alB);
        { const int t_ = s0; s0 = s1; s1 = s2; s2 = t_; }
        const bool more2 = j + 3 < NT;
        if (more2) GLDS((j + 3) * KVBLK, s2);
        SBAR(); if (more1) qkt_l(pA0, pA1, lds + s1 * SLOT, qr, r32, hi);
        finishSM(pB0, pB1, alB, l_reg, pa0, pa1, pa2, pa3); SBAR();
        pv_d0(o, vrb + s0 * SLOT, pa0, pa1, pa2, pa3); if (more1) partialSM(pA0, pA1, m_reg, mnA, alA);
        if (more2) WAITBAR(2); else WAITBAR(0);
        if (more1) RESC(alA);
        { const int t_ = s0; s0 = s1; s1 = s2; s2 = t_; }
    }
    if (hi == 0) li_l[r32] = l_reg; asm volatile("s_waitcnt lgkmcnt(0)" ::: "memory");
    char* Ow = (char*)(O + (tokb + qb * 256 + wid * 32) * 1024 + h * 128);
    const unsigned oo = (unsigned)(4 * hi * 1024 + r32) * 2u;
#pragma unroll
    for (int r = 0; r < 16; ++r) { const float rl = __builtin_amdgcn_rcpf(li_l[crow(r, hi)]);
#pragma unroll
        for (int d0 = 0; d0 < 4; ++d0) { const unsigned w = cvt_pk_bf16(o[d0][r] * rl, 0.f); *(bf16*)(Ow + oo + (unsigned)((((r & 3) + 8 * (r >> 2)) * 1024 + d0 * 32) * 2)) = (bf16)(w & 0xffffu); } }
    WAITBAR(0);
#undef GLDS
#undef RESC
}
constexpr int F8_SK = 64 * 192, F8_SV = 128 * 64, F8_SLOT = F8_SK + F8_SV;
typedef int v8i32 __attribute__((ext_vector_type(8)));
__device__ __forceinline__ v8i32 ld32(const LAS char* p0, const LAS char* p1) { const u32x4 a = *(const LAS u32x4*)p0, b = *(const LAS u32x4*)p1; return (v8i32){(int)a.x, (int)a.y, (int)a.z, (int)a.w, (int)b.x, (int)b.y, (int)b.z, (int)b.w}; }
__device__ __forceinline__ void attn_unit_f8(const int tid, const unsigned char* Q8, const unsigned char* KN8, const unsigned char* KR8, const unsigned char* VT8, unsigned char* O, int b, int h, int qb, LAS char* lds) {
    const int wid = __builtin_amdgcn_readfirstlane(tid >> 6), lane = tid & 63, r32 = lane & 31, hi = lane >> 5;
    LAS float* wsc = (LAS float*)(lds + 6 * F8_SLOT) + wid * 64; LAS float* al_l = wsc + 32;
    constexpr float TAU = 1.0f;
    f32x16 o[4] = {}, osum = {}, minit = {}; v8i32 qr[3];
    LAS char* const onep = lds + 6 * F8_SLOT + 2048;
    if (tid < 4) ((LAS unsigned*)onep)[tid] = 0x38383838u;
    const size_t tokb = (size_t)b * SEQ;
    { const unsigned char* Qw = Q8 + (tokb + qb * 256 + wid * 32) * 1536 + h * 192; const unsigned qo = (unsigned)(r32 * 1536 + hi * 32);
#pragma unroll
      for (int st = 0; st < 3; ++st) { const u32x4 x = *(const u32x4*)(Qw + qo + st * 64), y = *(const u32x4*)(Qw + qo + st * 64 + 16); qr[st] = (v8i32){(int)x.x, (int)x.y, (int)x.z, (int)x.w, (int)y.x, (int)y.y, (int)y.z, (int)y.w}; } }
    const unsigned char* Knb = KN8 + tokb * 1024 + h * 128; const unsigned char* Krb = KR8 + tokb * 64; const unsigned char* Vtb = VT8 + (size_t)(b * 8 + h) * 128 * SEQ;
    unsigned koff[3], voff; bool krope[3]; int kdst[3];
#pragma unroll
    for (int t = 0; t < 3; ++t) { const int q = wid + 8 * t, tl = q / 12, pc = q % 12, p = pc * 64 + lane, row = p / 12, cp = p % 12, c = (cp & ~3) | ((cp ^ (row >> 2)) & 3);
        krope[t] = c >= 8; koff[t] = krope[t] ? (unsigned)((tl * 64 + row) * 64 + (c - 8) * 16) : (unsigned)((tl * 64 + row) * 1024 + c * 16); kdst[t] = tl * F8_SLOT + pc * 1024; }
    { const int p = wid * 64 + lane, d = p >> 2, cp = p & 3, c = cp ^ ((d >> 2) & 3); voff = (unsigned)(d * SEQ + c * 16); }
#define GLDS8(k0, slot) do { const unsigned char* kb_ = Knb + (size_t)(k0) * 1024; const unsigned char* rb_ = Krb + (size_t)(k0) * 64; LAS char* kd_ = lds + (slot) * (2 * F8_SLOT); \
    _Pragma("unroll") for (int t_ = 0; t_ < 3; ++t_) { const unsigned char* s_ = (krope[t_] ? rb_ : kb_) + koff[t_]; __builtin_amdgcn_global_load_lds((const unsigned*)s_, (LAS unsigned*)(kd_ + kdst[t_]), 16, 0, 0); } \
    _Pragma("unroll") for (int t_ = 0; t_ < 2; ++t_) __builtin_amdgcn_global_load_lds((const unsigned*)(Vtb + (k0) + t_ * 64 + voff), (LAS unsigned*)(kd_ + t_ * F8_SLOT + F8_SK + wid * 1024), 16, 0, 0); } while (0)
    const int krow = 16 * ((r32 >> 2) & 1) + 4 * (r32 >> 3) + (r32 & 3), kx = (krow >> 2) & 3;
    const int ka0 = krow * 192 + 16 * ((2 * hi) ^ kx), ka1 = krow * 192 + 16 * ((2 * hi + 1) ^ kx);
    const int vx = (r32 >> 2) & 3, va0 = F8_SK + r32 * 64 + 16 * (hi ^ vx), va1 = F8_SK + r32 * 64 + 16 * ((2 + hi) ^ vx);
#define QKT8(P0, P1, Ks) do { _Pragma("unroll") for (int st = 0; st < 3; ++st) { \
        const v8i32 k0_ = ld32((Ks) + ka0 + st * 64, (Ks) + ka1 + st * 64), k1_ = ld32((Ks) + ka0 + st * 64 + 32 * 192, (Ks) + ka1 + st * 64 + 32 * 192); \
        P0 = __builtin_amdgcn_mfma_scale_f32_32x32x64_f8f6f4(k0_, qr[st], st == 0 ? minit : P0, 0, 0, 0, 0, 0, 0); P1 = __builtin_amdgcn_mfma_scale_f32_32x32x64_f8f6f4(k1_, qr[st], st == 0 ? minit : P1, 0, 0, 0, 0, 0, 0); } } while (0)
#define PV8_LOAD(Vs) do { vfr[0] = ld32((Vs) + va0, (Vs) + va1); } while (0)
#define PV8_MMA(Vs) do { const v8i32 v1_ = ld32((Vs) + va0 + 1 * 2048, (Vs) + va1 + 1 * 2048), v2_ = ld32((Vs) + va0 + 2 * 2048, (Vs) + va1 + 2 * 2048), v3_ = ld32((Vs) + va0 + 3 * 2048, (Vs) + va1 + 3 * 2048); \
        o[0] = __builtin_amdgcn_mfma_scale_f32_32x32x64_f8f6f4(pa, vfr[0], o[0], 0, 0, 0, 0, 0, 0); o[1] = __builtin_amdgcn_mfma_scale_f32_32x32x64_f8f6f4(pa, v1_, o[1], 0, 0, 0, 0, 0, 0); \
        o[2] = __builtin_amdgcn_mfma_scale_f32_32x32x64_f8f6f4(pa, v2_, o[2], 0, 0, 0, 0, 0, 0); o[3] = __builtin_amdgcn_mfma_scale_f32_32x32x64_f8f6f4(pa, v3_, o[3], 0, 0, 0, 0, 0, 0); \
        osum = __builtin_amdgcn_mfma_scale_f32_32x32x64_f8f6f4(pa, ld32(onep, onep), osum, 0, 0, 0, 0, 0, 0); } while (0)
#define PSM8(P0, P1, PM) do { float pm_ = P0[0]; _Pragma("unroll") for (int r = 1; r < 16; ++r) pm_ = fmaxf(pm_, P0[r]); _Pragma("unroll") for (int r = 0; r < 16; ++r) pm_ = fmaxf(pm_, P1[r]); \
        { auto rr_ = __builtin_amdgcn_permlane32_swap(__float_as_uint(pm_), __float_as_uint(pm_), false, false); PM = fmaxf(__uint_as_float(rr_[0]), __uint_as_float(rr_[1])); } \
        _Pragma("unroll") for (int r = 0; r < 16; ++r) P0[r] = __builtin_amdgcn_exp2f(P0[r]); } while (0)
#define PSM8_FIRST(P0, P1) do { float pm_ = P0[0]; _Pragma("unroll") for (int r = 1; r < 16; ++r) pm_ = fmaxf(pm_, P0[r]); _Pragma("unroll") for (int r = 0; r < 16; ++r) pm_ = fmaxf(pm_, P1[r]); \
        { auto rr_ = __builtin_amdgcn_permlane32_swap(__float_as_uint(pm_), __float_as_uint(pm_), false, false); pm_ = fmaxf(__uint_as_float(rr_[0]), __uint_as_float(rr_[1])); } \
        const float dl_ = pm_ - 7.0f; _Pragma("unroll") for (int r = 0; r < 16; ++r) { P0[r] = __builtin_amdgcn_exp2f(P0[r] - dl_); P1[r] -= dl_; minit[r] = -dl_; } } while (0)
#define FSM8(P0, P1) do { _Pragma("unroll") for (int r = 0; r < 16; ++r) P1[r] = __builtin_amdgcn_exp2f(P1[r]); \
        pa = (v8i32){(int)pk_fp8x4(P0[0], P0[1], P0[2], P0[3]), (int)pk_fp8x4(P0[4], P0[5], P0[6], P0[7]), (int)pk_fp8x4(P0[8], P0[9], P0[10], P0[11]), (int)pk_fp8x4(P0[12], P0[13], P0[14], P0[15]), \
                     (int)pk_fp8x4(P1[0], P1[1], P1[2], P1[3]), (int)pk_fp8x4(P1[4], P1[5], P1[6], P1[7]), (int)pk_fp8x4(P1[8], P1[9], P1[10], P1[11]), (int)pk_fp8x4(P1[12], P1[13], P1[14], P1[15])}; } while (0)
#define RESC(P0, P1, PM) do { if (__any((PM) > 7.0f + TAU)) { const float dl_ = (PM) > 7.0f + TAU ? (PM) - 7.0f : 0.f, a_ = __builtin_amdgcn_exp2f(-dl_); \
    if (hi == 0) al_l[r32] = a_; \
    _Pragma("unroll") for (int r = 0; r < 16; ++r) { P0[r] *= a_; P1[r] -= dl_; minit[r] -= dl_; } \
    asm volatile("s_waitcnt lgkmcnt(0)" ::: "memory"); \
    _Pragma("unroll") for (int r = 0; r < 16; ++r) { const float f_ = al_l[crow(r, hi)]; osum[r] *= f_; _Pragma("unroll") for (int d = 0; d < 4; ++d) o[d][r] *= f_; } } } while (0)
#define SGB_QK() do { _Pragma("unroll") for (int i_ = 0; i_ < 6; ++i_) { __builtin_amdgcn_sched_group_barrier(0x100, 2, 0); __builtin_amdgcn_sched_group_barrier(0x008, 1, 0); __builtin_amdgcn_sched_group_barrier(0x402, 12, 0); } } while (0)
#define SGB_PV() do { _Pragma("unroll") for (int i_ = 0; i_ < 4; ++i_) { __builtin_amdgcn_sched_group_barrier(0x100, 2, 0); __builtin_amdgcn_sched_group_barrier(0x008, 1, 0); __builtin_amdgcn_sched_group_barrier(0x402, 26, 0); } } while (0)
    f32x16 pA0, pA1, pB0, pB1; float pmA, pmB; v8i32 pa, vfr[1]; constexpr int NT = SEQ / KVBLK;
    int s0 = 0, s1 = 1, s2 = 2;
    GLDS8(0, 0); GLDS8(2 * KVBLK, 1);
    WAITBAR(5);
    QKT8(pA0, pA1, lds); PSM8_FIRST(pA0, pA1);
    WAITBAR(2);
#pragma unroll 1
    for (int j = 0; j < NT; j += 2) {
        const bool more = j + 4 < NT;
        if (more) GLDS8((j + 4) * KVBLK, s2);
        LAS char* const t0 = lds + s0 * (2 * F8_SLOT); LAS char* const t1 = t0 + F8_SLOT; LAS char* const t2 = lds + s1 * (2 * F8_SLOT);
        SBAR(); PV8_LOAD(t0); QKT8(pB0, pB1, t1);
        FSM8(pA0, pA1); SBAR();
        PV8_MMA(t0); PSM8(pB0, pB1, pmB); SBAR();
        RESC(pB0, pB1, pmB);
        SBAR(); PV8_LOAD(t1); QKT8(pA0, pA1, t2);
        FSM8(pB0, pB1); SBAR();
        PV8_MMA(t1); PSM8(pA0, pA1, pmA); SBAR();
        if (more) WAITBAR(2); else WAITBAR(0);
        if (j + 2 < NT) RESC(pA0, pA1, pmA);
        { const int t_ = s0; s0 = s1; s1 = s2; s2 = t_; }
    }
    unsigned char* Ow = O + (tokb + qb * 256 + wid * 32) * 1024 + h * 128;
    const unsigned oo = (unsigned)(4 * hi * 1024 + r32);
#pragma unroll
    for (int r = 0; r < 16; ++r) { const float rl = __builtin_amdgcn_rcpf(osum[r] * ATT8_SCALE) * O8_SCALE;
        const unsigned w = pk_fp8x4(o[0][r] * rl, o[1][r] * rl, o[2][r] * rl, o[3][r] * rl);
#pragma unroll
        for (int d0 = 0; d0 < 4; ++d0) Ow[oo + (unsigned)(((r & 3) + 8 * (r >> 2)) * 1024 + d0 * 32)] = (unsigned char)(w >> (8 * d0)); }
    WAITBAR(0);
#undef GLDS8
#undef QKT8
#undef PV8_LOAD
#undef PV8_MMA
#undef PSM8
#undef PSM8_FIRST
#undef FSM8
#undef RESC
}
}

namespace watt {
constexpr float C2 = 1.4426950408889634f;
constexpr int WLDS = 16384 + 256;
__device__ __forceinline__ void unit(const bf16* QKV, bf16* OG, float* LSE, int g, int b, int r, int h, int qb, LAS char* wl, int lane) {
    const int r32 = lane & 31, hi = lane >> 5, sh = 2 * g, L = SEQ >> sh, l0 = qb * 64;
    LAS float* scr = (LAS float*)(wl + 16384);
    const size_t tokb = (size_t)b * SEQ + r;
    const char* base = (const char*)QKV + (size_t)(((g * 3) * 8 + h) * 64) * 2;
    bf16x8 qf[2][4];
#pragma unroll
    for (int qs = 0; qs < 2; ++qs) { const char* p = base + (tokb + ((size_t)(l0 + 32 * qs + r32) << sh)) * 9216 + hi * 16;
#pragma unroll
        for (int d0 = 0; d0 < 4; ++d0) qf[qs][d0] = *reinterpret_cast<const bf16x8*>(p + d0 * 32); }
    f32x16 o[2][2] = {}; float m[2] = {-1e30f, -1e30f}, l[2] = {0.f, 0.f};
    const int vb = (int)(uintptr_t)wl + mla::v_rd_base(lane);
#pragma unroll
    for (int tt = 0; tt < 3; ++tt) {
        const int t = tt == 0 ? 1 : (tt == 1 ? 0 : 2);
        const int lk0 = l0 - 64 + 64 * t;
        bf16x8 kf[2][4];
#pragma unroll
        for (int half = 0; half < 2; ++half) { int lk = lk0 + 32 * half + r32; lk = lk < 0 ? 0 : (lk >= L ? L - 1 : lk);
            const char* p = base + 1024 + (tokb + ((size_t)lk << sh)) * 9216 + hi * 16;
#pragma unroll
            for (int d0 = 0; d0 < 4; ++d0) kf[half][d0] = *reinterpret_cast<const bf16x8*>(p + d0 * 32); }
        bf16x8 vs[8];
#pragma unroll
        for (int i = 0; i < 8; ++i) { int lk = lk0 + i * 8 + (lane >> 3); lk = lk < 0 ? 0 : (lk >= L ? L - 1 : lk);
            vs[i] = *reinterpret_cast<const bf16x8*>(base + 2048 + (tokb + ((size_t)lk << sh)) * 9216 + (lane & 7) * 16); }
#pragma unroll
        for (int i = 0; i < 8; ++i) *(LAS bf16x8*)(wl + mla::v_st(i * 8 + (lane >> 3), (lane & 7) * 8)) = vs[i];
#pragma unroll
        for (int qs = 0; qs < 2; ++qs) {
            f32x16 p0 = {}, p1 = {};
#pragma unroll
            for (int d0 = 0; d0 < 4; ++d0) { p0 = __builtin_amdgcn_mfma_f32_32x32x16_bf16(kf[0][d0], qf[qs][d0], p0, 0, 0, 0); p1 = __builtin_amdgcn_mfma_f32_32x32x16_bf16(kf[1][d0], qf[qs][d0], p1, 0, 0, 0); }
            const int lq = l0 + 32 * qs + r32; float pmax = -INFINITY;
#pragma unroll
            for (int rr = 0; rr < 16; ++rr) { const int k0 = lk0 + mla::crow(rr, hi), k1 = k0 + 32;
                const bool v0 = (k0 >= 0) && (k0 < L) && (k0 - lq <= 64) && (lq - k0 <= 64), v1 = (k1 >= 0) && (k1 < L) && (k1 - lq <= 64) && (lq - k1 <= 64);
                p0[rr] = v0 ? p0[rr] : -INFINITY; p1[rr] = v1 ? p1[rr] : -INFINITY; pmax = fmaxf(pmax, fmaxf(p0[rr], p1[rr])); }
            { auto sw = __builtin_amdgcn_permlane32_swap(__float_as_uint(pmax), __float_as_uint(pmax), false, false); pmax = fmaxf(__uint_as_float(sw[0]), __uint_as_float(sw[1])); }
            const float mn = fmaxf(m[qs], pmax), alpha = __builtin_amdgcn_exp2f((m[qs] - mn) * C2), mnC = -mn * C2; m[qs] = mn;
            float ps = 0.f;
#pragma unroll
            for (int rr = 0; rr < 16; ++rr) { p0[rr] = __builtin_amdgcn_exp2f(fmaf(p0[rr], C2, mnC)); p1[rr] = __builtin_amdgcn_exp2f(fmaf(p1[rr], C2, mnC)); ps += p0[rr] + p1[rr]; }
            { auto sw = __builtin_amdgcn_permlane32_swap(__float_as_uint(ps), __float_as_uint(ps), false, false); ps = __uint_as_float(sw[0]) + __uint_as_float(sw[1]); }
            l[qs] = l[qs] * alpha + ps;
            bf16x8 pa0, pa1, pa2, pa3;
#define PK4(P, BASE, OUT) do { unsigned a0 = cvt_pk_bf16(P[BASE + 0], P[BASE + 1]), a1 = cvt_pk_bf16(P[BASE + 2], P[BASE + 3]);   \
    unsigned b0 = cvt_pk_bf16(P[BASE + 4], P[BASE + 5]), b1 = cvt_pk_bf16(P[BASE + 6], P[BASE + 7]);                              \
    auto r0 = __builtin_amdgcn_permlane32_swap(a0, b0, false, false); auto r1 = __builtin_amdgcn_permlane32_swap(a1, b1, false, false); \
    u32x4 w = {r0[0], r1[0], r0[1], r1[1]}; OUT = *reinterpret_cast<bf16x8*>(&w); } while (0)
            PK4(p0, 0, pa0); PK4(p0, 8, pa1); PK4(p1, 0, pa2); PK4(p1, 8, pa3);
#undef PK4
            if (tt > 0) { if (__any(alpha < 1.f)) { if (hi == 0) scr[r32] = alpha; asm volatile("s_waitcnt lgkmcnt(0)" ::: "memory");
#pragma unroll
                for (int d = 0; d < 2; ++d)
#pragma unroll
                    for (int rr = 0; rr < 16; ++rr) o[qs][d][rr] *= scr[mla::crow(rr, hi)]; } }
            mla::pv_one<0>(o[qs][0], vb, pa0, pa1, pa2, pa3); mla::pv_one<1>(o[qs][1], vb, pa0, pa1, pa2, pa3);
        }
    }
#pragma unroll
    for (int qs = 0; qs < 2; ++qs) {
        if (hi == 0) { scr[r32] = l[qs]; LSE[((size_t)g * NTOK + tokb + ((size_t)(l0 + 32 * qs + r32) << sh)) * 8 + h] = m[qs] + __logf(l[qs]); }
        asm volatile("s_waitcnt lgkmcnt(0)" ::: "memory");
#pragma unroll
        for (int rr = 0; rr < 16; ++rr) { const int qi = mla::crow(rr, hi); const float rl = __builtin_amdgcn_rcpf(scr[qi]);
            bf16* op = OG + ((size_t)g * NTOK + tokb + ((size_t)(l0 + 32 * qs + qi) << sh)) * 512 + h * 64 + r32;
#pragma unroll
            for (int d = 0; d < 2; ++d) { const unsigned w = cvt_pk_bf16(o[qs][d][rr] * rl, 0.f); op[d * 32] = (bf16)(w & 0xffffu); } }
        asm volatile("s_waitcnt lgkmcnt(0)" ::: "memory");
    }
}
}
__device__ __forceinline__ void watt_phase(const Ctx& C) {
    const bf16* QKV = (const bf16*)(C.ws + AR_QKV); bf16* OG = (bf16*)(C.ws + AR_OG); float* LSE = (float*)(C.ws + AR_LSE);
    LAS char* wl = (LAS char*)C.lds + C.wave * watt::WLDS;
    for (int u = C.bx * NWAVES + C.wave; u < 12288; u += C.G * NWAVES) {
        const int g = u >> 12, v = u & 4095, sh = 2 * g, nqb = 128 >> sh, qb = v & (nqb - 1), w2 = v >> (7 - sh), h = w2 & 7, w3 = w2 >> 3, r = w3 & ((1 << sh) - 1), b = w3 >> sh;
        watt::unit(QKV, OG, LSE, g, b, r, h, qb, wl, C.lane);
    }
}
__device__ __forceinline__ void watt_combine(const Ctx& C) {
    const bf16* OG = (const bf16*)(C.ws + AR_OG); const float* LSE = (const float*)(C.ws + AR_LSE); unsigned char* O = C.ws + AR_OD;
    for (int it0 = C.bx * NTHR + C.tid; it0 < NTOK * 64; it0 += 4 * C.G * NTHR) {
      float lq[4][3]; u32x4 oq[4][3];
#pragma unroll
      for (int q = 0; q < 4; ++q) { const int it = it0 + q * C.G * NTHR, tok = it >> 6, c = it & 63, h = c >> 3;
#pragma unroll
          for (int g = 0; g < 3; ++g) { lq[q][g] = LSE[((size_t)g * NTOK + tok) * 8 + h]; oq[q][g] = *(const u32x4*)(OG + ((size_t)g * NTOK + tok) * 512 + c * 8); } }
#pragma unroll
      for (int q = 0; q < 4; ++q) {
        const int it = it0 + q * C.G * NTHR, tok = it >> 6, c = it & 63;
        const float l0 = lq[q][0], l1 = lq[q][1], l2 = lq[q][2];
        const float mx = fmaxf(l0, fmaxf(l1, l2)); float w0 = __expf(l0 - mx), w1 = __expf(l1 - mx), w2 = __expf(l2 - mx); const float inv = 1.0f / (w0 + w1 + w2); w0 *= inv; w1 *= inv; w2 *= inv;
        const u32x4 a = oq[q][0], bq = oq[q][1], cq = oq[q][2];
        w0 *= OD8_SCALE; w1 *= OD8_SCALE; w2 *= OD8_SCALE;
        float e[8];
#pragma unroll
        for (int j = 0; j < 4; ++j) { e[2 * j] = w0 * bflo(a[j]) + w1 * bflo(bq[j]) + w2 * bflo(cq[j]); e[2 * j + 1] = w0 * bfhi(a[j]) + w1 * bfhi(bq[j]) + w2 * bfhi(cq[j]); }
        *(u32x2*)(O + (size_t)tok * 512 + c * 8) = (u32x2){pk_fp8x4(e[0], e[1], e[2], e[3]), pk_fp8x4(e[4], e[5], e[6], e[7])};
      }
    }
}

constexpr int N_PHASES = 64;
constexpr int PP_SPLIT = 100;
__global__ void __launch_bounds__(NTHR, 2) fwd_kernel(Args args) {
    extern __shared__ __attribute__((aligned(16))) unsigned char lds_raw[];
    volatile LAS unsigned* MISC = (volatile LAS unsigned*)((LAS unsigned char*)lds_raw + LDS_MISC);
    if (threadIdx.x < 64) MISC[threadIdx.x] = 0u;
    if (threadIdx.x == 0) {
#pragma unroll
        for (int i = 0; i < 30; ++i) *(LAS unsigned long long*)((LAS unsigned char*)lds_raw + LDS_PTRS + 8 * i) = (unsigned long long)args.in[i];
    }
    __syncthreads();
    XcdBarrier bar = xcd_barrier_post((unsigned*)(args.ws + WS_CTL) + CW_BAR, MISC + 8);
    const int lo = args.ph_lo, hi = args.ph_hi; int ph = 0;
    const int wave_s = __builtin_amdgcn_readfirstlane(threadIdx.x >> 6);
#define FRESH_CTX Ctx C; { unsigned on_ = ~0u; asm volatile("" : "+s"(on_)); int t_ = wave_s * 64 + (int)__builtin_amdgcn_mbcnt_hi(on_, __builtin_amdgcn_mbcnt_lo(on_, 0u)), bx_ = blockIdx.x, g_ = gridDim.x; unsigned char* ws_ = args.ws; float* out_ = args.out; \
        asm volatile("" : "+v"(t_)); asm volatile("" : "+s"(bx_), "+s"(g_), "+s"(ws_), "+s"(out_)); \
        C.lds = (LAS unsigned char*)lds_raw; C.ws = (unsigned char*)(GAS unsigned char*)(unsigned long long)ws_; C.in.lds = C.lds; C.out = (float*)(GAS float*)(unsigned long long)out_;       C.tid = t_; C.lane = t_ & 63; C.wave = __builtin_amdgcn_readfirstlane(t_ >> 6); C.G = g_; C.bx = bx_; } \
        unsigned char* ws = C.ws; LAS unsigned char* lds = C.lds; const float* SSQ = (const float*)(ws + WS_SSQ); bf16* H = (bf16*)(ws + WS_HB); const bf16* HB = (const bf16*)(ws + WS_HB); \
        const float* ct = (const float*)(ws + WS_COS); const float* st = (const float*)(ws + WS_SIN); (void)SSQ; (void)H; (void)HB; (void)ct; (void)st; (void)lds;
#ifndef PROBE_MASK
#define PROBE_MASK 0ull
#endif
#ifndef PROBE_DRY
#define PROBE_DRY 0ull
#endif
#define PHASE_BEGIN if (lo <= ph && ph < hi) { const int nrep_ = (((PROBE_MASK | PROBE_DRY) >> ph) & 1ull) ? 2 : 1; for (int rep_ = 0; rep_ < nrep_; ++rep_) { const float DRYS = (((PROBE_DRY >> ph) & 1ull) && rep_ == 0) ? 0.0f : 1.0f; (void)DRYS; FRESH_CTX
#define PHASE_END   } if (ph + 1 < hi) { unsigned on_ = ~0u; asm volatile("" : "+s"(on_)); xcd_barrier(bar, wave_s * 64 + (int)__builtin_amdgcn_mbcnt_hi(on_, __builtin_amdgcn_mbcnt_lo(on_, 0u))); } } ++ph;
#define DENSE(name, Aptr, Btptr, Kv, ldav, ldbv, nMv, nNv, nbv, abs_, bbs_) pg8::DenseSched name{Aptr, Btptr, Kv, ldav, ldbv, pg8::TileOrder{nMv, nNv, nbv, C.G, C.bx}, abs_, bbs_}

    PHASE_BEGIN prologue(C); PHASE_END

    PHASE_BEGIN
        DENSE(S, HB, (const bf16*)(ws + WA_T), 1024, 1024, 1024, NTOK / 256, 3, 1, 0, 0);
        EpiMlaA E{SSQ, (bf16*)(ws + AR_CQ), (bf16*)(ws + AR_CKV), (bf16*)(ws + AR_KR), (float*)(ws + AR_SSQQ), (float*)(ws + AR_SSQKV), ct, st};
        pg8::gemm_phase<EpiMlaA, pg8::DenseSched, true>(lds, C.tid, S, E);
        if (C.G == 256 && C.bx >= 128) { __syncthreads(); moe_weight_prep(C, 0, 8192, 1 << 30, (C.bx - 128) * NWAVES + C.wave, 128 * NWAVES); __syncthreads(); }
    PHASE_END
    PHASE_BEGIN
        { DENSE(S, (const bf16*)(ws + AR_CQ), (const bf16*)(ws + WUQ_T), 384, 384, 384, NTOK / 256, 6, 1, 0, 0);
          EpiMlaQ E{(const float*)(ws + AR_SSQQ), (bf16*)(ws + AR_Q), ct, st};
          pg8::gemm_phase<EpiMlaQ, pg8::DenseSched, true>(lds, C.tid, S, E); }
        { FRESH_CTX MlaKnSched S{(const bf16*)(ws + AR_CKV), (const bf16*)(ws + WUKV_T), 256, 256, C.G, C.bx};
          EpiMlaKN E{(const float*)(ws + AR_SSQKV), ws + AR_KN};
          pg8::gemm_phase<EpiMlaKN, MlaKnSched, true>(lds, C.tid, S, E); }
        { FRESH_CTX MlaVtSched S{(const bf16*)(ws + WUKV_T), (const bf16*)(ws + AR_CKV), 256, 256, C.G, C.bx};
          EpiMlaVT E{(const float*)(ws + AR_SSQKV), ws + AR_VT};
          pg8::gemm_phase<EpiMlaVT, MlaVtSched, true>(lds, C.tid, S, E); }
    PHASE_END
    PHASE_BEGIN
        for (int i = 0; ; ++i) { const int bh = i * 8 + (C.bx & 7), qb = C.bx >> 3; if (bh >= 32 || C.G != 256) break;
            mla::attn_unit_f8(C.tid, ws + AR_Q, ws + AR_KN, ws + AR_KR, ws + AR_VT, ws + AR_O, bh >> 3, bh & 7, qb, (LAS char*)lds); }
    PHASE_END
    PHASE_BEGIN
        pg8::DenseSched8 S{ws + AR_O, ws + WOM_T, 1024, 1024, 1024, pg8::TileOrder{NTOK / 256, 4, 1, C.G, C.bx}};
        EpiResidual E{H, nullptr, DRYS / (O8_SCALE * W8_SCALE)};
        pg8::gemm_phase<EpiResidual, pg8::DenseSched8, true, true>(lds, C.tid, S, E);
    PHASE_END

#pragma unroll 1
    for (int layer = 0; layer < DEPTH; ++layer) {
        if (layer == 1) {
            PHASE_BEGIN
                FnetTSched S{(const bf16*)(ws + FCH_T), HB, 256, 1024, C.G, C.bx};
                EpiFnetT E{SSQ, (bf16*)(ws + AR_TT)};
                pg8::gemm_phase<EpiFnetT, FnetTSched, true>(lds, C.tid, S, E);
            PHASE_END
            PHASE_BEGIN
                FnetConstASched S{(const bf16*)(ws + FW1_T), (const bf16*)(ws + AR_TT), 256, 256, 1024, C.G, C.bx};
                EpiFnet1 E{(bf16*)(ws + AR_Z), (const float*)(ws + FTWC), (const float*)(ws + FTWS)};
                pg8::gemm_phase<EpiFnet1, FnetConstASched, true>(lds, C.tid, S, E);
            PHASE_END
            PHASE_BEGIN
                FnetConstASched S{(const bf16*)(ws + FW2_T), (const bf16*)(ws + AR_Z), 128, 128, 2048, C.G, C.bx};
                EpiFnet2 E{ws + AR_F, 6.905339660024878e-4f * FN8_SCALE};
                pg8::gemm_phase<EpiFnet2, FnetConstASched, true>(lds, C.tid, S, E);
            PHASE_END
            PHASE_BEGIN
                pg8::DenseSched8 S{ws + AR_F, ws + WOF_T, 1024, 1024, 1024, pg8::TileOrder{NTOK / 256, 4, 1, C.G, C.bx}};
                EpiResidual E{H, C.in[I_FN_BO], DRYS / (FN8_SCALE * W8_SCALE), DRYS};
                pg8::gemm_phase<EpiResidual, pg8::DenseSched8, true, true>(lds, C.tid, S, E);
            PHASE_END
        } else if (layer == 2) {
            PHASE_BEGIN
                pg8::DenseSched8 S{ws + WS_H8, ws + WIN_T, 1024, 1024, 1024, pg8::TileOrder{NTOK / 256, 16, 1, C.G, C.bx}};
                EpiGmlpIn E{SSQ, (bf16*)(ws + AR_U), (bf16*)(ws + AR_V), (float*)(ws + AR_SSQV), 1.0f / (XN8_SCALE * W8_SCALE)};
                pg8::gemm_phase<EpiGmlpIn, pg8::DenseSched8, true, true>(lds, C.tid, S, E);
            PHASE_END
            PHASE_BEGIN spatial_phase(C); PHASE_END
            PHASE_BEGIN
                pg8::DenseSched8 S{ws + AR_G, ws + WOG_T, 2048, 2048, 2048, pg8::TileOrder{NTOK / 256, 4, 1, C.G, C.bx}};
                EpiResidual E{H, nullptr, DRYS / (G8_SCALE * W8_SCALE)};
                pg8::gemm_phase<EpiResidual, pg8::DenseSched8, true, true>(lds, C.tid, S, E);
            PHASE_END
        } else if (layer == 3) {
            PHASE_BEGIN
                pg8::DenseSched8 S{ws + WS_H8, ws + WQKV_T, 1024, 1024, 1024, pg8::TileOrder{NTOK / 256, 18, 1, C.G, C.bx}};
                EpiDilQkv E{SSQ, (bf16*)(ws + AR_QKV), ct, st, 1.0f / (XN8_SCALE * W8_SCALE)};
                pg8::gemm_phase<EpiDilQkv, pg8::DenseSched8, true, true>(lds, C.tid, S, E);
            PHASE_END
            PHASE_BEGIN watt_phase(C); PHASE_END
            PHASE_BEGIN watt_combine(C); PHASE_END
            PHASE_BEGIN
                pg8::DenseSched8 S{ws + AR_OD, ws + WOD_T, 512, 512, 512, pg8::TileOrder{NTOK / 256, 4, 1, C.G, C.bx}};
                EpiResidual E{H, nullptr, DRYS / (OD8_SCALE * W8_SCALE)};
                pg8::gemm_phase<EpiResidual, pg8::DenseSched8, true, true>(lds, C.tid, S, E);
            PHASE_END
        }
        PHASE_BEGIN
            if (layer > 0) { moe_weight_prep(C, layer); __syncthreads(); }
            router_phase(C, layer);
        PHASE_END
        PHASE_BEGIN
            moe_tables(C, layer);
            const LAS int* T = (const LAS int*)(lds + LDS_TAB);
            MoeSched1 S{ws + WS_XN, ws + WS_MOEW1, (const u32x2*)(ws + WS_LIST), T, 1024, 1024, C.G, C.bx};
            EpiMoe1 E{ws + AR_HBUF, T};
            pg8::gemm_phase<EpiMoe1, MoeSched1, true, true>(lds, C.tid, S, E);
#define PP_TAIL(RT0, NRT) { FRESH_CTX const int U1 = __builtin_amdgcn_readfirstlane(((const LAS int*)(lds + LDS_TAB))[64]) * 4, rem = U1 % C.G; int nl = C.G - rem, li = C.bx - rem; if (2 * nl < C.G) { nl = C.G; li = C.bx; } \
              if (li >= 0) { pg8::DenseSched S2{(const bf16*)(ws + WS_PB) + ((size_t)layer * NTOK + (size_t)(RT0) * 256) * 256, (const bf16*)(ws + WP_T) + (size_t)layer * 1024 * 256, 256, 256, 256, pg8::TileOrder{(NRT), 4, 1, nl, li}, 0, 0}; \
                EpiStoreBf16 E2{(bf16*)(ws + WS_PP) + (size_t)(RT0) * 256 * 1024, 1024, 1.0f, 0}; \
                pg8::gemm_phase<EpiStoreBf16, pg8::DenseSched, true>(lds, C.tid, S2, E2); } }
            PP_TAIL(0, PP_SPLIT)
        PHASE_END
        PHASE_BEGIN
            moe_tables(C, layer);
            const LAS int* T = (const LAS int*)(lds + LDS_TAB);
            MoeSched2 S{ws + AR_HBUF, ws + WS_MOEW2, T, 512, 512, C.G, C.bx};
            EpiMoe2 E{(bf16*)(ws + AR_YB), (const u32x2*)(ws + WS_LIST), T};
            pg8::gemm_phase<EpiMoe2, MoeSched2, true, true>(lds, C.tid, S, E);
            PP_TAIL(PP_SPLIT, NTOK / 256 - PP_SPLIT)
        PHASE_END
        PHASE_BEGIN combine_phase(C, C.in[I_PLE_NORM] + layer * 1024, DRYS); PHASE_END
        PHASE_BEGIN
            pg8::DenseSched8 S{ws + WS_XN, ws + WG_T + (size_t)layer * 1024 * 1024, 1024, 1024, 1024, pg8::TileOrder{NTOK / 256, 4, 1, C.G, C.bx}};
            EpiPle E{H, (const bf16*)(ws + WS_PP), (float*)(ws + WS_SSQ), DRYS, (layer == 1 || layer == 2) ? ws + WS_H8 : nullptr, -1.4426950408889634f / (XN8_SCALE * W8_SCALE)};
            pg8::gemm_phase<EpiPle, pg8::DenseSched8, true, true>(lds, C.tid, S, E);
        PHASE_END
    }
    PHASE_BEGIN final_phase(C); PHASE_END
}

#ifndef MK_SPLIT
#define MK_SPLIT 0
#endif
extern "C" void kernel_launch(void* const* d_in, const int* in_sizes, int n_in, void* d_out, int out_size, void* d_ws, size_t ws_size, hipStream_t stream) {
    static int grid = 0;
    if (grid == 0) {
        if (n_in != 30 || in_sizes[0] != NTOK * DM || out_size != NTOK * DM || ws_size < WS_END) { fprintf(stderr, "kernel_launch: shape/workspace mismatch (n_in %d, ws %zu, need %zu)\n", n_in, ws_size, (size_t)WS_END); grid = -1; return; }
        int dev = 0, cus = 0;
        if (hipGetDevice(&dev) != hipSuccess || hipDeviceGetAttribute(&cus, hipDeviceAttributeMultiprocessorCount, dev) != hipSuccess) { grid = -1; return; }
        if (hipFuncSetAttribute((const void*)fwd_kernel, hipFuncAttributeMaxDynamicSharedMemorySize, LDS_BYTES) != hipSuccess) { grid = -1; return; }
        int per_cu = 0;
        if (hipOccupancyMaxActiveBlocksPerMultiprocessor(&per_cu, (const void*)fwd_kernel, NTHR, LDS_BYTES) != hipSuccess || per_cu < 1) fprintf(stderr, "kernel_launch: occupancy query reports %d\n", per_cu);
        (void)hipGetLastError();
        grid = cus;
    }
    if (grid < 0) return;
    hipMemsetAsync((char*)d_ws + WS_CTL, 0, CTL_ZERO_BYTES, stream);
    Args a{};
    for (int i = 0; i < 30; ++i) a.in[i] = (const float*)d_in[i];
    a.out = (float*)d_out; a.ws = (unsigned char*)d_ws;
#if MK_SPLIT
    for (int p = 0; p < N_PHASES; ++p) { a.ph_lo = p; a.ph_hi = p + 1; hipLaunchKernelGGL(fwd_kernel, dim3(grid), dim3(NTHR), LDS_BYTES, stream, a); }
#else
    a.ph_lo = 0; a.ph_hi = N_PHASES;
    hipLaunchKernelGGL(fwd_kernel, dim3(grid), dim3(NTHR), LDS_BYTES, stream, a);
#endif
}
```

```cpp
#include <hip/hip_runtime.h>
#include <cstdio>
#include <cstdint>

#define LAS __attribute__((address_space(3)))
#define GAS __attribute__((address_space(1)))
typedef unsigned short bf16;
typedef short bf16x8 __attribute__((ext_vector_type(8)));
typedef short s16x4 __attribute__((ext_vector_type(4)));
typedef float f32x2 __attribute__((ext_vector_type(2)));
typedef float f32x4 __attribute__((ext_vector_type(4)));
typedef float f32x16 __attribute__((ext_vector_type(16)));
typedef unsigned u32x2 __attribute__((ext_vector_type(2)));
typedef unsigned u32x4 __attribute__((ext_vector_type(4)));

constexpr int DM = 1024, BATCH = 4, SEQ = 8192, NTOK = BATCH * SEQ, DEPTH = 4;
constexpr float EPS = 1e-6f;
constexpr int NWAVES = 8, NTHR = 512;
constexpr int MOE_CAP = 32768;
constexpr int HB_ROWS = 65536 + 32 * 256;

constexpr size_t MiB = 1u << 20;
constexpr size_t WS_CTL = 0, CTL_ZERO_BYTES = 1 * MiB;
constexpr size_t WS_COS = 1 * MiB, WS_SIN = 2 * MiB;
constexpr size_t WS_WPERM = 3 * MiB;
constexpr size_t WS_SSQ = 4 * MiB;
constexpr size_t WS_LIST = 6 * MiB;
constexpr size_t WS_WSM = 14 * MiB;
constexpr size_t WA_T = WS_WSM + 0 * MiB, WUQ_T = WS_WSM + 2 * MiB, WUKV_T = WS_WSM + 4 * MiB, WOM_T = WS_WSM + 5 * MiB, FCH_T = WS_WSM + 7 * MiB, WOF_T = WS_WSM + 8 * MiB,
                 WIN_T = WS_WSM + 10 * MiB, WOG_T = WS_WSM + 18 * MiB, WQKV_T = WS_WSM + 22 * MiB, WOD_T = WS_WSM + 31 * MiB, WG_T = WS_WSM + 32 * MiB, WP_T = WS_WSM + 40 * MiB,
                 FW1_T = WS_WSM + 42 * MiB, FW2_T = WS_WSM + 43 * MiB, FTWC = WS_WSM + 44 * MiB, FTWS = WS_WSM + 45 * MiB;
constexpr size_t WS_MOEW1 = 64 * MiB, WS_MOEW2 = 128 * MiB;
constexpr size_t WS_H8 = 160 * MiB;
constexpr size_t WS_HB = 288 * MiB;
constexpr size_t WS_XN = 352 * MiB;
constexpr size_t WS_PP = 416 * MiB;
constexpr size_t WS_PB = 480 * MiB;
constexpr size_t WS_AR = 544 * MiB;
constexpr size_t WS_END = 1010 * MiB;
constexpr size_t AR_YB = WS_AR + 0 * MiB, AR_HBUF = WS_AR + 128 * MiB;
constexpr size_t AR_CQ = WS_AR + 0 * MiB, AR_CKV = WS_AR + 24 * MiB, AR_KR = WS_AR + 40 * MiB, AR_SSQQ = WS_AR + 44 * MiB, AR_SSQKV = WS_AR + 45 * MiB, AR_Q = WS_AR + 46 * MiB, AR_KN = WS_AR + 96 * MiB, AR_VT = WS_AR + 128 * MiB, AR_O = WS_AR + 160 * MiB;
constexpr size_t AR_TT = WS_AR + 0 * MiB, AR_Z = WS_AR + 128 * MiB, AR_F = WS_AR + 256 * MiB;
constexpr size_t AR_U = WS_AR + 0 * MiB, AR_V = WS_AR + 128 * MiB, AR_G = WS_AR + 256 * MiB, AR_SSQV = WS_AR + 384 * MiB;
constexpr size_t AR_QKV = WS_AR + 0 * MiB, AR_OD = WS_AR + 288 * MiB, AR_OG = WS_AR + 320 * MiB, AR_LSE = WS_AR + 416 * MiB;

constexpr int CW_TMO = 0;
constexpr int CW_BAR = 4096;
constexpr int CW_CNT = 8192;

constexpr int LDS_TAB = 131072;
constexpr int LDS_MISC = 131072 + 8192;
constexpr int LDS_PTRS = 131072 + 4096;
constexpr int LDS_BYTES = 147456;

#define LDS_WAIT() asm volatile("s_waitcnt lgkmcnt(0)" ::: "memory")
#define VM_WAIT() asm volatile("s_waitcnt vmcnt(0)" ::: "memory")
#define SBAR() __builtin_amdgcn_sched_barrier(0)
__device__ __forceinline__ unsigned cvt_pk_bf16(float lo, float hi) { unsigned r; asm volatile("v_cvt_pk_bf16_f32 %0, %1, %2" : "=v"(r) : "v"(lo), "v"(hi)); return r; }
constexpr float ATT8_SCALE = 4.f;
constexpr float K8_SCALE = 0.25f, Q8_SCALE = 0.07216878364870322f * 1.4426950408889634f / K8_SCALE;
constexpr float XN8_SCALE = 8.f, HB8_SCALE = 4.f, W8_SCALE = 64.f, G8_SCALE = 4.f, O8_SCALE = 32.f, FN8_SCALE = 16.f, OD8_SCALE = 32.f, YB8_SCALE = 32.f;
__device__ __forceinline__ unsigned pk_fp8x4(float a, float b, float c, float d) { unsigned w = __builtin_amdgcn_cvt_pk_fp8_f32(a, b, __float_as_uint(a), false); return __builtin_amdgcn_cvt_pk_fp8_f32(c, d, w, true); }
__device__ __forceinline__ float bf2f(unsigned short x) { return __uint_as_float(((unsigned)x) << 16); }
__device__ __forceinline__ float bflo(unsigned w) { return __uint_as_float(w << 16); }
__device__ __forceinline__ float bfhi(unsigned w) { return __uint_as_float(w & 0xffff0000u); }
__device__ __forceinline__ u32x2 pack4(f32x4 v) { u32x2 w; w.x = cvt_pk_bf16(v[0], v[1]); w.y = cvt_pk_bf16(v[2], v[3]); return w; }
__device__ __forceinline__ f32x4 unpack4(u32x2 w) { return (f32x4){bflo(w.x), bfhi(w.x), bflo(w.y), bfhi(w.y)}; }
__device__ __forceinline__ float sumsq4(f32x4 v) { return (v[0] * v[0] + v[1] * v[1]) + (v[2] * v[2] + v[3] * v[3]); }
__device__ __forceinline__ float wave_sum(float v) {
#pragma unroll
    for (int o = 1; o < 64; o <<= 1) v += __shfl_xor(v, o);
    return v;
}
__device__ __forceinline__ float fast_exp2(float x) { return __builtin_amdgcn_exp2f(x); }
__device__ __forceinline__ float fast_rcp(float x) { return __builtin_amdgcn_rcpf(x); }

#define XB_TMO      128
#define XB_XCNT(j)  (256  + 64 * (j))
#define XB_XSUB(j)  (1280 + 64 * (j))
#define XB_XGEN(j)  (2304 + 64 * (j))
#define XB_TOP      3328
#define XB_TOPGEN   3392
#define XCD_BAR_WORDS 3456
#define XB_SPIN_CAP (1u << 20)
__device__ __forceinline__ unsigned xb_ld(unsigned* p)              { return __hip_atomic_load(p, __ATOMIC_RELAXED, __HIP_MEMORY_SCOPE_AGENT); }
__device__ __forceinline__ unsigned xb_add(unsigned* p, unsigned v) { return __hip_atomic_fetch_add(p, v, __ATOMIC_RELAXED, __HIP_MEMORY_SCOPE_AGENT); }
__device__ __forceinline__ unsigned xb_xcc_id() { return (unsigned)__builtin_amdgcn_s_getreg((3 << 11) | 20) & 0xFu; }
#define XB_SPIN(cond, bar) do { unsigned _sp = 0; while (cond) { __builtin_amdgcn_s_sleep(1); \
    if ((++_sp & 255u) == 0u) { if (xb_ld(&(bar)[XB_TMO])) break; if (_sp > XB_SPIN_CAP) { atomicAdd(&(bar)[XB_TMO], 1u); break; } } } } while (0)
struct XcdBarrier { unsigned* bar; unsigned x; volatile LAS unsigned* st; };
__device__ __forceinline__ XcdBarrier xcd_barrier_post(unsigned* bar, volatile LAS unsigned* st) {
    XcdBarrier b; b.bar = bar; b.x = xb_xcc_id(); b.st = st;
    if (threadIdx.x == 0) (void)xb_add(&bar[XB_XCNT(b.x)], 1u);
    return b;
}
__device__ __forceinline__ void xcd_barrier_complete(unsigned* bar, unsigned x, unsigned& nloc, unsigned& nx) {
    const unsigned G = gridDim.x * gridDim.y * gridDim.z;
    unsigned sum, cnt, mine, sp = 0u;
    for (;;) {
        sum = 0u; cnt = 0u; mine = 0u;
#pragma unroll
        for (unsigned j = 0; j < 16; ++j) { const unsigned c = xb_ld(&bar[XB_XCNT(j)]); sum += c; cnt += (c > 0u) ? 1u : 0u; mine = (j == x) ? c : mine; }
        if (sum == G) break;
        __builtin_amdgcn_s_sleep(1);
        if ((++sp & 255u) == 0u) { if (xb_ld(&bar[XB_TMO])) break; if (sp > XB_SPIN_CAP) { atomicAdd(&bar[XB_TMO], 1u); break; } }
    }
    nloc = mine > 0u ? mine : 1u; nx = cnt > 0u ? cnt : 1u;
}
__device__ __forceinline__ void xcd_barrier(const XcdBarrier& b, const int tid) {
    asm volatile("s_waitcnt vmcnt(0)" ::: "memory");
    __syncthreads();
    if (tid == 0) {
        unsigned* bar = b.bar;
        __builtin_amdgcn_s_waitcnt(0);
        unsigned nloc = b.st[0], nx = b.st[1];
        if (nloc == 0u) { xcd_barrier_complete(bar, b.x, nloc, nx); b.st[0] = nloc; b.st[1] = nx; }
        const unsigned old = xb_add(&bar[XB_XSUB(b.x)], 1u);
        const unsigned gen = old / nloc;
        if (old + 1u == (gen + 1u) * nloc) {
            __builtin_amdgcn_fence(__ATOMIC_RELEASE, "agent");
            asm volatile("s_waitcnt vmcnt(0)" ::: "memory");
            const unsigned og = xb_add(&bar[XB_TOP], 1u);
            const unsigned tg = og / nx;
            if (og + 1u == (tg + 1u) * nx) xb_add(&bar[XB_TOPGEN], 1u);
            else XB_SPIN(xb_ld(&bar[XB_TOPGEN]) == tg, bar);
            __builtin_amdgcn_fence(__ATOMIC_ACQUIRE, "agent");
            xb_add(&bar[XB_XGEN(b.x)], 1u);
            asm volatile("s_waitcnt vmcnt(0)" ::: "memory");
        } else {
            XB_SPIN(xb_ld(&bar[XB_XGEN(b.x)]) == gen, bar);
            __builtin_amdgcn_fence(__ATOMIC_ACQUIRE, "agent");
            asm volatile("s_waitcnt vmcnt(0)" ::: "memory");
        }
    }
    __syncthreads();
}

namespace pg8 {
constexpr int BM = 256, BK = 64, HALF = 128, HTB = HALF * BK * 2, STAGE_BYTES = 8 * HTB, NXCD = 8, WGM = 8;
__host__ __device__ __forceinline__ int lds_byte(int r, int c) { const int st = (r >> 4) * 2 + (c >> 5), rr = r & 15, cc = c & 31, ob = rr * 64 + cc * 2; return st * 1024 + (ob ^ (((ob >> 9) & 1) << 5)); }
__host__ __device__ __forceinline__ void stage_rc(int b, int& R, int& C) { const int st = b / 1024, sb = b % 1024, swz = sb ^ (((sb >> 9) & 1) << 5); R = (st >> 1) * 16 + swz / 64; C = (st & 1) * 32 + (swz % 64) / 2; }

typedef int v8i32 __attribute__((ext_vector_type(8)));
__device__ __forceinline__ v8i32 cat8(bf16x8 lo, bf16x8 hi) { const u32x4 a = __builtin_bit_cast(u32x4, lo), b = __builtin_bit_cast(u32x4, hi); return (v8i32){(int)a.x, (int)a.y, (int)a.z, (int)a.w, (int)b.x, (int)b.y, (int)b.z, (int)b.w}; }
union Frag { v8i32 v; bf16x8 q[2]; };
struct Unit { const char* a; const char* b; int pm, pn, aux; };

struct TileOrder {
    int nM, nN, nb, G, c;
    __device__ __forceinline__ bool decode(int i, int& bt, int& pm, int& pn) const {
        const int per = nM * nN, total = per * nb; const long L = (long)i * G + c; if (L >= total) return false;
        int wgid = (int)L; { const int q = total / NXCD, r = total % NXCD, xcd = wgid % NXCD, off = wgid / NXCD; wgid = (xcd < r ? xcd * (q + 1) : r * (q + 1) + (xcd - r) * q) + off; }
        bt = wgid / per; const int rem = wgid % per;
        const int nig = WGM * nN, gid = rem / nig, fm = gid * WGM, gsz = (nM - fm) < WGM ? (nM - fm) : WGM;
        pm = fm + ((rem % nig) % gsz); pn = (rem % nig) / gsz; return true;
    }
};

#define PG8_SA(b, h) (((b) * 2 + (h)) * HTB)
#define PG8_SB(b, h) ((4 + (b) * 2 + (h)) * HTB)
#define PG8_WAIT_V(n) asm volatile("s_waitcnt vmcnt(" #n ")" ::: "memory")
#define PG8_WAIT_L(n) asm volatile("s_waitcnt lgkmcnt(" #n ")" ::: "memory")
#define PG8_BAR __builtin_amdgcn_s_barrier()
#define PG8_SCHED __builtin_amdgcn_sched_barrier(0)

template <class Epi, class Sched, bool ALIGN_EPI, bool FP8 = false>
__device__ __forceinline__ void gemm_phase(LAS unsigned char* lds, const int tid, const Sched& S, const Epi& E) {
    const int wid = __builtin_amdgcn_readfirstlane(tid >> 6), lane = tid & 63, wr = wid >> 2, wc = wid & 3, fr = lane & 15, fq = lane >> 4;
    const int K = S.K, nt = K / (FP8 ? 2 * BK : BK);
    int Rs[2], Cs[2]; unsigned voffB[2];
#pragma unroll
    for (int i = 0; i < 2; ++i) { stage_rc(tid * 16 + i * 8192, Rs[i], Cs[i]); voffB[i] = S.boff(Rs[i], Cs[i]); }
    const size_t kstep = (size_t)(BK * 2);
    const size_t hstepB = S.hstepB();
    const unsigned ldsw = (unsigned)wid * 1024u;
    const int aoff = lds_byte(wr * 64 + fr, fq * 8), boff = lds_byte(wc * 32 + fr, fq * 8);
#define PG8_STAGE_B(bufoff, gbase) do { _Pragma("unroll") for (int _i = 0; _i < 2; ++_i) \
        __builtin_amdgcn_global_load_lds((const unsigned*)((const char*)(gbase) + voffB[_i]), (LAS unsigned*)(lds + (bufoff) + ldsw + _i * 8192), 16, 0, 0); } while (0)
#define PG8_STAGE_A(bufoff, gbase, vo) do { _Pragma("unroll") for (int _i = 0; _i < 2; ++_i) \
        __builtin_amdgcn_global_load_lds((const unsigned*)((const char*)(gbase) + (vo)[_i]), (LAS unsigned*)(lds + (bufoff) + ldsw + _i * 8192), 16, 0, 0); } while (0)
#define PG8_LDA(dst, b, h) do { _Pragma("unroll") for (int m = 0; m < 4; ++m) _Pragma("unroll") for (int k = 0; k < 2; ++k) dst[m].q[k] = *(const LAS bf16x8*)(lds + PG8_SA(b, h) + aoff + m * 2048 + k * 1024); } while (0)
#define PG8_LDB(dst, b, h) do { _Pragma("unroll") for (int n = 0; n < 2; ++n) _Pragma("unroll") for (int k = 0; k < 2; ++k) dst[n].q[k] = *(const LAS bf16x8*)(lds + PG8_SB(b, h) + boff + n * 2048 + k * 1024); } while (0)
#define PG8_MMA(ai, bj, At, Bt) do { __builtin_amdgcn_s_setprio(1); if constexpr (FP8) { _Pragma("unroll") for (int m = 0; m < 4; ++m) _Pragma("unroll") for (int n = 0; n < 2; ++n) \
        asm volatile("v_mfma_f32_16x16x128_f8f6f4 %0, %1, %2, %0" : "+v"(acc[ai][bj][m][n]) : "v"(Bt[n].v), "v"(At[m].v)); }     \
        else { _Pragma("unroll") for (int m = 0; m < 4; ++m) _Pragma("unroll") for (int n = 0; n < 2; ++n) _Pragma("unroll") for (int k = 0; k < 2; ++k) \
        acc[ai][bj][m][n] = __builtin_amdgcn_mfma_f32_16x16x32_bf16(Bt[n].q[k], At[m].q[k], acc[ai][bj][m][n], 0, 0, 0); } __builtin_amdgcn_s_setprio(0); } while (0)
    Unit cur, nxt; int ui = 0;
    if (!S.next(0, cur)) return;
    unsigned cv0[2], cv1[2], nv0[2], nv1[2];
#pragma unroll
    for (int i = 0; i < 2; ++i) { cv0[i] = S.aoff(cur, 0, Rs[i], Cs[i]); cv1[i] = S.aoff(cur, 1, Rs[i], Cs[i]); nv0[i] = cv0[i]; nv1[i] = cv1[i]; }
    f32x4 acc[2][2][4][2];
#pragma unroll
    for (int a = 0; a < 2; ++a)
#pragma unroll
        for (int b = 0; b < 2; ++b)
#pragma unroll
            for (int m = 0; m < 4; ++m)
#pragma unroll
                for (int n = 0; n < 2; ++n) acc[a][b][m][n] = (f32x4){0.f, 0.f, 0.f, 0.f};
    Frag At[4], B0[2], B1[2];
    const char* cA = cur.a; const char* cB = cur.b;
    PG8_STAGE_B(PG8_SB(0, 0), cB); PG8_STAGE_B(PG8_SB(0, 1), cB + hstepB); PG8_STAGE_A(PG8_SA(0, 0), cA, cv0); PG8_STAGE_A(PG8_SA(0, 1), cA, cv1);
    if (wr == 1) PG8_BAR;
    PG8_WAIT_V(2); PG8_BAR;
    PG8_STAGE_B(PG8_SB(1, 0), cB + kstep); PG8_STAGE_A(PG8_SA(1, 0), cA + kstep, cv0); PG8_STAGE_B(PG8_SB(1, 1), cB + hstepB + kstep);
    PG8_WAIT_V(6); PG8_BAR;
    for (;;) {
        const bool has_next = S.next(ui + 1, nxt);
        const char* nA = has_next ? nxt.a : cA; const char* nB = has_next ? nxt.b : cB;
        if (has_next) {
#pragma unroll
            for (int i = 0; i < 2; ++i) { nv0[i] = S.aoff(nxt, 0, Rs[i], Cs[i]); nv1[i] = S.aoff(nxt, 1, Rs[i], Cs[i]); }
        } else {
#pragma unroll
            for (int i = 0; i < 2; ++i) { nv0[i] = cv0[i]; nv1[i] = cv1[i]; }
        }
        for (int t = 0; t < nt; t += 2) {
            const bool last = (t == nt - 2);
            const char* a1 = cA + (size_t)(t + 1) * kstep;
            const char* a2 = last ? nA : cA + (size_t)(t + 2) * kstep; const char* b2 = last ? nB : cB + (size_t)(t + 2) * kstep;
            const char* a3 = a2 + kstep; const char* b3 = b2 + kstep;
            unsigned x0[2], x1[2];
#pragma unroll
            for (int i = 0; i < 2; ++i) { x0[i] = last ? nv0[i] : cv0[i]; x1[i] = last ? nv1[i] : cv1[i]; }
            PG8_LDB(B0, 0, 0); PG8_LDB(B1, 0, 1); PG8_SCHED; PG8_LDA(At, 0, 0); PG8_STAGE_A(PG8_SA(1, 1), a1, cv1);
            PG8_WAIT_V(8); PG8_WAIT_L(0); PG8_BAR; PG8_MMA(0, 0, At, B0); PG8_MMA(0, 1, At, B1); PG8_BAR; PG8_SCHED;
            PG8_LDA(At, 0, 1); PG8_STAGE_B(PG8_SB(0, 0), b2); PG8_STAGE_B(PG8_SB(0, 1), b2 + hstepB); PG8_STAGE_A(PG8_SA(0, 0), a2, x0);
            PG8_WAIT_V(8); PG8_WAIT_L(0); PG8_BAR; PG8_MMA(1, 0, At, B0); PG8_MMA(1, 1, At, B1); PG8_BAR; PG8_SCHED;
            PG8_LDB(B0, 1, 0); PG8_LDB(B1, 1, 1); PG8_SCHED; PG8_LDA(At, 1, 0); PG8_STAGE_A(PG8_SA(0, 1), a2, x1);
            PG8_WAIT_V(8); PG8_WAIT_L(0); PG8_BAR; PG8_MMA(0, 0, At, B0); PG8_MMA(0, 1, At, B1); PG8_BAR; PG8_SCHED;
            PG8_LDA(At, 1, 1); PG8_STAGE_B(PG8_SB(1, 0), b3); PG8_STAGE_B(PG8_SB(1, 1), b3 + hstepB); PG8_STAGE_A(PG8_SA(1, 0), a3, x0);
            PG8_WAIT_V(8); PG8_WAIT_L(0); PG8_BAR; PG8_MMA(1, 0, At, B0); PG8_MMA(1, 1, At, B1); PG8_BAR; PG8_SCHED;
        }
        if constexpr (FP8) asm volatile("s_nop 15\n\ts_nop 7" ::: "memory");
        if constexpr (ALIGN_EPI) { if (wr == 0) PG8_BAR; }
        E(acc, cur, wr, wc, fr, fq);
        if (!has_next) break;
#pragma unroll
        for (int a = 0; a < 2; ++a)
#pragma unroll
            for (int b = 0; b < 2; ++b)
#pragma unroll
                for (int m = 0; m < 4; ++m)
#pragma unroll
                    for (int n = 0; n < 2; ++n) acc[a][b][m][n] = (f32x4){0.f, 0.f, 0.f, 0.f};
        cur = nxt; cA = nA; cB = nB; ++ui;
#pragma unroll
        for (int i = 0; i < 2; ++i) { cv0[i] = nv0[i]; cv1[i] = nv1[i]; }
        if constexpr (ALIGN_EPI) { if (wr == 1) PG8_BAR; }
    }
    PG8_WAIT_V(0);
    if constexpr (!ALIGN_EPI) { if (wr == 0) PG8_BAR; }
    PG8_BAR;
#undef PG8_STAGE_A
#undef PG8_STAGE_B
#undef PG8_LDA
#undef PG8_LDB
#undef PG8_MMA
}

struct DenseSched {
    const bf16* A; const bf16* Bt; int K, lda, ldb; TileOrder T; size_t a_bstride, b_bstride;
    __device__ __forceinline__ bool next(int i, Unit& u) const {
        int bt, pm, pn; if (!T.decode(i, bt, pm, pn)) return false;
        u.pm = pm; u.pn = pn; u.aux = bt;
        u.a = (const char*)(A + (size_t)bt * a_bstride + (size_t)pm * BM * lda); u.b = (const char*)(Bt + (size_t)bt * b_bstride + (size_t)pn * BM * ldb); return true;
    }
    __device__ __forceinline__ unsigned aoff(const Unit&, int half, int R, int C) const { return (unsigned)((R + HALF * half) * lda + C) * 2u; }
    __device__ __forceinline__ unsigned boff(int R, int C) const { return (unsigned)(R * ldb + C) * 2u; }
    __device__ __forceinline__ size_t hstepB() const { return (size_t)HALF * ldb * 2; }
};
struct DenseSched8 {
    const unsigned char* A; const unsigned char* Bt; int K, lda, ldb; TileOrder T;
    __device__ __forceinline__ bool next(int i, Unit& u) const {
        int bt, pm, pn; if (!T.decode(i, bt, pm, pn)) return false;
        u.pm = pm; u.pn = pn; u.aux = bt; u.a = (const char*)(A + (size_t)pm * BM * lda); u.b = (const char*)(Bt + (size_t)pn * BM * ldb); return true;
    }
    __device__ __forceinline__ unsigned aoff(const Unit&, int half, int R, int C) const { return (unsigned)((R + HALF * half) * lda + 2 * C); }
    __device__ __forceinline__ unsigned boff(int R, int C) const { return (unsigned)(R * ldb + 2 * C); }
    __device__ __forceinline__ size_t hstepB() const { return (size_t)HALF * ldb; }
};
}

#define EPI_LOOP_BEGIN _Pragma("unroll") for (int ai = 0; ai < 2; ++ai) _Pragma("unroll") for (int m = 0; m < 4; ++m) { const int rowt = ai * 128 + wr * 64 + m * 16 + fr;
#define EPI_LOOP_END }

struct Args {
    const float* in[30];
    float* out; unsigned char* ws; int ph_lo, ph_hi;
};
enum { I_X = 0, I_P, I_NORM_MIX, I_NORM_MOE, I_MLA_WA, I_MLA_NQ, I_MLA_NKV, I_MLA_WUQ, I_MLA_WUKV, I_MLA_WO, I_FN_WO, I_FN_BO, I_GM_WIN, I_GM_NV, I_GM_WS, I_GM_BS, I_GM_WO,
       I_DL_WQKV, I_DL_WO, I_MOE_WGRP, I_MOE_BGRP, I_MOE_WEXP, I_MOE_BEXP, I_MOE_WGATE, I_MOE_WUP, I_MOE_WDOWN, I_PLE_NORM, I_PLE_WGATE, I_PLE_WPROJ, I_NORM_FINAL };

struct Ctx {
    LAS unsigned char* lds; unsigned char* ws; float* out;
    int tid, lane, wave, G, bx;
    struct InTab { LAS unsigned char* lds;
        __device__ __forceinline__ const float* operator[](int i) const {
            const u32x2 w = *(const LAS u32x2*)(lds + LDS_PTRS + 8 * i);
            const unsigned long long p = ((unsigned long long)(unsigned)__builtin_amdgcn_readfirstlane((int)w.y) << 32) | (unsigned)__builtin_amdgcn_readfirstlane((int)w.x);
            return (const float*)(GAS const float*)p; } } in;
};

__device__ __forceinline__ int rope_phys(int l) { return (((l & 31) >> 4) << 5) + ((l >> 5) << 4) + (l & 15); }
__device__ __forceinline__ int tr_map(int mode, int n) {
    switch (mode) {
        case 1: return n < 640 ? n : 640 + rope_phys(n - 640);
        case 2: { const int h = n / 192, r = n % 192; return h * 192 + (r < 128 ? r : 128 + rope_phys(r - 128)); }
        case 3: { const int blk = n >> 6, l = n & 63, t = (blk >> 3) % 3; return t < 2 ? (blk << 6) + rope_phys(l) : n; }
        case 4: case 5: { const int pn = n >> 7, wc = (n >> 5) & 3, fq = (n >> 3) & 3, bj = (n >> 2) & 1, i = n & 3; return 256 * pn + 128 * bj + 32 * wc + 16 * (mode - 4) + 4 * fq + i; }
        default: return n;
    }
}
__device__ __forceinline__ void transpose_item(const float* W, int K, int N, bf16* WT, int ldt, const float* gain, int mode, LAS float* scr, int item, int lane) {
    const int nblk = N / 64, kb = item / nblk, nb = item % nblk, k0 = 64 * kb, n0 = 64 * nb;
    const int lr = lane >> 4, lc = (lane & 15) * 4;
    f32x4 v[16];
#pragma unroll
    for (int i = 0; i < 16; ++i) v[i] = *(const f32x4*)(W + (size_t)(k0 + 4 * i + lr) * N + n0 + lc);
    if (gain) {
#pragma unroll
        for (int i = 0; i < 16; ++i) v[i] *= gain[k0 + 4 * i + lr];
    }
#pragma unroll
    for (int i = 0; i < 16; ++i) { LAS float* p = scr + (4 * i + lr) * 65 + lc; p[0] = v[i][0]; p[1] = v[i][1]; p[2] = v[i][2]; p[3] = v[i][3]; }
    LDS_WAIT(); asm volatile("" ::: "memory");
    const int c = lane & 7;
#pragma unroll
    for (int j = 0; j < 8; ++j) { const int n = (lane >> 3) + 8 * j; const LAS float* s = scr + (8 * c) * 65 + n;
        u32x4 o; o.x = cvt_pk_bf16(s[0 * 65], s[1 * 65]); o.y = cvt_pk_bf16(s[2 * 65], s[3 * 65]); o.z = cvt_pk_bf16(s[4 * 65], s[5 * 65]); o.w = cvt_pk_bf16(s[6 * 65], s[7 * 65]);
        *(u32x4*)(WT + (size_t)tr_map(mode, n0 + n) * ldt + k0 + 8 * c) = o; }
    LDS_WAIT(); asm volatile("" ::: "memory");
}
__device__ __forceinline__ void transpose_item8(const float* W, int K, int N, unsigned char* WT, int ldt, float scale, int mode, LAS float* scr, int item, int lane, const float* gain = nullptr) {
    const int nblk = N / 64, kb = item / nblk, nb = item % nblk, k0 = 64 * kb, n0 = 64 * nb;
    const int lr = lane >> 4, lc = (lane & 15) * 4;
    f32x4 v[16];
#pragma unroll
    for (int i = 0; i < 16; ++i) v[i] = *(const f32x4*)(W + (size_t)(k0 + 4 * i + lr) * N + n0 + lc);
#pragma unroll
    for (int i = 0; i < 16; ++i) { LAS float* p = scr + (4 * i + lr) * 65 + lc; const float sg = gain ? scale * gain[k0 + 4 * i + lr] : scale; p[0] = v[i][0] * sg; p[1] = v[i][1] * sg; p[2] = v[i][2] * sg; p[3] = v[i][3] * sg; }
    LDS_WAIT(); asm volatile("" ::: "memory");
    const int c = lane & 3;
#pragma unroll
    for (int j = 0; j < 4; ++j) { const int n = (lane >> 2) + 16 * j; const LAS float* s = scr + (16 * c) * 65 + n;
        u32x4 o; o.x = pk_fp8x4(s[0 * 65], s[1 * 65], s[2 * 65], s[3 * 65]); o.y = pk_fp8x4(s[4 * 65], s[5 * 65], s[6 * 65], s[7 * 65]);
        o.z = pk_fp8x4(s[8 * 65], s[9 * 65], s[10 * 65], s[11 * 65]); o.w = pk_fp8x4(s[12 * 65], s[13 * 65], s[14 * 65], s[15 * 65]);
        *(u32x4*)(WT + (size_t)tr_map(mode, n0 + n) * ldt + k0 + 16 * c) = o; }
    LDS_WAIT(); asm volatile("" ::: "memory");
}
__device__ __forceinline__ void transpose_matrix(const Ctx& C, const float* W, int K, int N, bf16* WT, int ldt, const float* gain, int mode) {
    LAS float* scr = (LAS float*)(C.lds + C.wave * 16896);
    const int gw = C.bx * NWAVES + C.wave, NGW = C.G * NWAVES, nitems = (K / 64) * (N / 64);
    for (int it = gw; it < nitems; it += NGW) transpose_item(W, K, N, WT, ldt, gain, mode, scr, it, C.lane);
}
__device__ __forceinline__ void moe_weight_prep(const Ctx& C, int layer, int it_lo = 0, int it_hi = 1 << 30, int gwo = -1, int ngwo = 0) {
    LAS float* scr = (LAS float*)(C.lds + C.wave * 16896);
    const int gw = C.bx * NWAVES + C.wave, NGW = C.G * NWAVES;
    const float* wg = C.in[I_MOE_WGATE] + (size_t)layer * 32 * 1024 * 512; const float* wu = C.in[I_MOE_WUP] + (size_t)layer * 32 * 1024 * 512; const float* wd = C.in[I_MOE_WDOWN] + (size_t)layer * 32 * 512 * 1024;
    unsigned char* w1 = C.ws + WS_MOEW1; unsigned char* w2 = C.ws + WS_MOEW2;
    constexpr int IT1 = (1024 / 64) * (512 / 64), IT2 = (512 / 64) * (1024 / 64);
    const int total = 32 * (2 * IT1 + IT2), hi_ = it_hi < total ? it_hi : total;
    for (int it = it_lo + (gwo >= 0 ? gwo : gw); it < hi_; it += (gwo >= 0 ? ngwo : NGW)) {
        const int e = it / (2 * IT1 + IT2); int r = it % (2 * IT1 + IT2);
        if (r < IT1) { transpose_item8(wg + (size_t)e * 1024 * 512, 1024, 512, w1 + (size_t)e * 1024 * 1024, 1024, 64.f, 4, scr, r, C.lane); continue; } r -= IT1;
        if (r < IT1) { transpose_item8(wu + (size_t)e * 1024 * 512, 1024, 512, w1 + (size_t)e * 1024 * 1024, 1024, 64.f, 5, scr, r, C.lane); continue; } r -= IT1;
        transpose_item8(wd + (size_t)e * 512 * 1024, 512, 1024, w2 + (size_t)e * 1024 * 512, 512, 64.f, 0, scr, r, C.lane);
    }
}

__device__ __forceinline__ void prologue(const Ctx& C) {
    const int gw = C.bx * NWAVES + C.wave, NGW = C.G * NWAVES, gt = C.bx * NTHR + C.tid, NGT = C.G * NTHR;
    unsigned char* ws = C.ws;
    for (int i = gt; i < 64 * 1024 / 8; i += NGT) ((u32x4*)(ws + WA_T + (size_t)704 * 1024 * 2))[i] = (u32x4){0u, 0u, 0u, 0u};
    {
        LAS float* scr = (LAS float*)(C.lds + C.wave * 16896);
        constexpr int N_WA = 16 * 11, N_UQ = 6 * 24, N_UKV = 4 * 32, N_SQ = 16 * 16, N_WIN = 16 * 64, N_GWO = 32 * 16, N_QKV = 16 * 72, N_DWO = 8 * 16, N_PP = 4 * 16;
        constexpr int TOTAL = N_WA + N_UQ + N_UKV + 2 * N_SQ + N_WIN + N_GWO + N_QKV + N_DWO + DEPTH * (N_SQ + N_PP);
        for (int it = gw; it < TOTAL; it += NGW) {
            int r = it;
            if (r < N_WA)  { transpose_item(C.in[I_MLA_WA], 1024, 704, (bf16*)(ws + WA_T), 1024, C.in[I_NORM_MIX] + 0 * 1024, 1, scr, r, C.lane); continue; } r -= N_WA;
            if (r < N_UQ)  { transpose_item(C.in[I_MLA_WUQ], 384, 1536, (bf16*)(ws + WUQ_T), 384, C.in[I_MLA_NQ], 2, scr, r, C.lane); continue; } r -= N_UQ;
            if (r < N_UKV) { transpose_item(C.in[I_MLA_WUKV], 256, 2048, (bf16*)(ws + WUKV_T), 256, C.in[I_MLA_NKV], 0, scr, r, C.lane); continue; } r -= N_UKV;
            if (r < N_SQ)  { transpose_item8(C.in[I_MLA_WO], 1024, 1024, ws + WOM_T, 1024, 64.f, 0, scr, r, C.lane); continue; } r -= N_SQ;
            if (r < N_SQ)  { transpose_item8(C.in[I_FN_WO], 1024, 1024, ws + WOF_T, 1024, 64.f, 0, scr, r, C.lane); continue; } r -= N_SQ;
            if (r < N_WIN) { transpose_item8(C.in[I_GM_WIN], 1024, 4096, ws + WIN_T, 1024, 64.f, 0, scr, r, C.lane, C.in[I_NORM_MIX] + 2 * 1024); continue; } r -= N_WIN;
            if (r < N_GWO) { transpose_item8(C.in[I_GM_WO], 2048, 1024, ws + WOG_T, 2048, 64.f, 0, scr, r, C.lane); continue; } r -= N_GWO;
            if (r < N_QKV) { transpose_item8(C.in[I_DL_WQKV], 1024, 4608, ws + WQKV_T, 1024, 64.f, 3, scr, r, C.lane, C.in[I_NORM_MIX] + 3 * 1024); continue; } r -= N_QKV;
            if (r < N_DWO) { transpose_item8(C.in[I_DL_WO], 512, 1024, ws + WOD_T, 512, 64.f, 0, scr, r, C.lane); continue; } r -= N_DWO;
            const int l = r / (N_SQ + N_PP); r -= l * (N_SQ + N_PP);
            if (r < N_SQ)  { transpose_item8(C.in[I_PLE_WGATE] + (size_t)l * 1024 * 1024, 1024, 1024, ws + WG_T + (size_t)l * 1024 * 1024, 1024, 64.f, 0, scr, r, C.lane); continue; } r -= N_SQ;
            transpose_item(C.in[I_PLE_WPROJ] + (size_t)l * 256 * 1024, 256, 1024, (bf16*)(ws + WP_T) + (size_t)l * 1024 * 256, 256, nullptr, 0, scr, r, C.lane);
        }
    }
    {
        const float* gain = C.in[I_NORM_MIX] + 1 * 1024; bf16* F = (bf16*)(ws + FCH_T);
        for (int i = gt; i < 4 * 512 * 256 / 2; i += NGT) {
            const int e = i * 2, k = e & 255, f = (e >> 8) & 511, g = e >> 17;
            float v[2];
#pragma unroll
            for (int j = 0; j < 2; ++j) { const int kk = k + j, ff = f & 255; const float x = (float)((ff * kk) & 255) * (1.0f / 256.0f);
                const float t = f < 256 ? __builtin_amdgcn_cosf(x) : -__builtin_amdgcn_sinf(x); v[j] = t * gain[g * 256 + kk]; }
            ((unsigned*)F)[i] = cvt_pk_bf16(v[0], v[1]);
        }
    }
    {
        bf16* W1 = (bf16*)(ws + FW1_T); bf16* W2 = (bf16*)(ws + FW2_T); float* twc = (float*)(ws + FTWC); float* tws = (float*)(ws + FTWS);
        for (int i = gt; i < 256 * 256; i += NGT) { const int col = i & 255, row = i >> 8, p = col >> 7, s1 = col & 127, pp = row >> 7, k1 = row & 127;
            const float x = (float)((s1 * k1) & 127) * (1.0f / 128.0f); const float cv = __builtin_amdgcn_cosf(x), sv = __builtin_amdgcn_sinf(x);
            const float v = (pp == p) ? cv : (pp == 0 ? sv : -sv); W1[i] = (bf16)(cvt_pk_bf16(v, 0.f) & 0xffffu); }
        for (int i = gt; i < 256 * 128; i += NGT) { const int col = i & 127, row = i >> 7, p = col >> 6, s2 = col & 63;
            float v = 0.f; if (row < 64) { const float x = (float)((s2 * row) & 63) * (1.0f / 64.0f); v = p == 0 ? __builtin_amdgcn_cosf(x) : __builtin_amdgcn_sinf(x); }
            W2[i] = (bf16)(cvt_pk_bf16(v, 0.f) & 0xffffu); }
        for (int i = gt; i < 128 * 64; i += NGT) { const int s2 = i & 63, k1 = i >> 6; const float x = (float)(s2 * k1) * (1.0f / 8192.0f); twc[i] = __builtin_amdgcn_cosf(x); tws[i] = __builtin_amdgcn_sinf(x); }
    }
    {
        float* ct = (float*)(ws + WS_COS); float* st = (float*)(ws + WS_SIN);
        for (int i = gt; i < SEQ * 32; i += NGT) { const int s = i >> 5, j = i & 31; const float inv = exp2f(-13.287712379549449f * ((float)(2 * j) / 64.0f)); const float ang = (float)s * inv;
            const double rv = (double)ang * 0.15915494309189535; const float fr = (float)(rv - floor(rv));
            ct[i] = __builtin_amdgcn_cosf(fr); st[i] = __builtin_amdgcn_sinf(fr); }
    }
    {
        u32x4* wp = (u32x4*)(ws + WS_WPERM);
        for (int i = gt; i < DEPTH * 32 * 64 * 6; i += NGT) {
            const int q = i % 6, l = (i / 6) & 63, st = (i / (6 * 64)) & 31, layer = i / (6 * 64 * 32);
            const int nb = q >> 1, part = q & 1, c = nb * 16 + (l & 15);
            float v[8];
#pragma unroll
            for (int j = 0; j < 8; ++j) { const int k = 32 * st + 8 * (l >> 4) + j; float w = 0.f;
                if (c < 4) w = C.in[I_MOE_WGRP][((size_t)layer * 1024 + k) * 4 + c]; else if (c < 36) w = C.in[I_MOE_WEXP][((size_t)layer * 1024 + k) * 32 + (c - 4)];
                w *= C.in[I_NORM_MOE][layer * 1024 + k];
                const float hi = bflo(cvt_pk_bf16(w, 0.f)); v[j] = part == 0 ? hi : w - hi; }
            wp[i] = (u32x4){cvt_pk_bf16(v[0], v[1]), cvt_pk_bf16(v[2], v[3]), cvt_pk_bf16(v[4], v[5]), cvt_pk_bf16(v[6], v[7])};
        }
    }
    {
        const f32x4* p = (const f32x4*)C.in[I_P]; u32x2* pb = (u32x2*)(ws + WS_PB);
        static_assert((DEPTH * NTOK * 256 / 4) % (8 * 256 * NTHR) == 0, "p conversion batches");
        for (int i = gt; i < DEPTH * NTOK * 256 / 4; i += 8 * NGT) {
            f32x4 v[8];
#pragma unroll
            for (int k = 0; k < 8; ++k) v[k] = p[i + k * NGT];
#pragma unroll
            for (int k = 0; k < 8; ++k) pb[i + k * NGT] = pack4(v[k]); }
    }
    {
        const float* x = C.in[I_X]; bf16* HB = (bf16*)(ws + WS_HB); float* SSQ = (float*)(ws + WS_SSQ);
        for (int r0 = gw; r0 < NTOK; r0 += 4 * NGW) {
            f32x4 xv[4][4];
#pragma unroll
            for (int q = 0; q < 4; ++q) { const f32x4* xr = (const f32x4*)(x + (size_t)(r0 + q * NGW) * DM) + C.lane;
#pragma unroll
                for (int j = 0; j < 4; ++j) xv[q][j] = xr[64 * j]; }
#pragma unroll
            for (int q = 0; q < 4; ++q) { const int r = r0 + q * NGW; u32x2* br = (u32x2*)(HB + (size_t)r * DM) + C.lane;
                float s = 0.f;
#pragma unroll
                for (int j = 0; j < 4; ++j) { const u32x2 w = pack4(xv[q][j]); br[64 * j] = w; s += sumsq4(unpack4(w)); }
                s = wave_sum(s);
                if (C.lane < 16) SSQ[(size_t)r * 16 + C.lane] = C.lane == 0 ? s : 0.f; }
        }
    }
    moe_weight_prep(C, 0, 0, C.G == 256 ? 8192 : (1 << 30));
}

__device__ __forceinline__ float rstd_from_slots16(const float* SSQ, int row) {
    const f32x4* p = (const f32x4*)(SSQ + (size_t)row * 16); const f32x4 a = p[0], b = p[1], c = p[2], d = p[3];
    const float s = ((a[0] + a[1]) + (a[2] + a[3])) + ((b[0] + b[1]) + (b[2] + b[3])) + ((c[0] + c[1]) + (c[2] + c[3])) + ((d[0] + d[1]) + (d[2] + d[3]));
    return __builtin_amdgcn_rsqf(s * (1.0f / 1024.0f) + EPS);
}
__device__ __forceinline__ float rstd_from_slots8(const float* S8, int row, float invn) {
    const f32x4* p = (const f32x4*)(S8 + (size_t)row * 8); const f32x4 a = p[0], b = p[1];
    const float s = ((a[0] + a[1]) + (a[2] + a[3])) + ((b[0] + b[1]) + (b[2] + b[3]));
    return __builtin_amdgcn_rsqf(s * invn + EPS);
}
__device__ __forceinline__ float slots16_part(const float* SSQ, int row, int fq) { const f32x4 a = ((const f32x4*)(SSQ + (size_t)row * 16))[fq]; return (a[0] + a[1]) + (a[2] + a[3]); }
__device__ __forceinline__ float slots16_finish(float s) { s += __shfl_xor(s, 16); s += __shfl_xor(s, 32); return __builtin_amdgcn_rsqf(s * (1.0f / 1024.0f) + EPS); }
__device__ __forceinline__ float slots8_part(const float* S8, int row, int fq) { const f32x4 a = ((const f32x4*)(S8 + (size_t)row * 8))[fq & 1]; return (a[0] + a[1]) + (a[2] + a[3]); }
__device__ __forceinline__ float slots8_finish(float s, float invn) { s += __shfl_xor(s, 16); return __builtin_amdgcn_rsqf(s * invn + EPS); }
__device__ __forceinline__ void rope4(f32x4& v0, f32x4& v1, const float* ct, const float* st, int pos, int j0) {
    const f32x4 c = *(const f32x4*)(ct + pos * 32 + j0), s = *(const f32x4*)(st + pos * 32 + j0);
    const f32x4 a = v0 * c - v1 * s, b = v1 * c + v0 * s; v0 = a; v1 = b;
}

typedef f32x4 Acc[2][2][4][2];
using pg8::Unit;

struct EpiStoreBf16 {
    bf16* O; int ldc; float scale; size_t bstride;
    __device__ __forceinline__ void operator()(const Acc& acc, const Unit& u, int wr, int wc, int fr, int fq) const {
        bf16* base = O + (size_t)u.aux * bstride;
        EPI_LOOP_BEGIN
            bf16* rp = base + (size_t)(u.pm * 256 + rowt) * ldc + u.pn * 256 + wc * 32 + 4 * fq;
#pragma unroll
            for (int bj = 0; bj < 2; ++bj) { *(u32x2*)(rp + bj * 128) = pack4(acc[ai][bj][m][0] * scale); *(u32x2*)(rp + bj * 128 + 16) = pack4(acc[ai][bj][m][1] * scale); }
        EPI_LOOP_END
    }
};
struct EpiResidual {
    bf16* H; const float* bias; float scale, bsc;
    __device__ __forceinline__ void operator()(const Acc& acc, const Unit& u, int wr, int wc, int fr, int fq) const {
        const int colb = u.pn * 256 + wc * 32 + 4 * fq;
#pragma unroll
        for (int ai = 0; ai < 2; ++ai) {
            u32x2 hv[4][2][2];
#pragma unroll
            for (int m = 0; m < 4; ++m) { const bf16* rp = H + (size_t)(u.pm * 256 + ai * 128 + wr * 64 + m * 16 + fr) * DM + colb;
#pragma unroll
                for (int bj = 0; bj < 2; ++bj)
#pragma unroll
                    for (int n = 0; n < 2; ++n) hv[m][bj][n] = *(const u32x2*)(rp + bj * 128 + n * 16); }
#pragma unroll
            for (int m = 0; m < 4; ++m) { bf16* rp = H + (size_t)(u.pm * 256 + ai * 128 + wr * 64 + m * 16 + fr) * DM + colb;
#pragma unroll
                for (int bj = 0; bj < 2; ++bj)
#pragma unroll
                    for (int n = 0; n < 2; ++n) { f32x4 v = unpack4(hv[m][bj][n]) + acc[ai][bj][m][n] * scale; if (bias) v += *(const f32x4*)(bias + colb + bj * 128 + n * 16) * bsc; *(u32x2*)(rp + bj * 128 + n * 16) = pack4(v); } }
        }
    }
};
struct EpiMlaA {
    const float* SSQ; bf16* CQ; bf16* CKV; bf16* KR; float* SSQQ; float* SSQKV; const float* ct; const float* st;
    __device__ __forceinline__ void operator()(const Acc& acc, const Unit& u, int wr, int wc, int fr, int fq) const {
        float rsv_[2][4];
#pragma unroll
        for (int ai = 0; ai < 2; ++ai)
#pragma unroll
            for (int m = 0; m < 4; ++m) { const int row = u.pm * 256 + ai * 128 + wr * 64 + m * 16 + fr; rsv_[ai][m] = slots16_part(SSQ, row, fq); }
#pragma unroll
        for (int ai = 0; ai < 2; ++ai)
#pragma unroll
            for (int m = 0; m < 4; ++m) rsv_[ai][m] = slots16_finish(rsv_[ai][m]);
        EPI_LOOP_BEGIN
            const int row = u.pm * 256 + rowt; const float rs = rsv_[ai][m];
            float sq = 0.f, skv = 0.f;
#pragma unroll
            for (int bj = 0; bj < 2; ++bj) {
                f32x4 v0 = acc[ai][bj][m][0] * rs, v1 = acc[ai][bj][m][1] * rs; const int col = u.pn * 256 + bj * 128 + wc * 32 + 4 * fq;
                const int seg = u.pn * 2 + bj;
                if (seg < 3) { sq += sumsq4(v0) + sumsq4(v1); bf16* p = CQ + (size_t)row * 384 + col; *(u32x2*)p = pack4(v0); *(u32x2*)(p + 16) = pack4(v1); }
                else if (seg < 5) { skv += sumsq4(v0) + sumsq4(v1); bf16* p = CKV + (size_t)row * 256 + (col - 384); *(u32x2*)p = pack4(v0); *(u32x2*)(p + 16) = pack4(v1); }
                else if (wc < 2) { rope4(v0, v1, ct, st, row & (SEQ - 1), wc * 16 + 4 * fq); unsigned char* p = (unsigned char*)KR + (size_t)row * 64 + wc * 32 + 4 * fq; v0 *= K8_SCALE; v1 *= K8_SCALE;
                    *(unsigned*)p = pk_fp8x4(v0[0], v0[1], v0[2], v0[3]); *(unsigned*)(p + 16) = pk_fp8x4(v1[0], v1[1], v1[2], v1[3]); }
            }
            sq += __shfl_xor(sq, 16); sq += __shfl_xor(sq, 32); skv += __shfl_xor(skv, 16); skv += __shfl_xor(skv, 32);
            if (fq == 0) {
                if (u.pn == 0) SSQQ[(size_t)row * 8 + wc] = sq;
                else if (u.pn == 1) { SSQQ[(size_t)row * 8 + 4 + wc] = sq; SSQKV[(size_t)row * 8 + wc] = skv; }
                else SSQKV[(size_t)row * 8 + 4 + wc] = skv;
            }
        EPI_LOOP_END
    }
};
struct EpiMlaQ {
    const float* SSQQ; bf16* Q; const float* ct; const float* st;
    __device__ __forceinline__ void operator()(const Acc& acc, const Unit& u, int wr, int wc, int fr, int fq) const {
        float rsv_[2][4];
#pragma unroll
        for (int ai = 0; ai < 2; ++ai)
#pragma unroll
            for (int m = 0; m < 4; ++m) { const int row = u.pm * 256 + ai * 128 + wr * 64 + m * 16 + fr; rsv_[ai][m] = slots8_part(SSQQ, row, fq); }
#pragma unroll
        for (int ai = 0; ai < 2; ++ai)
#pragma unroll
            for (int m = 0; m < 4; ++m) rsv_[ai][m] = slots8_finish(rsv_[ai][m], 1.0f / 384.0f);
        EPI_LOOP_BEGIN
            const int row = u.pm * 256 + rowt; const float rs = rsv_[ai][m];
#pragma unroll
            for (int bj = 0; bj < 2; ++bj) {
                f32x4 v0 = acc[ai][bj][m][0] * rs, v1 = acc[ai][bj][m][1] * rs; const int g32 = u.pn * 8 + bj * 4 + wc, gi = g32 % 6;
                if (gi >= 4) rope4(v0, v1, ct, st, row & (SEQ - 1), (gi - 4) * 16 + 4 * fq);
                unsigned char* p = (unsigned char*)Q + (size_t)row * 1536 + g32 * 32 + 4 * fq; v0 *= Q8_SCALE; v1 *= Q8_SCALE;
                *(unsigned*)p = pk_fp8x4(v0[0], v0[1], v0[2], v0[3]); *(unsigned*)(p + 16) = pk_fp8x4(v1[0], v1[1], v1[2], v1[3]);
            }
        EPI_LOOP_END
    }
};
struct MlaKnSched { const bf16* A; const bf16* W; int K, ldb, G, c;
    __device__ __forceinline__ bool next(int i, Unit& u) const { const int L = i * G + c; if (L >= 512) return false;
        u.pn = L & 3; u.pm = L >> 2; u.aux = 0; u.a = (const char*)(A + (size_t)u.pm * 256 * 256); u.b = (const char*)(W + (size_t)(2 * u.pn) * 256 * 256); return true; }
    __device__ __forceinline__ unsigned aoff(const Unit&, int half, int R, int Cc) const { return (unsigned)((R + 128 * half) * 256 + Cc) * 2u; }
    __device__ __forceinline__ unsigned boff(int R, int Cc) const { return (unsigned)(R * 256 + Cc) * 2u; }
    __device__ __forceinline__ size_t hstepB() const { return (size_t)256 * 256 * 2; } };
struct EpiMlaKN {
    const float* SSQKV; unsigned char* KN;
    __device__ __forceinline__ void operator()(const Acc& acc, const Unit& u, int wr, int wc, int fr, int fq) const {
        float rsv_[2][4];
#pragma unroll
        for (int ai = 0; ai < 2; ++ai)
#pragma unroll
            for (int m = 0; m < 4; ++m) { const int row = u.pm * 256 + ai * 128 + wr * 64 + m * 16 + fr; rsv_[ai][m] = slots8_part(SSQKV, row, fq); }
#pragma unroll
        for (int ai = 0; ai < 2; ++ai)
#pragma unroll
            for (int m = 0; m < 4; ++m) rsv_[ai][m] = slots8_finish(rsv_[ai][m], 1.0f / 256.0f) * K8_SCALE;
        EPI_LOOP_BEGIN
            const int row = u.pm * 256 + rowt; const float rs = rsv_[ai][m];
            unsigned char* rp = KN + (size_t)row * 1024 + (2 * u.pn) * 128 + wc * 32 + 4 * fq;
#pragma unroll
            for (int bj = 0; bj < 2; ++bj) { const f32x4 v0 = acc[ai][bj][m][0] * rs, v1 = acc[ai][bj][m][1] * rs;
                *(unsigned*)(rp + bj * 128) = pk_fp8x4(v0[0], v0[1], v0[2], v0[3]); *(unsigned*)(rp + bj * 128 + 16) = pk_fp8x4(v1[0], v1[1], v1[2], v1[3]); }
        EPI_LOOP_END
    }
};
struct MlaVtSched { const bf16* W; const bf16* Bm; int K, ldb, G, c;
    __device__ __forceinline__ bool next(int i, Unit& u) const { const int L = i * G + c; if (L >= 512) return false;
        u.pn = L >> 2; u.pm = L & 3; u.aux = 0; u.a = (const char*)(W + ((size_t)(2 * u.pm) * 256 + 128) * 256); u.b = (const char*)(Bm + (size_t)u.pn * 256 * 256); return true; }
    __device__ __forceinline__ unsigned aoff(const Unit&, int half, int R, int Cc) const { return (unsigned)((R + 256 * half) * 256 + Cc) * 2u; }
    __device__ __forceinline__ unsigned boff(int R, int Cc) const { return (unsigned)(R * 256 + Cc) * 2u; }
    __device__ __forceinline__ size_t hstepB() const { return (size_t)128 * 256 * 2; } };
struct EpiMlaVT {
    const float* SSQKV; unsigned char* VT;
    __device__ __forceinline__ void operator()(const Acc& acc, const Unit& u, int wr, int wc, int fr, int fq) const {
        f32x4 rs[2][2];
#pragma unroll
        for (int bj = 0; bj < 2; ++bj)
#pragma unroll
            for (int n = 0; n < 2; ++n)
#pragma unroll
                for (int i = 0; i < 4; ++i) rs[bj][n][i] = rstd_from_slots8(SSQKV, u.pn * 256 + bj * 128 + wc * 32 + n * 16 + 4 * fq + i, 1.0f / 256.0f) * ATT8_SCALE;
        const int tok0 = u.pn * 256 + wc * 32 + 4 * fq, b = tok0 >> 13, s0 = tok0 & (SEQ - 1);
        EPI_LOOP_BEGIN
            const int head = 2 * u.pm + ai, d = wr * 64 + m * 16 + fr;
            unsigned char* rp = VT + ((size_t)(b * 8 + head) * 128 + d) * SEQ + s0;
#pragma unroll
            for (int bj = 0; bj < 2; ++bj) { const f32x4 v0 = acc[ai][bj][m][0] * rs[bj][0], v1 = acc[ai][bj][m][1] * rs[bj][1];
                *(unsigned*)(rp + bj * 128) = pk_fp8x4(v0[0], v0[1], v0[2], v0[3]); *(unsigned*)(rp + bj * 128 + 16) = pk_fp8x4(v1[0], v1[1], v1[2], v1[3]); }
        EPI_LOOP_END
    }
};
struct FnetTSched { const bf16* Fch; const bf16* HB; int K, ldb, G, c;
    __device__ __forceinline__ bool next(int i, Unit& u) const { const int L = i * G + c; if (L >= 1024) return false;
        const int pn = L & 31, pm = (L >> 5) & 1, g = (L >> 6) & 3, b = L >> 8; u.pm = pm; u.pn = pn; u.aux = b * 4 + g;
        u.a = (const char*)(Fch + (size_t)(g * 512 + pm * 256) * 256); u.b = (const char*)(HB + ((size_t)(b * SEQ + pn * 2)) * 1024 + g * 256); return true; }
    __device__ __forceinline__ unsigned aoff(const Unit&, int half, int R, int Cc) const { return (unsigned)((R + 128 * half) * 256 + Cc) * 2u; }
    __device__ __forceinline__ unsigned boff(int R, int Cc) const { return (unsigned)(R * 64 * 1024 + Cc) * 2u; }
    __device__ __forceinline__ size_t hstepB() const { return (size_t)1024 * 2; } };
struct EpiFnetT {
    const float* SSQ; bf16* TT;
    __device__ __forceinline__ void operator()(const Acc& acc, const Unit& u, int wr, int wc, int fr, int fq) const {
        const int b = u.aux >> 2, g = u.aux & 3;
        f32x4 rs[2][2];
#pragma unroll
        for (int bj = 0; bj < 2; ++bj)
#pragma unroll
            for (int n = 0; n < 2; ++n)
#pragma unroll
                for (int i = 0; i < 4; ++i) rs[bj][n][i] = rstd_from_slots16(SSQ, b * SEQ + (wc * 32 + n * 16 + 4 * fq + i) * 64 + u.pn * 2 + bj);
        EPI_LOOP_BEGIN
            const int f = u.pm * 256 + rowt, part = f >> 8, j = f & 255;
#pragma unroll
            for (int bj = 0; bj < 2; ++bj) {
                bf16* rp = TT + (((size_t)(b * 1024 + g * 256 + j) * 64 + u.pn * 2 + bj) * 2 + part) * 128 + wc * 32 + 4 * fq;
                *(u32x2*)rp = pack4(acc[ai][bj][m][0] * rs[bj][0]); *(u32x2*)(rp + 16) = pack4(acc[ai][bj][m][1] * rs[bj][1]); }
        EPI_LOOP_END
    }
};
struct FnetConstASched { const bf16* W; const bf16* Bm; int K, ldb, nunits, G, c;
    __device__ __forceinline__ bool next(int i, Unit& u) const { const int L = i * G + c; if (L >= nunits) return false;
        u.pm = 0; u.pn = L; u.aux = 0; u.a = (const char*)W; u.b = (const char*)(Bm + (size_t)L * 256 * ldb); return true; }
    __device__ __forceinline__ unsigned aoff(const Unit&, int half, int R, int Cc) const { return (unsigned)((R + 128 * half) * K + Cc) * 2u; }
    __device__ __forceinline__ unsigned boff(int R, int Cc) const { return (unsigned)(R * ldb + Cc) * 2u; }
    __device__ __forceinline__ size_t hstepB() const { return (size_t)128 * ldb * 2; } };
struct EpiFnet1 {
    bf16* Z; const float* twc; const float* tws;
    __device__ __forceinline__ void operator()(const Acc& acc, const Unit& u, int wr, int wc, int fr, int fq) const {
        f32x4 tc_[4][2], tn_[4][2];
#pragma unroll
        for (int m = 0; m < 4; ++m)
#pragma unroll
            for (int n = 0; n < 2; ++n) { const int k1 = wr * 64 + m * 16 + fr, s2 = (wc * 32 + n * 16 + 4 * fq) & 63; tc_[m][n] = *(const f32x4*)(twc + k1 * 64 + s2); tn_[m][n] = *(const f32x4*)(tws + k1 * 64 + s2); }
#pragma unroll
        for (int m = 0; m < 4; ++m) { const int k1 = wr * 64 + m * 16 + fr;
#pragma unroll
            for (int bj = 0; bj < 2; ++bj)
#pragma unroll
                for (int n = 0; n < 2; ++n) {
                    const int nrow = u.pn * 256 + bj * 128 + wc * 32 + n * 16 + 4 * fq, s2 = nrow & 63, c = (nrow >> 6) & 1023, b = nrow >> 16;
                    const f32x4 cs = tc_[m][n], sn = tn_[m][n];
                    const f32x4 zr = acc[0][bj][m][n], zi = acc[1][bj][m][n];
                    const f32x4 orr = zr * cs + zi * sn, oi = zi * cs - zr * sn;
                    bf16* p = Z + ((((size_t)(b * 128 + k1) * 1024 + c) * 2) * 64) + s2;
                    *(u32x2*)p = pack4(orr); *(u32x2*)(p + 64) = pack4(oi); }
        }
    }
};
struct EpiFnet2 {
    unsigned char* F; float scale;
    __device__ __forceinline__ void operator()(const Acc& acc, const Unit& u, int wr, int wc, int fr, int fq) const {
        if (wr != 0) return;
#pragma unroll
        for (int m = 0; m < 4; ++m) { const int k2 = m * 16 + fr;
#pragma unroll
            for (int bj = 0; bj < 2; ++bj)
#pragma unroll
                for (int n = 0; n < 2; ++n) {
                    const int nrow = u.pn * 256 + bj * 128 + wc * 32 + n * 16 + 4 * fq, c = nrow & 1023, k1 = (nrow >> 10) & 127, b = nrow >> 17;
                    const f32x4 v = acc[0][bj][m][n] * scale; *(unsigned*)(F + ((size_t)b * SEQ + k1 + 128 * k2) * 1024 + c) = pk_fp8x4(v[0], v[1], v[2], v[3]); }
        }
    }
};
__device__ __forceinline__ float gelu_tanh(float x) {
    const float u = x * (0.7978845608028654f + 0.035677408136300125f * x * x);
    return x * fast_rcp(1.0f + fast_exp2(-2.8853900817779268f * u));
}
struct EpiGmlpIn {
    const float* SSQ; bf16* U; bf16* V; float* SSQV; float sc;
    __device__ __forceinline__ void operator()(const Acc& acc, const Unit& u, int wr, int wc, int fr, int fq) const {
        const bool isv = u.pn >= 8; bf16* O = isv ? V : U; const int colt = (isv ? u.pn - 8 : u.pn) * 256 + wc * 32 + 4 * fq;
        float rsv_[2][4];
#pragma unroll
        for (int ai = 0; ai < 2; ++ai)
#pragma unroll
            for (int m = 0; m < 4; ++m) { const int row = u.pm * 256 + ai * 128 + wr * 64 + m * 16 + fr; rsv_[ai][m] = slots16_part(SSQ, row, fq); }
#pragma unroll
        for (int ai = 0; ai < 2; ++ai)
#pragma unroll
            for (int m = 0; m < 4; ++m) rsv_[ai][m] = slots16_finish(rsv_[ai][m]) * sc;
        EPI_LOOP_BEGIN
            const int row = u.pm * 256 + rowt; const float rs = rsv_[ai][m]; float sv = 0.f;
            bf16* rp = O + (size_t)row * 2048 + colt;
#pragma unroll
            for (int bj = 0; bj < 2; ++bj)
#pragma unroll
                for (int n = 0; n < 2; ++n) { f32x4 v = acc[ai][bj][m][n] * rs;
#pragma unroll
                    for (int i = 0; i < 4; ++i) v[i] = gelu_tanh(v[i]);
                    sv += sumsq4(v); *(u32x2*)(rp + bj * 128 + n * 16) = pack4(v); }
            if (isv) { sv += __shfl_xor(sv, 16); sv += __shfl_xor(sv, 32); if (fq == 0) SSQV[(size_t)row * 32 + (u.pn - 8) * 4 + wc] = sv; }
        EPI_LOOP_END
    }
};
struct EpiDilQkv {
    const float* SSQ; bf16* QKV; const float* ct; const float* st; float sc;
    __device__ __forceinline__ void operator()(const Acc& acc, const Unit& u, int wr, int wc, int fr, int fq) const {
        float rsv_[2][4];
#pragma unroll
        for (int ai = 0; ai < 2; ++ai)
#pragma unroll
            for (int m = 0; m < 4; ++m) { const int row = u.pm * 256 + ai * 128 + wr * 64 + m * 16 + fr; rsv_[ai][m] = slots16_part(SSQ, row, fq); }
#pragma unroll
        for (int ai = 0; ai < 2; ++ai)
#pragma unroll
            for (int m = 0; m < 4; ++m) rsv_[ai][m] = slots16_finish(rsv_[ai][m]) * sc;
        const int tq = (u.pn >> 1) % 3;
        f32x4 rc_[2][4], rn_[2][4];
        if (tq < 2) {
#pragma unroll
            for (int ai = 0; ai < 2; ++ai)
#pragma unroll
                for (int m = 0; m < 4; ++m) { const int pos = (u.pm * 256 + ai * 128 + wr * 64 + m * 16 + fr) & (SEQ - 1), j0 = (wc & 1) * 16 + 4 * fq; rc_[ai][m] = *(const f32x4*)(ct + pos * 32 + j0); rn_[ai][m] = *(const f32x4*)(st + pos * 32 + j0); }
        }
        EPI_LOOP_BEGIN
            const int row = u.pm * 256 + rowt; const float rs = rsv_[ai][m];
#pragma unroll
            for (int bj = 0; bj < 2; ++bj) {
                f32x4 v0 = acc[ai][bj][m][0] * rs, v1 = acc[ai][bj][m][1] * rs; const int g32 = u.pn * 8 + bj * 4 + wc;
                if (tq < 2) { const f32x4 a_ = v0 * rc_[ai][m] - v1 * rn_[ai][m], b_ = v1 * rc_[ai][m] + v0 * rn_[ai][m]; v0 = a_; v1 = b_; if (tq == 0) { v0 *= 0.125f; v1 *= 0.125f; } }
                bf16* p = QKV + (size_t)row * 4608 + g32 * 32 + 4 * fq; *(u32x2*)p = pack4(v0); *(u32x2*)(p + 16) = pack4(v1);
            }
        EPI_LOOP_END
    }
};
struct EpiPle {
    bf16* H; const bf16* PP; float* SSQ; float scale; unsigned char* H8; float asc;
    __device__ __forceinline__ void operator()(const Acc& acc, const Unit& u, int wr, int wc, int fr, int fq) const {
        const int colb = u.pn * 256 + wc * 32 + 4 * fq;
#pragma unroll
        for (int ai = 0; ai < 2; ++ai) {
            u32x2 hv[4][2][2], pv[4][2][2];
#pragma unroll
            for (int m = 0; m < 4; ++m) { const size_t ro = (size_t)(u.pm * 256 + ai * 128 + wr * 64 + m * 16 + fr) * DM + colb;
#pragma unroll
                for (int bj = 0; bj < 2; ++bj)
#pragma unroll
                    for (int n = 0; n < 2; ++n) { hv[m][bj][n] = *(const u32x2*)(H + ro + bj * 128 + n * 16); pv[m][bj][n] = *(const u32x2*)(PP + ro + bj * 128 + n * 16); } }
#pragma unroll
            for (int m = 0; m < 4; ++m) { const int row = u.pm * 256 + ai * 128 + wr * 64 + m * 16 + fr; float ss = 0.f;
#pragma unroll
                for (int bj = 0; bj < 2; ++bj)
#pragma unroll
                    for (int n = 0; n < 2; ++n) {
                        const size_t o = (size_t)row * DM + colb + bj * 128 + n * 16; const f32x4 a = acc[ai][bj][m][n]; const f32x4 pp = unpack4(pv[m][bj][n]); f32x4 h = unpack4(hv[m][bj][n]);
#pragma unroll
                        for (int i = 0; i < 4; ++i) h[i] += scale * pp[i] * fast_rcp(1.0f + fast_exp2(asc * a[i]));
                        const u32x2 hw = pack4(h); *(u32x2*)(H + o) = hw; ss += sumsq4(unpack4(hw));
                        if (H8) *(unsigned*)(H8 + o) = pk_fp8x4(h[0] * XN8_SCALE, h[1] * XN8_SCALE, h[2] * XN8_SCALE, h[3] * XN8_SCALE);
                    }
                ss += __shfl_xor(ss, 16); ss += __shfl_xor(ss, 32);
                if (fq == 0) SSQ[(size_t)row * 16 + u.pn * 4 + wc] = ss; }
        }
    }
};

__device__ __forceinline__ void moe_tables(const Ctx& C, int layer) {
    LAS int* T = (LAS int*)(C.lds + LDS_TAB);
    if (C.tid < 32) T[C.tid] = (int)__hip_atomic_load((unsigned*)(C.ws + WS_CTL) + CW_CNT + layer * 32 + C.tid, __ATOMIC_RELAXED, __HIP_MEMORY_SCOPE_AGENT);
    __syncthreads();
    if (C.tid == 0) { int s = 0; for (int e = 0; e < 32; ++e) { T[32 + e] = s; s += (T[e] + 255) >> 8; } T[64] = s; }
    __syncthreads();
}
struct MoeSched1 {
    const unsigned char* XN; const unsigned char* W1; const u32x2* LIST; const LAS int* T; int K, ldb, G, c;
    __device__ __forceinline__ bool next(int i, Unit& u) const {
        const int L = i * G + c, ntile = __builtin_amdgcn_readfirstlane(T[64]); if (L >= ntile * 4) return false;
        const int tile = L >> 2; u.pn = L & 3; int e = 0;
#pragma unroll 1
        for (int j = 16; j >= 1; j >>= 1) if (e + j < 32 && T[32 + e + j] <= tile) e += j;
        e = __builtin_amdgcn_readfirstlane(e); const int t0 = __builtin_amdgcn_readfirstlane(T[32 + e]);
        u.aux = e; u.pm = tile - t0; u.a = (const char*)XN; u.b = (const char*)(W1 + (size_t)e * 1024 * 1024 + (size_t)u.pn * 256 * 1024); return true;
    }
    __device__ __forceinline__ unsigned aoff(const Unit& u, int half, int R, int C) const {
        const int r = u.pm * 256 + R + 128 * half; unsigned tok = 0; if (r < T[u.aux]) tok = LIST[(size_t)u.aux * MOE_CAP + r].x >> 1;
        return tok * 1024u + 2u * (unsigned)C;
    }
    __device__ __forceinline__ unsigned boff(int R, int C) const { return (unsigned)(R * 1024 + 2 * C); }
    __device__ __forceinline__ size_t hstepB() const { return (size_t)128 * 1024; }
};
struct EpiMoe1 {
    unsigned char* HBUF; const LAS int* T;
    __device__ __forceinline__ void operator()(const Acc& acc, const Unit& u, int wr, int wc, int fr, int fq) const {
        unsigned char* base = HBUF + (size_t)__builtin_amdgcn_readfirstlane(T[32 + u.aux] + u.pm) * (256 * 512) + 128 * u.pn; constexpr float sc = 1.0f / (XN8_SCALE * W8_SCALE);
        const unsigned lo = (unsigned)(32 * wc + 8 * fq);
        EPI_LOOP_BEGIN
            unsigned w[2];
#pragma unroll
            for (int bj = 0; bj < 2; ++bj) { const f32x4 g = acc[ai][bj][m][0] * sc, up = acc[ai][bj][m][1] * (sc * HB8_SCALE); f32x4 h;
#pragma unroll
                for (int i = 0; i < 4; ++i) h[i] = g[i] * fast_rcp(1.0f + fast_exp2(-1.4426950408889634f * g[i])) * up[i];
                w[bj] = pk_fp8x4(h[0], h[1], h[2], h[3]); }
            *(u32x2*)(base + ((unsigned)rowt * 512u + lo)) = (u32x2){w[0], w[1]};
        EPI_LOOP_END
    }
};
struct MoeSched2 {
    const unsigned char* HBUF; const unsigned char* W2; const LAS int* T; int K, ldb, G, c;
    __device__ __forceinline__ bool next(int i, Unit& u) const {
        const int L = i * G + c, ntile = __builtin_amdgcn_readfirstlane(T[64]); if (L >= ntile * 4) return false;
        const int tile = L >> 2; u.pn = L & 3; int e = 0;
#pragma unroll 1
        for (int j = 16; j >= 1; j >>= 1) if (e + j < 32 && T[32 + e + j] <= tile) e += j;
        e = __builtin_amdgcn_readfirstlane(e); const int t0 = __builtin_amdgcn_readfirstlane(T[32 + e]);
        u.aux = e; u.pm = tile - t0; u.a = (const char*)(HBUF + (size_t)tile * 256 * 512); u.b = (const char*)(W2 + (size_t)e * 1024 * 512 + (size_t)u.pn * 256 * 512); return true;
    }
    __device__ __forceinline__ unsigned aoff(const Unit&, int half, int R, int C) const { return (unsigned)((R + 128 * half) * 512 + 2 * C); }
    __device__ __forceinline__ unsigned boff(int R, int C) const { return (unsigned)(R * 512 + 2 * C); }
    __device__ __forceinline__ size_t hstepB() const { return (size_t)128 * 512; }
};
struct EpiMoe2 {
    bf16* YB; const u32x2* LIST; const LAS int* T;
    __device__ __forceinline__ void operator()(const Acc& acc, const Unit& u, int wr, int wc, int fr, int fq) const {
        const int cnt = T[u.aux];
        u32x2 ents[2][4];
#pragma unroll
        for (int ai = 0; ai < 2; ++ai)
#pragma unroll
            for (int m = 0; m < 4; ++m) { const int r = u.pm * 256 + ai * 128 + wr * 64 + m * 16 + fr; ents[ai][m] = LIST[(size_t)u.aux * MOE_CAP + (r < cnt ? r : 0)]; }
        EPI_LOOP_BEGIN
            const int r = u.pm * 256 + rowt;
            if (r < cnt) {
                const u32x2 ent = ents[ai][m]; const float w = __uint_as_float(ent.y) * (YB8_SCALE / (HB8_SCALE * W8_SCALE));
                unsigned char* rp = (unsigned char*)YB + (size_t)ent.x * 1024 + u.pn * 256 + wc * 32 + 4 * fq;
#pragma unroll
                for (int bj = 0; bj < 2; ++bj) { const f32x4 a0 = acc[ai][bj][m][0] * w, a1 = acc[ai][bj][m][1] * w; *(unsigned*)(rp + bj * 128) = pk_fp8x4(a0[0], a0[1], a0[2], a0[3]); *(unsigned*)(rp + bj * 128 + 16) = pk_fp8x4(a1[0], a1[1], a1[2], a1[3]); }
            }
        EPI_LOOP_END
    }
};

__device__ __forceinline__ void router_phase(const Ctx& C, int layer, const bool dry = false) {
    const bf16* H = (const bf16*)(C.ws + WS_HB); unsigned char* XN = C.ws + WS_XN; const u32x4* wp = (const u32x4*)(C.ws + WS_WPERM) + (size_t)layer * 32 * 64 * 6;
    const float* gain = C.in[I_NORM_MOE] + layer * 1024; const float* bgrp = C.in[I_MOE_BGRP] + layer * 4; const float* bexp = C.in[I_MOE_BEXP] + layer * 32;
    u32x2* LIST = (u32x2*)(C.ws + WS_LIST); unsigned* CNT = (unsigned*)(C.ws + WS_CTL) + CW_CNT + layer * 32;
    LAS float* lg = (LAS float*)(C.lds);
    LAS float* sq = (LAS float*)(C.lds + 32768);
    LAS int* hist = (LAS int*)(C.lds + 36864);
    LAS int* tk = (LAS int*)(C.lds + 40960);
    const int lane = C.lane, wave = C.wave;
    for (int chunk = C.bx; chunk < NTOK / 128; chunk += C.G) {
        const int tok0 = chunk * 128 + wave * 16;
        if (C.tid < 64) hist[C.tid] = 0;
        f32x4 acc0 = {0.f, 0.f, 0.f, 0.f}, acc1 = acc0, acc2 = acc0; float ss = 0.f;
        const bf16* hrow = H + (size_t)(tok0 + (lane & 15)) * DM + 8 * (lane >> 4);
        const u32x4* wl = wp + lane * 6;
#pragma unroll 1
        for (int half = 0; half < 2; ++half) {
            u32x4 hws[16];
#pragma unroll
            for (int s_ = 0; s_ < 16; ++s_) hws[s_] = *(const u32x4*)(hrow + (half * 16 + s_) * 32);
#pragma unroll
            for (int s_ = 0; s_ < 16; ++s_) { const int st = half * 16 + s_;
                const u32x4 hw = hws[s_]; const bf16x8 hv = __builtin_bit_cast(bf16x8, hw);
                ss += (bflo(hw.x) * bflo(hw.x) + bfhi(hw.x) * bfhi(hw.x)) + (bflo(hw.y) * bflo(hw.y) + bfhi(hw.y) * bfhi(hw.y)) + (bflo(hw.z) * bflo(hw.z) + bfhi(hw.z) * bfhi(hw.z)) + (bflo(hw.w) * bflo(hw.w) + bfhi(hw.w) * bfhi(hw.w));
                const u32x4* w6 = wl + st * 384;
                acc0 = __builtin_amdgcn_mfma_f32_16x16x32_bf16(hv, __builtin_bit_cast(bf16x8, w6[0]), acc0, 0, 0, 0); acc0 = __builtin_amdgcn_mfma_f32_16x16x32_bf16(hv, __builtin_bit_cast(bf16x8, w6[1]), acc0, 0, 0, 0);
                acc1 = __builtin_amdgcn_mfma_f32_16x16x32_bf16(hv, __builtin_bit_cast(bf16x8, w6[2]), acc1, 0, 0, 0); acc1 = __builtin_amdgcn_mfma_f32_16x16x32_bf16(hv, __builtin_bit_cast(bf16x8, w6[3]), acc1, 0, 0, 0);
                acc2 = __builtin_amdgcn_mfma_f32_16x16x32_bf16(hv, __builtin_bit_cast(bf16x8, w6[4]), acc2, 0, 0, 0); acc2 = __builtin_amdgcn_mfma_f32_16x16x32_bf16(hv, __builtin_bit_cast(bf16x8, w6[5]), acc2, 0, 0, 0); }
        }
        ss += __shfl_xor(ss, 16); ss += __shfl_xor(ss, 32);
        LAS float* lgw = lg + wave * 16 * 48;
#pragma unroll
        for (int r = 0; r < 4; ++r) { const int t = (lane >> 4) * 4 + r; lgw[t * 48 + (lane & 15)] = acc0[r]; lgw[t * 48 + 16 + (lane & 15)] = acc1[r]; lgw[t * 48 + 32 + (lane & 15)] = acc2[r]; }
        if (lane < 16) sq[wave * 16 + lane] = ss;
        __syncthreads();
        if (lane < 16) {
            const int t = lane; const float rs = __builtin_amdgcn_rsqf(sq[wave * 16 + t] * (1.0f / 1024.0f) + EPS); const LAS float* L = lgw + t * 48;
            float pgv[4]; float mx = -3.0e38f; int g = 0;
#pragma unroll
            for (int j = 0; j < 4; ++j) { pgv[j] = L[j] * rs + bgrp[j]; if (pgv[j] > mx) { mx = pgv[j]; g = j; } }
            float den = 0.f;
#pragma unroll
            for (int j = 0; j < 4; ++j) den += __expf(pgv[j] - mx);
            const float ggate = 1.0f / den;
            float v0 = -3.0e38f, v1 = -3.0e38f; int i0 = 0, i1 = 0;
#pragma unroll
            for (int j = 0; j < 8; ++j) { const float le = L[4 + g * 8 + j] * rs + bexp[g * 8 + j];
                if (le > v0) { v1 = v0; i1 = i0; v0 = le; i0 = j; } else if (le > v1) { v1 = le; i1 = j; } }
            const float e1 = __expf(v1 - v0); const float w0 = ggate / (1.0f + e1), w1 = ggate * e1 / (1.0f + e1);
            const int ex0 = g * 8 + i0, ex1 = g * 8 + i1;
            const int r0 = __hip_atomic_fetch_add(&hist[ex0], 1, __ATOMIC_RELAXED, __HIP_MEMORY_SCOPE_WORKGROUP), r1 = __hip_atomic_fetch_add(&hist[ex1], 1, __ATOMIC_RELAXED, __HIP_MEMORY_SCOPE_WORKGROUP);
            LAS int* T = tk + (wave * 16 + t) * 8; T[0] = ex0; T[1] = ex1; T[2] = r0; T[3] = r1; T[4] = (int)__float_as_uint(w0); T[5] = (int)__float_as_uint(w1);
            sq[wave * 16 + t] = rs;
        }
        __syncthreads();
        if (C.tid < 32) { const int n = hist[C.tid]; hist[32 + C.tid] = (n && !dry) ? (int)__hip_atomic_fetch_add(CNT + C.tid, (unsigned)n, __ATOMIC_RELAXED, __HIP_MEMORY_SCOPE_AGENT) : 0; }
        __syncthreads();
        if (C.tid < 128 && !dry) { const LAS int* T = tk + C.tid * 8; const unsigned tokid = (unsigned)(chunk * 128 + C.tid);
            LIST[(size_t)T[0] * MOE_CAP + hist[32 + T[0]] + T[2]] = (u32x2){tokid * 2u, (unsigned)T[4]};
            LIST[(size_t)T[1] * MOE_CAP + hist[32 + T[1]] + T[3]] = (u32x2){tokid * 2u + 1u, (unsigned)T[5]}; }
        { const f32x4* gr = (const f32x4*)gain + lane; const f32x4 g0 = gr[0], g1 = gr[64], g2 = gr[128], g3 = gr[192];
#pragma unroll 1
          for (int t = 0; t < 16; t += 4) {
            u32x2 hv[4][4];
#pragma unroll
            for (int tt = 0; tt < 4; ++tt) { const u32x2* hr = (const u32x2*)(H + (size_t)(tok0 + t + tt) * DM) + lane;
#pragma unroll
                for (int j = 0; j < 4; ++j) hv[tt][j] = hr[64 * j]; }
#pragma unroll
            for (int tt = 0; tt < 4; ++tt) { const float rs8 = sq[wave * 16 + t + tt] * XN8_SCALE; unsigned* xr = (unsigned*)(XN + (size_t)(tok0 + t + tt) * DM) + lane;
                const f32x4 a = unpack4(hv[tt][0]) * g0 * rs8, b = unpack4(hv[tt][1]) * g1 * rs8, c = unpack4(hv[tt][2]) * g2 * rs8, d = unpack4(hv[tt][3]) * g3 * rs8;
                xr[0] = pk_fp8x4(a[0], a[1], a[2], a[3]); xr[64] = pk_fp8x4(b[0], b[1], b[2], b[3]); xr[128] = pk_fp8x4(c[0], c[1], c[2], c[3]); xr[192] = pk_fp8x4(d[0], d[1], d[2], d[3]); }
          } }
        __syncthreads();
    }
}
__device__ __forceinline__ void combine_phase(const Ctx& C, const float* gain, const float scale) {
    bf16* H = (bf16*)(C.ws + WS_HB); unsigned char* XN = C.ws + WS_XN; const bf16* YB = (const bf16*)(C.ws + AR_YB);
    const int gw = C.bx * NWAVES + C.wave, NGW = C.G * NWAVES;
    const f32x4* gr = (const f32x4*)gain + C.lane; const f32x4 g0 = gr[0], g1 = gr[64], g2 = gr[128], g3 = gr[192];
    for (int row = gw; row < NTOK; row += 2 * NGW) {
        u32x2 hin[2][4]; unsigned ya[2][4], yb[2][4];
#pragma unroll
        for (int q = 0; q < 2; ++q) { const int rw = row + q * NGW; const u32x2* hr = (const u32x2*)(H + (size_t)rw * DM) + C.lane; const unsigned* y0 = (const unsigned*)((const unsigned char*)YB + (size_t)rw * 2048) + C.lane;
#pragma unroll
            for (int j = 0; j < 4; ++j) { hin[q][j] = hr[64 * j]; ya[q][j] = y0[64 * j]; yb[q][j] = y0[256 + 64 * j]; } }
#pragma unroll
        for (int q = 0; q < 2; ++q) { const int rw = row + q * NGW; u32x2* hr = (u32x2*)(H + (size_t)rw * DM) + C.lane; unsigned* xr = (unsigned*)(XN + (size_t)rw * DM) + C.lane;
            f32x4 v[4]; float s = 0.f;
#pragma unroll
            for (int j = 0; j < 4; ++j) { const unsigned a_ = ya[q][j], b_ = yb[q][j]; const f32x4 ys = {__builtin_amdgcn_cvt_f32_fp8(a_, 0) + __builtin_amdgcn_cvt_f32_fp8(b_, 0), __builtin_amdgcn_cvt_f32_fp8(a_, 1) + __builtin_amdgcn_cvt_f32_fp8(b_, 1), __builtin_amdgcn_cvt_f32_fp8(a_, 2) + __builtin_amdgcn_cvt_f32_fp8(b_, 2), __builtin_amdgcn_cvt_f32_fp8(a_, 3) + __builtin_amdgcn_cvt_f32_fp8(b_, 3)};
                const u32x2 hw = pack4(unpack4(hin[q][j]) + ys * (scale / YB8_SCALE)); hr[64 * j] = hw; v[j] = unpack4(hw); s += sumsq4(v[j]); }
            const float rs = __builtin_amdgcn_rsqf(wave_sum(s) * (1.0f / 1024.0f) + EPS) * XN8_SCALE;
            const f32x4 a = v[0] * g0 * rs, b = v[1] * g1 * rs, c = v[2] * g2 * rs, d = v[3] * g3 * rs;
            xr[0] = pk_fp8x4(a[0], a[1], a[2], a[3]); xr[64] = pk_fp8x4(b[0], b[1], b[2], b[3]); xr[128] = pk_fp8x4(c[0], c[1], c[2], c[3]); xr[192] = pk_fp8x4(d[0], d[1], d[2], d[3]); }
    }
}
__device__ __forceinline__ void final_phase(const Ctx& C) {
    const bf16* H = (const bf16*)(C.ws + WS_HB); const float* gain = C.in[I_NORM_FINAL];
    const int gw = C.bx * NWAVES + C.wave, NGW = C.G * NWAVES;
    const f32x4* gr = (const f32x4*)gain + C.lane; const f32x4 g0 = gr[0], g1 = gr[64], g2 = gr[128], g3 = gr[192];
    for (int row0 = gw; row0 < NTOK; row0 += 4 * NGW) {
        u32x2 hv[4][4];
#pragma unroll
        for (int q = 0; q < 4; ++q) { const u32x2* hr = (const u32x2*)(H + (size_t)(row0 + q * NGW) * DM) + C.lane;
#pragma unroll
            for (int j = 0; j < 4; ++j) hv[q][j] = hr[64 * j]; }
#pragma unroll
        for (int q = 0; q < 4; ++q) { f32x4* o = (f32x4*)(C.out + (size_t)(row0 + q * NGW) * DM) + C.lane;
            f32x4 v[4]; float s = 0.f;
#pragma unroll
            for (int j = 0; j < 4; ++j) { v[j] = unpack4(hv[q][j]); s += sumsq4(v[j]); }
            const float rs = __builtin_amdgcn_rsqf(wave_sum(s) * (1.0f / 1024.0f) + EPS);
            o[0] = v[0] * g0 * rs; o[64] = v[1] * g1 * rs; o[128] = v[2] * g2 * rs; o[192] = v[3] * g3 * rs; }
    }
}
template <int OFF> __device__ __forceinline__ s16x4 tr_read_a(int addr) { s16x4 r; asm volatile("ds_read_b64_tr_b16 %0, %1 offset:%2" : "=&v"(r) : "v"(addr), "i"(OFF) : "memory"); return r; }
__device__ __forceinline__ void spatial_phase(const Ctx& C) {
    const bf16* U = (const bf16*)(C.ws + AR_U); const bf16* V = (const bf16*)(C.ws + AR_V); unsigned char* Gt = C.ws + AR_G; const float* SSQV = (const float*)(C.ws + AR_SSQV);
    const float* Ws = C.in[I_GM_WS]; const float* bs = C.in[I_GM_BS]; const float* nv = C.in[I_GM_NV];
    const int g = C.bx & 15, tid = C.tid, lane = C.lane, fr = lane & 15, fq = lane >> 4, wp = C.wave >> 1, wd = C.wave & 1;
    bf16x8 Af[2][4];
#pragma unroll
    for (int m = 0; m < 2; ++m)
#pragma unroll
        for (int ks = 0; ks < 4; ++ks) { const f32x4* src = (const f32x4*)(Ws + (size_t)g * 16384 + (32 * wp + 16 * m + fr) * 128 + 32 * ks + 8 * fq); const f32x4 x = src[0], y = src[1];
            u32x4 w = {cvt_pk_bf16(x[0], x[1]), cvt_pk_bf16(x[2], x[3]), cvt_pk_bf16(y[0], y[1]), cvt_pk_bf16(y[2], y[3])}; Af[m][ks] = *reinterpret_cast<bf16x8*>(&w); }
    f32x4 nvv[4];
#pragma unroll
    for (int n = 0; n < 4; ++n) nvv[n] = *(const f32x4*)(nv + g * 128 + 64 * wd + 16 * fq + 4 * n);
    const float bias0 = bs[g * 128 + 32 * wp + fr], bias1 = bs[g * 128 + 32 * wp + 16 + fr];
    const int qq = fr >> 2, pcol = fr & 3;
    int tra[4];
#pragma unroll
    for (int n = 0; n < 4; ++n) tra[n] = (int)(uintptr_t)C.lds + (8 * fq + qq) * 256 + ((128 * wd + 32 * pcol + 8 * n) ^ ((qq << 3) | ((fq & 1) << 7)));
    const int sq = tid >> 2, sc0 = (tid & 3) * 4, sswz = ((sq & 3) << 3) | (((sq >> 3) & 1) << 7);
    u32x4 vreg[4]; float rsv;
#define SP_LOAD(chunk) do { const int tok_ = (chunk) * 128 + sq; const f32x4* sp_ = (const f32x4*)(SSQV + (size_t)tok_ * 32) + (tid & 3) * 2; const f32x4 a_ = sp_[0], b_ = sp_[1]; \
        float s_ = ((a_[0] + a_[1]) + (a_[2] + a_[3])) + ((b_[0] + b_[1]) + (b_[2] + b_[3])); s_ += __shfl_xor(s_, 1); s_ += __shfl_xor(s_, 2); rsv = __builtin_amdgcn_rsqf(s_ * (1.0f / 2048.0f) + EPS); \
        const u32x4* vp_ = (const u32x4*)(V + (size_t)tok_ * 2048 + g * 128 + sc0 * 8); _Pragma("unroll") for (int j = 0; j < 4; ++j) vreg[j] = vp_[j]; } while (0)
#define SP_WRITE() do { _Pragma("unroll") for (int j = 0; j < 4; ++j) { const u32x4 w_ = vreg[j]; \
        const u32x2 lo_ = {cvt_pk_bf16(bflo(w_.x) * rsv, bfhi(w_.x) * rsv), cvt_pk_bf16(bflo(w_.y) * rsv, bfhi(w_.y) * rsv)}, hi_ = {cvt_pk_bf16(bflo(w_.z) * rsv, bfhi(w_.z) * rsv), cvt_pk_bf16(bflo(w_.w) * rsv, bfhi(w_.w) * rsv)}; \
        const int cb_ = (sc0 + j) * 16; *(LAS u32x2*)(C.lds + sq * 256 + (cb_ ^ sswz)) = lo_; *(LAS u32x2*)(C.lds + sq * 256 + ((cb_ + 8) ^ sswz)) = hi_; } } while (0)
    int chunk = C.bx >> 4; const int cstep = C.G >> 4;
    if (chunk < NTOK / 128) SP_LOAD(chunk);
    for (; chunk < NTOK / 128; chunk += cstep) {
        __syncthreads();
        SP_WRITE();
        __syncthreads();
        if (chunk + cstep < NTOK / 128) SP_LOAD(chunk + cstep);
        f32x4 acc[2][4];
#pragma unroll
        for (int m = 0; m < 2; ++m)
#pragma unroll
            for (int n = 0; n < 4; ++n) acc[m][n] = (f32x4){0.f, 0.f, 0.f, 0.f};
#define SP_KS(KS) do { bf16x8 Bf[4]; _Pragma("unroll") for (int n = 0; n < 4; ++n) { const s16x4 l_ = tr_read_a<(KS) * 8192>(tra[n]), h_ = tr_read_a<(KS) * 8192 + 1024>(tra[n]); \
            Bf[n] = (bf16x8){l_[0], l_[1], l_[2], l_[3], h_[0], h_[1], h_[2], h_[3]}; } \
        asm volatile("s_waitcnt lgkmcnt(0)" ::: "memory"); SBAR(); \
        _Pragma("unroll") for (int m = 0; m < 2; ++m) _Pragma("unroll") for (int n = 0; n < 4; ++n) acc[m][n] = __builtin_amdgcn_mfma_f32_16x16x32_bf16(Bf[n], Af[m][KS], acc[m][n], 0, 0, 0); } while (0)
        SP_KS(0); SP_KS(1); SP_KS(2); SP_KS(3);
#undef SP_KS
#pragma unroll
        for (int m = 0; m < 2; ++m) { const int p = 32 * wp + 16 * m + fr; const float bias = m == 0 ? bias0 : bias1;
            const size_t o = (size_t)(chunk * 128 + p) * 2048 + g * 128 + 64 * wd + 16 * fq;
            const u32x4 u0 = *(const u32x4*)(U + o), u1 = *(const u32x4*)(U + o + 8);
            const f32x4 s0 = (acc[m][0] * nvv[0] + bias) * G8_SCALE, s1 = (acc[m][1] * nvv[1] + bias) * G8_SCALE, s2 = (acc[m][2] * nvv[2] + bias) * G8_SCALE, s3 = (acc[m][3] * nvv[3] + bias) * G8_SCALE;
            const u32x4 o8 = {pk_fp8x4(bflo(u0.x) * s0[0], bfhi(u0.x) * s0[1], bflo(u0.y) * s0[2], bfhi(u0.y) * s0[3]), pk_fp8x4(bflo(u0.z) * s1[0], bfhi(u0.z) * s1[1], bflo(u0.w) * s1[2], bfhi(u0.w) * s1[3]),
                              pk_fp8x4(bflo(u1.x) * s2[0], bfhi(u1.x) * s2[1], bflo(u1.y) * s2[2], bfhi(u1.y) * s2[3]), pk_fp8x4(bflo(u1.z) * s3[0], bfhi(u1.z) * s3[1], bflo(u1.w) * s3[2], bfhi(u1.w) * s3[3])};
            *(u32x4*)(Gt + o) = o8; }
    }
#undef SP_LOAD
#undef SP_WRITE
    __syncthreads();
}

namespace mla {
constexpr int DQK = 192, DV = 128, KVBLK = 64;
constexpr float SCALE = 0.07216878364870322f;
constexpr float THR = 8.f;
constexpr int SHM_V = KVBLK * DV * 2, SHM_K = KVBLK * DQK * 2;
#define KSWZ(row, colB) ((row) * 384 + ((colB) ^ ((((row) >> 1) & 7) << 4)))
__device__ __forceinline__ int crow(int r, int hi) { return (r & 3) + 8 * (r >> 2) + 4 * hi; }
__device__ __forceinline__ void partialSM(f32x16& p0, f32x16& p1, float& m_reg, float& mn, float& alpha) {
    constexpr float Cc = SCALE * 1.4426950408889634f;
    float pmax = p0[0];
#pragma unroll
    for (int r = 1; r < 16; ++r) pmax = fmaxf(pmax, p0[r]);
#pragma unroll
    for (int r = 0; r < 16; ++r) pmax = fmaxf(pmax, p1[r]);
    { auto rr = __builtin_amdgcn_permlane32_swap(__float_as_uint(pmax), __float_as_uint(pmax), false, false); pmax = fmaxf(__uint_as_float(rr[0]), __uint_as_float(rr[1])); }
    if (__builtin_expect(__all(pmax - m_reg <= THR / SCALE), 1)) { mn = m_reg; alpha = 1.f; }
    else { mn = fmaxf(m_reg, pmax); alpha = __builtin_amdgcn_exp2f((m_reg - mn) * Cc); m_reg = mn; }
    const float mnC = -mn * Cc;
#pragma unroll
    for (int r = 0; r < 16; ++r) p0[r] = fmaf(p0[r], Cc, mnC);
#pragma unroll
    for (int r = 0; r < 16; ++r) p1[r] = fmaf(p1[r], Cc, mnC);
#pragma unroll
    for (int r = 0; r < 16; ++r) p0[r] = __builtin_amdgcn_exp2f(p0[r]);
}
__device__ __forceinline__ void finishSM(f32x16& p0, f32x16& p1, float alpha, float& l_reg, bf16x8& pa0, bf16x8& pa1, bf16x8& pa2, bf16x8& pa3) {
#pragma unroll
    for (int r = 0; r < 16; ++r) p1[r] = __builtin_amdgcn_exp2f(p1[r]);
    float ps = 0;
#pragma unroll
    for (int r = 0; r < 16; ++r) ps += p0[r];
#pragma unroll
    for (int r = 0; r < 16; ++r) ps += p1[r];
    { auto rr = __builtin_amdgcn_permlane32_swap(__float_as_uint(ps), __float_as_uint(ps), false, false); ps = __uint_as_float(rr[0]) + __uint_as_float(rr[1]); }
    l_reg = l_reg * alpha + ps;
#define PK4(P, BASE, OUT) do { unsigned a0 = cvt_pk_bf16(P[BASE + 0], P[BASE + 1]), a1 = cvt_pk_bf16(P[BASE + 2], P[BASE + 3]);   \
    unsigned b0 = cvt_pk_bf16(P[BASE + 4], P[BASE + 5]), b1 = cvt_pk_bf16(P[BASE + 6], P[BASE + 7]);                              \
    auto r0 = __builtin_amdgcn_permlane32_swap(a0, b0, false, false); auto r1 = __builtin_amdgcn_permlane32_swap(a1, b1, false, false); \
    u32x4 w = {r0[0], r1[0], r0[1], r1[1]}; OUT = *reinterpret_cast<bf16x8*>(&w); } while (0)
    PK4(p0, 0, pa0); PK4(p0, 8, pa1); PK4(p1, 0, pa2); PK4(p1, 8, pa3);
#undef PK4
}
__device__ __forceinline__ void qkt(f32x16& p0, f32x16& p1, const char* Ks, const bf16x8* qr, int r32, int hi) {
    p0 = f32x16{}; p1 = f32x16{};
#pragma unroll
    for (int d0 = 0; d0 < 12; ++d0) { const int cb = (d0 * 16 + hi * 8) * 2;
        const bf16x8 b0 = *reinterpret_cast<const bf16x8*>(Ks + KSWZ(r32, cb));
        const bf16x8 b1 = *reinterpret_cast<const bf16x8*>(Ks + KSWZ(32 + r32, cb));
        p0 = __builtin_amdgcn_mfma_f32_32x32x16_bf16(b0, qr[d0], p0, 0, 0, 0);
        p1 = __builtin_amdgcn_mfma_f32_32x32x16_bf16(b1, qr[d0], p1, 0, 0, 0); }
}
__device__ __forceinline__ int v_st(int k, int c) { const int kk = (k & ~0xC) | ((k & 4) << 1) | ((k & 8) >> 1); return ((kk >> 3) * 4 + (c >> 5)) * 512 + ((kk & 7) * 32 + (c & 31)) * 2; }
__device__ __forceinline__ int v_rd_base(int lane) { return ((lane & 3) << 3) | (((lane >> 2) & 3) << 6) | (((lane >> 4) & 1) << 5) | (((lane >> 5) & 1) << 8); }
constexpr int v_rd_off(int d0, int ks, int half) { return d0 * 512 + ks * 4096 + half * 2048; }
template <int OFF> __device__ __forceinline__ s16x4 tr_read(int vb) { s16x4 r; asm volatile("ds_read_b64_tr_b16 %0, %1 offset:%2" : "=&v"(r) : "v"(vb), "i"(OFF) : "memory"); return r; }
template <int D0> __device__ __forceinline__ void pv_one(f32x16& od, int vb, bf16x8 pa0, bf16x8 pa1, bf16x8 pa2, bf16x8 pa3) {
    const s16x4 l0 = tr_read<v_rd_off(D0, 0, 0)>(vb), h0 = tr_read<v_rd_off(D0, 0, 1)>(vb), l1 = tr_read<v_rd_off(D0, 1, 0)>(vb), h1 = tr_read<v_rd_off(D0, 1, 1)>(vb);
    const s16x4 l2 = tr_read<v_rd_off(D0, 2, 0)>(vb), h2 = tr_read<v_rd_off(D0, 2, 1)>(vb), l3 = tr_read<v_rd_off(D0, 3, 0)>(vb), h3 = tr_read<v_rd_off(D0, 3, 1)>(vb);
    asm volatile("s_waitcnt lgkmcnt(0)" ::: "memory"); SBAR();
#define PK(L, H) (bf16x8){L[0], L[1], L[2], L[3], H[0], H[1], H[2], H[3]}
    od = __builtin_amdgcn_mfma_f32_32x32x16_bf16(pa0, PK(l0, h0), od, 0, 0, 0);
    od = __builtin_amdgcn_mfma_f32_32x32x16_bf16(pa1, PK(l1, h1), od, 0, 0, 0);
    od = __builtin_amdgcn_mfma_f32_32x32x16_bf16(pa2, PK(l2, h2), od, 0, 0, 0);
    od = __builtin_amdgcn_mfma_f32_32x32x16_bf16(pa3, PK(l3, h3), od, 0, 0, 0);
#undef PK
}
__device__ __forceinline__ void pv_d0(f32x16* o, int vb, bf16x8 pa0, bf16x8 pa1, bf16x8 pa2, bf16x8 pa3) {
    pv_one<0>(o[0], vb, pa0, pa1, pa2, pa3); pv_one<1>(o[1], vb, pa0, pa1, pa2, pa3); pv_one<2>(o[2], vb, pa0, pa1, pa2, pa3); pv_one<3>(o[3], vb, pa0, pa1, pa2, pa3);
}
__device__ __forceinline__ void attn_unit(const int tid, const bf16* Q, const bf16* KV, const bf16* KR, bf16* O, int b, int h, int qb, char* lds) {
    const int wid = tid >> 6, lane = tid & 63, r32 = lane & 31, hi = lane >> 5;
    char* V_lds = lds; char* K_lds = lds + 2 * SHM_V;
    float* ws = (float*)(lds + 2 * SHM_V + 2 * SHM_K) + wid * 64; float* li_l = ws; float* al_l = ws + 32;
    float m_reg = -1e30f, l_reg = 0; f32x16 o[4] = {}; bf16x8 qr[12];
    const size_t tokb = (size_t)b * SEQ;
    { const char* Qw = (const char*)(Q + (tokb + qb * 256 + __builtin_amdgcn_readfirstlane(wid) * 32) * 1536 + h * 192); const unsigned qo = (unsigned)(r32 * 1536 + hi * 8) * 2u;
#pragma unroll
      for (int d0 = 0; d0 < 12; ++d0) qr[d0] = *reinterpret_cast<const bf16x8*>(Qw + qo + d0 * 32); }
    const int sr = tid >> 4, sc = (tid & 15) * 8, vst0 = v_st(sr, sc), vst1 = v_st(32 + sr, sc);
    const int rr = tid >> 3, rc = (tid & 7) * 8;
    const int vb0 = (int)(uintptr_t)V_lds + v_rd_base(lane);
    const char* Kn = (const char*)(KV + tokb * 2048 + h * 256); const char* Kr = (const char*)(KR + tokb * 64);
    const unsigned ko0 = (unsigned)(sr * 2048 + sc) * 2u, ko1 = ko0 + 32u * 2048u * 2u, kro = (unsigned)(rr * 64 + rc) * 2u;
    bf16x8 sv0, sv1, sk0, sk1, skr;
#define SLOAD(k0) do { const char* kb_ = Kn + (size_t)(k0) * 4096; const char* rb_ = Kr + (size_t)(k0) * 128; \
    sv0 = *reinterpret_cast<const bf16x8*>(kb_ + 256 + ko0); sv1 = *reinterpret_cast<const bf16x8*>(kb_ + 256 + ko1); \
    sk0 = *reinterpret_cast<const bf16x8*>(kb_ + ko0); sk1 = *reinterpret_cast<const bf16x8*>(kb_ + ko1); \
    skr = *reinterpret_cast<const bf16x8*>(rb_ + kro); } while (0)
#define SWRITE(bb) do { *(bf16x8*)(V_lds + (bb) * SHM_V + vst0) = sv0; *(bf16x8*)(V_lds + (bb) * SHM_V + vst1) = sv1; const int kc = sc * 2; \
    *(bf16x8*)(K_lds + (bb) * SHM_K + KSWZ(sr, kc)) = sk0; *(bf16x8*)(K_lds + (bb) * SHM_K + KSWZ(32 + sr, kc)) = sk1; \
    *(bf16x8*)(K_lds + (bb) * SHM_K + KSWZ(rr, 256 + rc * 2)) = skr; } while (0)
#define RESC(a) do { if (__any((a) < 1.f)) { if (hi == 0) al_l[r32] = (a); asm volatile("s_waitcnt lgkmcnt(0)" ::: "memory"); \
    _Pragma("unroll") for (int d = 0; d < 4; ++d) _Pragma("unroll") for (int r = 0; r < 16; ++r) o[d][r] *= al_l[crow(r, hi)]; } } while (0)
    f32x16 p0, p1; float mn, al; bf16x8 pa0, pa1, pa2, pa3; constexpr int NT = SEQ / KVBLK;
    SLOAD(0); asm volatile("s_waitcnt vmcnt(0)" ::: "memory"); SWRITE(0); __syncthreads();
#pragma unroll 1
    for (int j = 0; j < NT; j += 2) {
        SLOAD((j + 1) * KVBLK); SBAR();
        qkt(p0, p1, K_lds, qr, r32, hi); partialSM(p0, p1, m_reg, mn, al); RESC(al);
        finishSM(p0, p1, al, l_reg, pa0, pa1, pa2, pa3); SBAR();
        pv_d0(o, vb0, pa0, pa1, pa2, pa3);
        asm volatile("s_waitcnt vmcnt(0)" ::: "memory"); SWRITE(1); __syncthreads();
        if (j + 2 < NT) SLOAD((j + 2) * KVBLK); SBAR();
        qkt(p0, p1, K_lds + SHM_K, qr, r32, hi); partialSM(p0, p1, m_reg, mn, al); RESC(al);
        finishSM(p0, p1, al, l_reg, pa0, pa1, pa2, pa3); SBAR();
        pv_d0(o, vb0 + SHM_V, pa0, pa1, pa2, pa3);
        if (j + 2 < NT) { asm volatile("s_waitcnt vmcnt(0)" ::: "memory"); SWRITE(0); } __syncthreads();
    }
    if (hi == 0) li_l[r32] = l_reg; asm volatile("s_waitcnt lgkmcnt(0)" ::: "memory");
    char* Ow = (char*)(O + (tokb + qb * 256 + __builtin_amdgcn_readfirstlane(wid) * 32) * 1024 + h * 128);
    const unsigned oo = (unsigned)(4 * hi * 1024 + r32) * 2u;
#pragma unroll
    for (int r = 0; r < 16; ++r) { const float rl = __builtin_amdgcn_rcpf(li_l[crow(r, hi)]);
#pragma unroll
        for (int d0 = 0; d0 < 4; ++d0) { const unsigned w = cvt_pk_bf16(o[d0][r] * rl, 0.f); *(bf16*)(Ow + oo + (unsigned)((((r & 3) + 8 * (r >> 2)) * 1024 + d0 * 32) * 2)) = (bf16)(w & 0xffffu); } }
    __syncthreads();
#undef SLOAD
#undef SWRITE
#undef RESC
}
constexpr int SLOT = SHM_K + SHM_V;
__device__ __forceinline__ void qkt_l(f32x16& p0, f32x16& p1, const LAS char* Ks, const bf16x8* qr, int r32, int hi) {
    p0 = f32x16{}; p1 = f32x16{};
#pragma unroll
    for (int d0 = 0; d0 < 12; ++d0) { const int cb = (d0 * 16 + hi * 8) * 2;
        const bf16x8 b0 = *reinterpret_cast<const LAS bf16x8*>(Ks + KSWZ(r32, cb));
        const bf16x8 b1 = *reinterpret_cast<const LAS bf16x8*>(Ks + KSWZ(32 + r32, cb));
        p0 = __builtin_amdgcn_mfma_f32_32x32x16_bf16(b0, qr[d0], p0, 0, 0, 0);
        p1 = __builtin_amdgcn_mfma_f32_32x32x16_bf16(b1, qr[d0], p1, 0, 0, 0); }
}
#define WAITBAR(N) asm volatile("s_waitcnt vmcnt(" #N ") lgkmcnt(0)\n\ts_barrier" ::: "memory")
__device__ __forceinline__ void attn_unit_g(const int tid, const bf16* Q, const bf16* KV, const bf16* KR, bf16* O, int b, int h, int qb, LAS char* lds) {
    const int wid = __builtin_amdgcn_readfirstlane(tid >> 6), lane = tid & 63, r32 = lane & 31, hi = lane >> 5;
    LAS float* wsc = (LAS float*)(lds + 3 * SLOT) + wid * 64; LAS float* li_l = wsc; LAS float* al_l = wsc + 32;
    float m_reg = -1e30f, l_reg = 0; f32x16 o[4] = {}; bf16x8 qr[12];
    const size_t tokb = (size_t)b * SEQ;
    { const char* Qw = (const char*)(Q + (tokb + qb * 256 + wid * 32) * 1536 + h * 192); const unsigned qo = (unsigned)(r32 * 1536 + hi * 8) * 2u;
#pragma unroll
      for (int d0 = 0; d0 < 12; ++d0) qr[d0] = *reinterpret_cast<const bf16x8*>(Qw + qo + d0 * 32); }
    const char* Kn = (const char*)(KV + tokb * 2048 + h * 256); const char* Kr = (const char*)(KR + tokb * 64);
    unsigned koff[3], voff[2]; bool krope[3];
#pragma unroll
    for (int t = 0; t < 3; ++t) { const int p = (wid * 3 + t) * 64 + lane, row = p / 24, cp = p % 24, c = (cp & ~7) | ((cp ^ (row >> 1)) & 7);
        krope[t] = c >= 16; koff[t] = krope[t] ? (unsigned)(row * 128 + (c - 16) * 16) : (unsigned)(row * 4096 + c * 16); }
#pragma unroll
    for (int t = 0; t < 2; ++t) { const int p = (wid * 2 + t) * 64 + lane, sub = p >> 5, w = p & 31, kk = (sub >> 2) * 8 + (w >> 2), c = (sub & 3) * 32 + (w & 3) * 8;
        const int k = (kk & ~0xC) | ((kk & 4) << 1) | ((kk & 8) >> 1); voff[t] = (unsigned)(k * 4096 + 256 + c * 2); }
#define GLDS(k0, slot) do { const char* kb_ = Kn + (size_t)(k0) * 4096; const char* rb_ = Kr + (size_t)(k0) * 128; LAS char* kd_ = lds + (slot) * SLOT + wid * 3072; LAS char* vd_ = lds + (slot) * SLOT + SHM_K + wid * 2048; \
    _Pragma("unroll") for (int t_ = 0; t_ < 3; ++t_) { const char* src_ = (krope[t_] ? rb_ : kb_) + koff[t_]; __builtin_amdgcn_global_load_lds((const unsigned*)src_, (LAS unsigned*)(kd_ + t_ * 1024), 16, 0, 0); } \
    _Pragma("unroll") for (int t_ = 0; t_ < 2; ++t_) __builtin_amdgcn_global_load_lds((const unsigned*)(kb_ + voff[t_]), (LAS unsigned*)(vd_ + t_ * 1024), 16, 0, 0); } while (0)
#define RESC(a) do { if (__any((a) < 1.f)) { if (hi == 0) al_l[r32] = (a); asm volatile("s_waitcnt lgkmcnt(0)" ::: "memory"); \
    _Pragma("unroll") for (int d = 0; d < 4; ++d) _Pragma("unroll") for (int r = 0; r < 16; ++r) o[d][r] *= al_l[crow(r, hi)]; } } while (0)
    f32x16 pA0, pA1, pB0, pB1; float mnA, mnB, alA, alB; bf16x8 pa0, pa1, pa2, pa3; constexpr int NT = SEQ / KVBLK;
    const int vrb = (int)(uintptr_t)lds + SHM_K + v_rd_base(lane);
    int s0 = 0, s1 = 1, s2 = 2;
    GLDS(0, 0); GLDS(KVBLK, 1);
    WAITBAR(5);
    qkt_l(pA0, pA1, lds, qr, r32, hi); partialSM(pA0, pA1, m_reg, mnA, alA);
    WAITBAR(2);
#pragma unroll 1
    for (int j = 0; j < NT; j += 2) {
        const bool more1 = j + 2 < NT;
        if (more1) GLDS((j + 2) * KVBLK, s2);
        SBAR(); qkt_l(pB0, pB1, lds + s1 * SLOT, qr, r32, hi);
        finishSM(pA0, pA1, alA, l_reg, pa0, pa1, pa2, pa3); SBAR();
        pv_d0(o, vrb + s0 * SLOT, pa0, pa1, pa2, pa3); partialSM(pB0, pB1, m_reg, mnB, alB);
        if (more1) WAITBAR(2); else WAITBAR(0);
        RESC(alB);
        { const int t_ = s0; s0 = s1; s1 = s2; s2 = t_; }
        const bool more2 = j + 3 < NT;
        if (more2) GLDS((j + 3) * KVBLK, s2);
        SBAR(); if (more1) qkt_l(pA0, pA1, lds + s1 * SLOT, qr, r32, hi);
        finishSM(pB0, pB1, alB, l_reg, pa0, pa1, pa2, pa3); SBAR();
        pv_d0(o, vrb + s0 * SLOT, pa0, pa1, pa2, pa3); if (more1) partialSM(pA0, pA1, m_reg, mnA, alA);
        if (more2) WAITBAR(2); else WAITBAR(0);
        if (more1) RESC(alA);
        { const int t_ = s0; s0 = s1; s1 = s2; s2 = t_; }
    }
    if (hi == 0) li_l[r32] = l_reg; asm volatile("s_waitcnt lgkmcnt(0)" ::: "memory");
    char* Ow = (char*)(O + (tokb + qb * 256 + wid * 32) * 1024 + h * 128);
    const unsigned oo = (unsigned)(4 * hi * 1024 + r32) * 2u;
#pragma unroll
    for (int r = 0; r < 16; ++r) { const float rl = __builtin_amdgcn_rcpf(li_l[crow(r, hi)]);
#pragma unroll
        for (int d0 = 0; d0 < 4; ++d0) { const unsigned w = cvt_pk_bf16(o[d0][r] * rl, 0.f); *(bf16*)(Ow + oo + (unsigned)((((r & 3) + 8 * (r >> 2)) * 1024 + d0 * 32) * 2)) = (bf16)(w & 0xffffu); } }
    WAITBAR(0);
#undef GLDS
#undef RESC
}
constexpr int F8_SK = 64 * 192, F8_SV = 128 * 64, F8_SLOT = F8_SK + F8_SV;
typedef int v8i32 __attribute__((ext_vector_type(8)));
__device__ __forceinline__ v8i32 ld32(const LAS char* p0, const LAS char* p1) { const u32x4 a = *(const LAS u32x4*)p0, b = *(const LAS u32x4*)p1; return (v8i32){(int)a.x, (int)a.y, (int)a.z, (int)a.w, (int)b.x, (int)b.y, (int)b.z, (int)b.w}; }
__device__ __forceinline__ void attn_unit_f8(const int tid, const unsigned char* Q8, const unsigned char* KN8, const unsigned char* KR8, const unsigned char* VT8, unsigned char* O, int b, int h, int qb, LAS char* lds) {
    const int wid = __builtin_amdgcn_readfirstlane(tid >> 6), lane = tid & 63, r32 = lane & 31, hi = lane >> 5;
    LAS float* wsc = (LAS float*)(lds + 6 * F8_SLOT) + wid * 64; LAS float* al_l = wsc + 32;
    constexpr float TAU = 1.0f;
    f32x16 o[4] = {}, osum = {}, minit = {}; v8i32 qr[3];
    LAS char* const onep = lds + 6 * F8_SLOT + 2048;
    if (tid < 4) ((LAS unsigned*)onep)[tid] = 0x38383838u;
    const size_t tokb = (size_t)b * SEQ;
    { const unsigned char* Qw = Q8 + (tokb + qb * 256 + wid * 32) * 1536 + h * 192; const unsigned qo = (unsigned)(r32 * 1536 + hi * 32);
#pragma unroll
      for (int st = 0; st < 3; ++st) { const u32x4 x = *(const u32x4*)(Qw + qo + st * 64), y = *(const u32x4*)(Qw + qo + st * 64 + 16); qr[st] = (v8i32){(int)x.x, (int)x.y, (int)x.z, (int)x.w, (int)y.x, (int)y.y, (int)y.z, (int)y.w}; } }
    const unsigned char* Knb = KN8 + tokb * 1024 + h * 128; const unsigned char* Krb = KR8 + tokb * 64; const unsigned char* Vtb = VT8 + (size_t)(b * 8 + h) * 128 * SEQ;
    unsigned koff[3], voff; bool krope[3]; int kdst[3];
#pragma unroll
    for (int t = 0; t < 3; ++t) { const int q = wid + 8 * t, tl = q / 12, pc = q % 12, p = pc * 64 + lane, row = p / 12, cp = p % 12, c = (cp & ~3) | ((cp ^ (row >> 2)) & 3);
        krope[t] = c >= 8; koff[t] = krope[t] ? (unsigned)((tl * 64 + row) * 64 + (c - 8) * 16) : (unsigned)((tl * 64 + row) * 1024 + c * 16); kdst[t] = tl * F8_SLOT + pc * 1024; }
    { const int p = wid * 64 + lane, d = p >> 2, cp = p & 3, c = cp ^ ((d >> 2) & 3); voff = (unsigned)(d * SEQ + c * 16); }
#define GLDS8(k0, slot) do { const unsigned char* kb_ = Knb + (size_t)(k0) * 1024; const unsigned char* rb_ = Krb + (size_t)(k0) * 64; LAS char* kd_ = lds + (slot) * (2 * F8_SLOT); \
    _Pragma("unroll") for (int t_ = 0; t_ < 3; ++t_) { const unsigned char* s_ = (krope[t_] ? rb_ : kb_) + koff[t_]; __builtin_amdgcn_global_load_lds((const unsigned*)s_, (LAS unsigned*)(kd_ + kdst[t_]), 16, 0, 0); } \
    _Pragma("unroll") for (int t_ = 0; t_ < 2; ++t_) __builtin_amdgcn_global_load_lds((const unsigned*)(Vtb + (k0) + t_ * 64 + voff), (LAS unsigned*)(kd_ + t_ * F8_SLOT + F8_SK + wid * 1024), 16, 0, 0); } while (0)
    const int krow = 16 * ((r32 >> 2) & 1) + 4 * (r32 >> 3) + (r32 & 3), kx = (krow >> 2) & 3;
    const int ka0 = krow * 192 + 16 * ((2 * hi) ^ kx), ka1 = krow * 192 + 16 * ((2 * hi + 1) ^ kx);
    const int vx = (r32 >> 2) & 3, va0 = F8_SK + r32 * 64 + 16 * (hi ^ vx), va1 = F8_SK + r32 * 64 + 16 * ((2 + hi) ^ vx);
#define QKT8(P0, P1, Ks) do { _Pragma("unroll") for (int st = 0; st < 3; ++st) { \
        const v8i32 k0_ = ld32((Ks) + ka0 + st * 64, (Ks) + ka1 + st * 64), k1_ = ld32((Ks) + ka0 + st * 64 + 32 * 192, (Ks) + ka1 + st * 64 + 32 * 192); \
        P0 = __builtin_amdgcn_mfma_scale_f32_32x32x64_f8f6f4(k0_, qr[st], st == 0 ? minit : P0, 0, 0, 0, 0, 0, 0); P1 = __builtin_amdgcn_mfma_scale_f32_32x32x64_f8f6f4(k1_, qr[st], st == 0 ? minit : P1, 0, 0, 0, 0, 0, 0); } } while (0)
#define PV8_LOAD(Vs) do { vfr[0] = ld32((Vs) + va0, (Vs) + va1); } while (0)
#define PV8_MMA(Vs) do { const v8i32 v1_ = ld32((Vs) + va0 + 1 * 2048, (Vs) + va1 + 1 * 2048), v2_ = ld32((Vs) + va0 + 2 * 2048, (Vs) + va1 + 2 * 2048), v3_ = ld32((Vs) + va0 + 3 * 2048, (Vs) + va1 + 3 * 2048); \
        o[0] = __builtin_amdgcn_mfma_scale_f32_32x32x64_f8f6f4(pa, vfr[0], o[0], 0, 0, 0, 0, 0, 0); o[1] = __builtin_amdgcn_mfma_scale_f32_32x32x64_f8f6f4(pa, v1_, o[1], 0, 0, 0, 0, 0, 0); \
        o[2] = __builtin_amdgcn_mfma_scale_f32_32x32x64_f8f6f4(pa, v2_, o[2], 0, 0, 0, 0, 0, 0); o[3] = __builtin_amdgcn_mfma_scale_f32_32x32x64_f8f6f4(pa, v3_, o[3], 0, 0, 0, 0, 0, 0); \
        osum = __builtin_amdgcn_mfma_scale_f32_32x32x64_f8f6f4(pa, ld32(onep, onep), osum, 0, 0, 0, 0, 0, 0); } while (0)
#define PSM8(P0, P1, PM) do { float pm_ = P0[0]; _Pragma("unroll") for (int r = 1; r < 16; ++r) pm_ = fmaxf(pm_, P0[r]); _Pragma("unroll") for (int r = 0; r < 16; ++r) pm_ = fmaxf(pm_, P1[r]); \
        { auto rr_ = __builtin_amdgcn_permlane32_swap(__float_as_uint(pm_), __float_as_uint(pm_), false, false); PM = fmaxf(__uint_as_float(rr_[0]), __uint_as_float(rr_[1])); } \
        _Pragma("unroll") for (int r = 0; r < 16; ++r) P0[r] = __builtin_amdgcn_exp2f(P0[r]); } while (0)
#define PSM8_FIRST(P0, P1) do { float pm_ = P0[0]; _Pragma("unroll") for (int r = 1; r < 16; ++r) pm_ = fmaxf(pm_, P0[r]); _Pragma("unroll") for (int r = 0; r < 16; ++r) pm_ = fmaxf(pm_, P1[r]); \
        { auto rr_ = __builtin_amdgcn_permlane32_swap(__float_as_uint(pm_), __float_as_uint(pm_), false, false); pm_ = fmaxf(__uint_as_float(rr_[0]), __uint_as_float(rr_[1])); } \
        const float dl_ = pm_ - 7.0f; _Pragma("unroll") for (int r = 0; r < 16; ++r) { P0[r] = __builtin_amdgcn_exp2f(P0[r] - dl_); P1[r] -= dl_; minit[r] = -dl_; } } while (0)
#define FSM8(P0, P1) do { _Pragma("unroll") for (int r = 0; r < 16; ++r) P1[r] = __builtin_amdgcn_exp2f(P1[r]); \
        pa = (v8i32){(int)pk_fp8x4(P0[0], P0[1], P0[2], P0[3]), (int)pk_fp8x4(P0[4], P0[5], P0[6], P0[7]), (int)pk_fp8x4(P0[8], P0[9], P0[10], P0[11]), (int)pk_fp8x4(P0[12], P0[13], P0[14], P0[15]), \
                     (int)pk_fp8x4(P1[0], P1[1], P1[2], P1[3]), (int)pk_fp8x4(P1[4], P1[5], P1[6], P1[7]), (int)pk_fp8x4(P1[8], P1[9], P1[10], P1[11]), (int)pk_fp8x4(P1[12], P1[13], P1[14], P1[15])}; } while (0)
#define RESC(P0, P1, PM) do { if (__any((PM) > 7.0f + TAU)) { const float dl_ = (PM) > 7.0f + TAU ? (PM) - 7.0f : 0.f, a_ = __builtin_amdgcn_exp2f(-dl_); \
    if (hi == 0) al_l[r32] = a_; \
    _Pragma("unroll") for (int r = 0; r < 16; ++r) { P0[r] *= a_; P1[r] -= dl_; minit[r] -= dl_; } \
    asm volatile("s_waitcnt lgkmcnt(0)" ::: "memory"); \
    _Pragma("unroll") for (int r = 0; r < 16; ++r) { const float f_ = al_l[crow(r, hi)]; osum[r] *= f_; _Pragma("unroll") for (int d = 0; d < 4; ++d) o[d][r] *= f_; } } } while (0)
#define SGB_QK() do { _Pragma("unroll") for (int i_ = 0; i_ < 6; ++i_) { __builtin_amdgcn_sched_group_barrier(0x100, 2, 0); __builtin_amdgcn_sched_group_barrier(0x008, 1, 0); __builtin_amdgcn_sched_group_barrier(0x402, 12, 0); } } while (0)
#define SGB_PV() do { _Pragma("unroll") for (int i_ = 0; i_ < 4; ++i_) { __builtin_amdgcn_sched_group_barrier(0x100, 2, 0); __builtin_amdgcn_sched_group_barrier(0x008, 1, 0); __builtin_amdgcn_sched_group_barrier(0x402, 26, 0); } } while (0)
    f32x16 pA0, pA1, pB0, pB1; float pmA, pmB; v8i32 pa, vfr[1]; constexpr int NT = SEQ / KVBLK;
    int s0 = 0, s1 = 1, s2 = 2;
    GLDS8(0, 0); GLDS8(2 * KVBLK, 1);
    WAITBAR(5);
    QKT8(pA0, pA1, lds); PSM8_FIRST(pA0, pA1);
    WAITBAR(2);
#pragma unroll 1
    for (int j = 0; j < NT; j += 2) {
        const bool more = j + 4 < NT;
        if (more) GLDS8((j + 4) * KVBLK, s2);
        LAS char* const t0 = lds + s0 * (2 * F8_SLOT); LAS char* const t1 = t0 + F8_SLOT; LAS char* const t2 = lds + s1 * (2 * F8_SLOT);
        SBAR(); PV8_LOAD(t0); QKT8(pB0, pB1, t1);
        FSM8(pA0, pA1); SBAR();
        PV8_MMA(t0); PSM8(pB0, pB1, pmB); SBAR();
        RESC(pB0, pB1, pmB);
        SBAR(); PV8_LOAD(t1); QKT8(pA0, pA1, t2);
        FSM8(pB0, pB1); SBAR();
        PV8_MMA(t1); PSM8(pA0, pA1, pmA); SBAR();
        if (more) WAITBAR(2); else WAITBAR(0);
        if (j + 2 < NT) RESC(pA0, pA1, pmA);
        { const int t_ = s0; s0 = s1; s1 = s2; s2 = t_; }
    }
    unsigned char* Ow = O + (tokb + qb * 256 + wid * 32) * 1024 + h * 128;
    const unsigned oo = (unsigned)(4 * hi * 1024 + r32);
#pragma unroll
    for (int r = 0; r < 16; ++r) { const float rl = __builtin_amdgcn_rcpf(osum[r] * ATT8_SCALE) * O8_SCALE;
        const unsigned w = pk_fp8x4(o[0][r] * rl, o[1][r] * rl, o[2][r] * rl, o[3][r] * rl);
#pragma unroll
        for (int d0 = 0; d0 < 4; ++d0) Ow[oo + (unsigned)(((r & 3) + 8 * (r >> 2)) * 1024 + d0 * 32)] = (unsigned char)(w >> (8 * d0)); }
    WAITBAR(0);
#undef GLDS8
#undef QKT8
#undef PV8_LOAD
#undef PV8_MMA
#undef PSM8
#undef PSM8_FIRST
#undef FSM8
#undef RESC
}
}

namespace watt {
constexpr float C2 = 1.4426950408889634f;
constexpr int WLDS = 16384 + 256;
__device__ __forceinline__ void unit(const bf16* QKV, bf16* OG, float* LSE, int g, int b, int r, int h, int qb, LAS char* wl, int lane) {
    const int r32 = lane & 31, hi = lane >> 5, sh = 2 * g, L = SEQ >> sh, l0 = qb * 64;
    LAS float* scr = (LAS float*)(wl + 16384);
    const size_t tokb = (size_t)b * SEQ + r;
    const char* base = (const char*)QKV + (size_t)(((g * 3) * 8 + h) * 64) * 2;
    bf16x8 qf[2][4];
#pragma unroll
    for (int qs = 0; qs < 2; ++qs) { const char* p = base + (tokb + ((size_t)(l0 + 32 * qs + r32) << sh)) * 9216 + hi * 16;
#pragma unroll
        for (int d0 = 0; d0 < 4; ++d0) qf[qs][d0] = *reinterpret_cast<const bf16x8*>(p + d0 * 32); }
    f32x16 o[2][2] = {}; float m[2] = {-1e30f, -1e30f}, l[2] = {0.f, 0.f};
    const int vb = (int)(uintptr_t)wl + mla::v_rd_base(lane);
#pragma unroll
    for (int tt = 0; tt < 3; ++tt) {
        const int t = tt == 0 ? 1 : (tt == 1 ? 0 : 2);
        const int lk0 = l0 - 64 + 64 * t;
        bf16x8 kf[2][4];
#pragma unroll
        for (int half = 0; half < 2; ++half) { int lk = lk0 + 32 * half + r32; lk = lk < 0 ? 0 : (lk >= L ? L - 1 : lk);
            const char* p = base + 1024 + (tokb + ((size_t)lk << sh)) * 9216 + hi * 16;
#pragma unroll
            for (int d0 = 0; d0 < 4; ++d0) kf[half][d0] = *reinterpret_cast<const bf16x8*>(p + d0 * 32); }
        bf16x8 vs[8];
#pragma unroll
        for (int i = 0; i < 8; ++i) { int lk = lk0 + i * 8 + (lane >> 3); lk = lk < 0 ? 0 : (lk >= L ? L - 1 : lk);
            vs[i] = *reinterpret_cast<const bf16x8*>(base + 2048 + (tokb + ((size_t)lk << sh)) * 9216 + (lane & 7) * 16); }
#pragma unroll
        for (int i = 0; i < 8; ++i) *(LAS bf16x8*)(wl + mla::v_st(i * 8 + (lane >> 3), (lane & 7) * 8)) = vs[i];
#pragma unroll
        for (int qs = 0; qs < 2; ++qs) {
            f32x16 p0 = {}, p1 = {};
#pragma unroll
            for (int d0 = 0; d0 < 4; ++d0) { p0 = __builtin_amdgcn_mfma_f32_32x32x16_bf16(kf[0][d0], qf[qs][d0], p0, 0, 0, 0); p1 = __builtin_amdgcn_mfma_f32_32x32x16_bf16(kf[1][d0], qf[qs][d0], p1, 0, 0, 0); }
            const int lq = l0 + 32 * qs + r32; float pmax = -INFINITY;
#pragma unroll
            for (int rr = 0; rr < 16; ++rr) { const int k0 = lk0 + mla::crow(rr, hi), k1 = k0 + 32;
                const bool v0 = (k0 >= 0) && (k0 < L) && (k0 - lq <= 64) && (lq - k0 <= 64), v1 = (k1 >= 0) && (k1 < L) && (k1 - lq <= 64) && (lq - k1 <= 64);
                p0[rr] = v0 ? p0[rr] : -INFINITY; p1[rr] = v1 ? p1[rr] : -INFINITY; pmax = fmaxf(pmax, fmaxf(p0[rr], p1[rr])); }
            { auto sw = __builtin_amdgcn_permlane32_swap(__float_as_uint(pmax), __float_as_uint(pmax), false, false); pmax = fmaxf(__uint_as_float(sw[0]), __uint_as_float(sw[1])); }
            const float mn = fmaxf(m[qs], pmax), alpha = __builtin_amdgcn_exp2f((m[qs] - mn) * C2), mnC = -mn * C2; m[qs] = mn;
            float ps = 0.f;
#pragma unroll
            for (int rr = 0; rr < 16; ++rr) { p0[rr] = __builtin_amdgcn_exp2f(fmaf(p0[rr], C2, mnC)); p1[rr] = __builtin_amdgcn_exp2f(fmaf(p1[rr], C2, mnC)); ps += p0[rr] + p1[rr]; }
            { auto sw = __builtin_amdgcn_permlane32_swap(__float_as_uint(ps), __float_as_uint(ps), false, false); ps = __uint_as_float(sw[0]) + __uint_as_float(sw[1]); }
            l[qs] = l[qs] * alpha + ps;
            bf16x8 pa0, pa1, pa2, pa3;
#define PK4(P, BASE, OUT) do { unsigned a0 = cvt_pk_bf16(P[BASE + 0], P[BASE + 1]), a1 = cvt_pk_bf16(P[BASE + 2], P[BASE + 3]);   \
    unsigned b0 = cvt_pk_bf16(P[BASE + 4], P[BASE + 5]), b1 = cvt_pk_bf16(P[BASE + 6], P[BASE + 7]);                              \
    auto r0 = __builtin_amdgcn_permlane32_swap(a0, b0, false, false); auto r1 = __builtin_amdgcn_permlane32_swap(a1, b1, false, false); \
    u32x4 w = {r0[0], r1[0], r0[1], r1[1]}; OUT = *reinterpret_cast<bf16x8*>(&w); } while (0)
            PK4(p0, 0, pa0); PK4(p0, 8, pa1); PK4(p1, 0, pa2); PK4(p1, 8, pa3);
#undef PK4
            if (tt > 0) { if (__any(alpha < 1.f)) { if (hi == 0) scr[r32] = alpha; asm volatile("s_waitcnt lgkmcnt(0)" ::: "memory");
#pragma unroll
                for (int d = 0; d < 2; ++d)
#pragma unroll
                    for (int rr = 0; rr < 16; ++rr) o[qs][d][rr] *= scr[mla::crow(rr, hi)]; } }
            mla::pv_one<0>(o[qs][0], vb, pa0, pa1, pa2, pa3); mla::pv_one<1>(o[qs][1], vb, pa0, pa1, pa2, pa3);
        }
    }
#pragma unroll
    for (int qs = 0; qs < 2; ++qs) {
        if (hi == 0) { scr[r32] = l[qs]; LSE[((size_t)g * NTOK + tokb + ((size_t)(l0 + 32 * qs + r32) << sh)) * 8 + h] = m[qs] + __logf(l[qs]); }
        asm volatile("s_waitcnt lgkmcnt(0)" ::: "memory");
#pragma unroll
        for (int rr = 0; rr < 16; ++rr) { const int qi = mla::crow(rr, hi); const float rl = __builtin_amdgcn_rcpf(scr[qi]);
            bf16* op = OG + ((size_t)g * NTOK + tokb + ((size_t)(l0 + 32 * qs + qi) << sh)) * 512 + h * 64 + r32;
#pragma unroll
            for (int d = 0; d < 2; ++d) { const unsigned w = cvt_pk_bf16(o[qs][d][rr] * rl, 0.f); op[d * 32] = (bf16)(w & 0xffffu); } }
        asm volatile("s_waitcnt lgkmcnt(0)" ::: "memory");
    }
}
}
__device__ __forceinline__ void watt_phase(const Ctx& C) {
    const bf16* QKV = (const bf16*)(C.ws + AR_QKV); bf16* OG = (bf16*)(C.ws + AR_OG); float* LSE = (float*)(C.ws + AR_LSE);
    LAS char* wl = (LAS char*)C.lds + C.wave * watt::WLDS;
    for (int u = C.bx * NWAVES + C.wave; u < 12288; u += C.G * NWAVES) {
        const int g = u >> 12, v = u & 4095, sh = 2 * g, nqb = 128 >> sh, qb = v & (nqb - 1), w2 = v >> (7 - sh), h = w2 & 7, w3 = w2 >> 3, r = w3 & ((1 << sh) - 1), b = w3 >> sh;
        watt::unit(QKV, OG, LSE, g, b, r, h, qb, wl, C.lane);
    }
}
__device__ __forceinline__ void watt_combine(const Ctx& C) {
    const bf16* OG = (const bf16*)(C.ws + AR_OG); const float* LSE = (const float*)(C.ws + AR_LSE); unsigned char* O = C.ws + AR_OD;
    for (int it0 = C.bx * NTHR + C.tid; it0 < NTOK * 64; it0 += 4 * C.G * NTHR) {
      float lq[4][3]; u32x4 oq[4][3];
#pragma unroll
      for (int q = 0; q < 4; ++q) { const int it = it0 + q * C.G * NTHR, tok = it >> 6, c = it & 63, h = c >> 3;
#pragma unroll
          for (int g = 0; g < 3; ++g) { lq[q][g] = LSE[((size_t)g * NTOK + tok) * 8 + h]; oq[q][g] = *(const u32x4*)(OG + ((size_t)g * NTOK + tok) * 512 + c * 8); } }
#pragma unroll
      for (int q = 0; q < 4; ++q) {
        const int it = it0 + q * C.G * NTHR, tok = it >> 6, c = it & 63;
        const float l0 = lq[q][0], l1 = lq[q][1], l2 = lq[q][2];
        const float mx = fmaxf(l0, fmaxf(l1, l2)); float w0 = __expf(l0 - mx), w1 = __expf(l1 - mx), w2 = __expf(l2 - mx); const float inv = 1.0f / (w0 + w1 + w2); w0 *= inv; w1 *= inv; w2 *= inv;
        const u32x4 a = oq[q][0], bq = oq[q][1], cq = oq[q][2];
        w0 *= OD8_SCALE; w1 *= OD8_SCALE; w2 *= OD8_SCALE;
        float e[8];
#pragma unroll
        for (int j = 0; j < 4; ++j) { e[2 * j] = w0 * bflo(a[j]) + w1 * bflo(bq[j]) + w2 * bflo(cq[j]); e[2 * j + 1] = w0 * bfhi(a[j]) + w1 * bfhi(bq[j]) + w2 * bfhi(cq[j]); }
        *(u32x2*)(O + (size_t)tok * 512 + c * 8) = (u32x2){pk_fp8x4(e[0], e[1], e[2], e[3]), pk_fp8x4(e[4], e[5], e[6], e[7])};
      }
    }
}

constexpr int N_PHASES = 64;
constexpr int PP_SPLIT = 100;
__global__ void __launch_bounds__(NTHR, 2) fwd_kernel(Args args) {
    extern __shared__ __attribute__((aligned(16))) unsigned char lds_raw[];
    volatile LAS unsigned* MISC = (volatile LAS unsigned*)((LAS unsigned char*)lds_raw + LDS_MISC);
    if (threadIdx.x < 64) MISC[threadIdx.x] = 0u;
    if (threadIdx.x == 0) {
#pragma unroll
        for (int i = 0; i < 30; ++i) *(LAS unsigned long long*)((LAS unsigned char*)lds_raw + LDS_PTRS + 8 * i) = (unsigned long long)args.in[i];
    }
    __syncthreads();
    XcdBarrier bar = xcd_barrier_post((unsigned*)(args.ws + WS_CTL) + CW_BAR, MISC + 8);
    const int lo = args.ph_lo, hi = args.ph_hi; int ph = 0;
    const int wave_s = __builtin_amdgcn_readfirstlane(threadIdx.x >> 6);
#define FRESH_CTX Ctx C; { unsigned on_ = ~0u; asm volatile("" : "+s"(on_)); int t_ = wave_s * 64 + (int)__builtin_amdgcn_mbcnt_hi(on_, __builtin_amdgcn_mbcnt_lo(on_, 0u)), bx_ = blockIdx.x, g_ = gridDim.x; unsigned char* ws_ = args.ws; float* out_ = args.out; \
        asm volatile("" : "+v"(t_)); asm volatile("" : "+s"(bx_), "+s"(g_), "+s"(ws_), "+s"(out_)); \
        C.lds = (LAS unsigned char*)lds_raw; C.ws = (unsigned char*)(GAS unsigned char*)(unsigned long long)ws_; C.in.lds = C.lds; C.out = (float*)(GAS float*)(unsigned long long)out_;       C.tid = t_; C.lane = t_ & 63; C.wave = __builtin_amdgcn_readfirstlane(t_ >> 6); C.G = g_; C.bx = bx_; } \
        unsigned char* ws = C.ws; LAS unsigned char* lds = C.lds; const float* SSQ = (const float*)(ws + WS_SSQ); bf16* H = (bf16*)(ws + WS_HB); const bf16* HB = (const bf16*)(ws + WS_HB); \
        const float* ct = (const float*)(ws + WS_COS); const float* st = (const float*)(ws + WS_SIN); (void)SSQ; (void)H; (void)HB; (void)ct; (void)st; (void)lds;
#ifndef PROBE_MASK
#define PROBE_MASK 0ull
#endif
#ifndef PROBE_DRY
#define PROBE_DRY 0ull
#endif
#define PHASE_BEGIN if (lo <= ph && ph < hi) { const int nrep_ = (((PROBE_MASK | PROBE_DRY) >> ph) & 1ull) ? 2 : 1; for (int rep_ = 0; rep_ < nrep_; ++rep_) { const float DRYS = (((PROBE_DRY >> ph) & 1ull) && rep_ == 0) ? 0.0f : 1.0f; (void)DRYS; FRESH_CTX
#define PHASE_END   } if (ph + 1 < hi) { unsigned on_ = ~0u; asm volatile("" : "+s"(on_)); xcd_barrier(bar, wave_s * 64 + (int)__builtin_amdgcn_mbcnt_hi(on_, __builtin_amdgcn_mbcnt_lo(on_, 0u))); } } ++ph;
#define DENSE(name, Aptr, Btptr, Kv, ldav, ldbv, nMv, nNv, nbv, abs_, bbs_) pg8::DenseSched name{Aptr, Btptr, Kv, ldav, ldbv, pg8::TileOrder{nMv, nNv, nbv, C.G, C.bx}, abs_, bbs_}

    PHASE_BEGIN prologue(C); PHASE_END

    PHASE_BEGIN
        DENSE(S, HB, (const bf16*)(ws + WA_T), 1024, 1024, 1024, NTOK / 256, 3, 1, 0, 0);
        EpiMlaA E{SSQ, (bf16*)(ws + AR_CQ), (bf16*)(ws + AR_CKV), (bf16*)(ws + AR_KR), (float*)(ws + AR_SSQQ), (float*)(ws + AR_SSQKV), ct, st};
        pg8::gemm_phase<EpiMlaA, pg8::DenseSched, true>(lds, C.tid, S, E);
        if (C.G == 256 && C.bx >= 128) { __syncthreads(); moe_weight_prep(C, 0, 8192, 1 << 30, (C.bx - 128) * NWAVES + C.wave, 128 * NWAVES); __syncthreads(); }
    PHASE_END
    PHASE_BEGIN
        { DENSE(S, (const bf16*)(ws + AR_CQ), (const bf16*)(ws + WUQ_T), 384, 384, 384, NTOK / 256, 6, 1, 0, 0);
          EpiMlaQ E{(const float*)(ws + AR_SSQQ), (bf16*)(ws + AR_Q), ct, st};
          pg8::gemm_phase<EpiMlaQ, pg8::DenseSched, true>(lds, C.tid, S, E); }
        { FRESH_CTX MlaKnSched S{(const bf16*)(ws + AR_CKV), (const bf16*)(ws + WUKV_T), 256, 256, C.G, C.bx};
          EpiMlaKN E{(const float*)(ws + AR_SSQKV), ws + AR_KN};
          pg8::gemm_phase<EpiMlaKN, MlaKnSched, true>(lds, C.tid, S, E); }
        { FRESH_CTX MlaVtSched S{(const bf16*)(ws + WUKV_T), (const bf16*)(ws + AR_CKV), 256, 256, C.G, C.bx};
          EpiMlaVT E{(const float*)(ws + AR_SSQKV), ws + AR_VT};
          pg8::gemm_phase<EpiMlaVT, MlaVtSched, true>(lds, C.tid, S, E); }
    PHASE_END
    PHASE_BEGIN
        for (int i = 0; ; ++i) { const int bh = i * 8 + (C.bx & 7), qb = C.bx >> 3; if (bh >= 32 || C.G != 256) break;
            mla::attn_unit_f8(C.tid, ws + AR_Q, ws + AR_KN, ws + AR_KR, ws + AR_VT, ws + AR_O, bh >> 3, bh & 7, qb, (LAS char*)lds); }
    PHASE_END
    PHASE_BEGIN
        pg8::DenseSched8 S{ws + AR_O, ws + WOM_T, 1024, 1024, 1024, pg8::TileOrder{NTOK / 256, 4, 1, C.G, C.bx}};
        EpiResidual E{H, nullptr, DRYS / (O8_SCALE * W8_SCALE)};
        pg8::gemm_phase<EpiResidual, pg8::DenseSched8, true, true>(lds, C.tid, S, E);
    PHASE_END

#pragma unroll 1
    for (int layer = 0; layer < DEPTH; ++layer) {
        if (layer == 1) {
            PHASE_BEGIN
                FnetTSched S{(const bf16*)(ws + FCH_T), HB, 256, 1024, C.G, C.bx};
                EpiFnetT E{SSQ, (bf16*)(ws + AR_TT)};
                pg8::gemm_phase<EpiFnetT, FnetTSched, true>(lds, C.tid, S, E);
            PHASE_END
            PHASE_BEGIN
                FnetConstASched S{(const bf16*)(ws + FW1_T), (const bf16*)(ws + AR_TT), 256, 256, 1024, C.G, C.bx};
                EpiFnet1 E{(bf16*)(ws + AR_Z), (const float*)(ws + FTWC), (const float*)(ws + FTWS)};
                pg8::gemm_phase<EpiFnet1, FnetConstASched, true>(lds, C.tid, S, E);
            PHASE_END
            PHASE_BEGIN
                FnetConstASched S{(const bf16*)(ws + FW2_T), (const bf16*)(ws + AR_Z), 128, 128, 2048, C.G, C.bx};
                EpiFnet2 E{ws + AR_F, 6.905339660024878e-4f * FN8_SCALE};
                pg8::gemm_phase<EpiFnet2, FnetConstASched, true>(lds, C.tid, S, E);
            PHASE_END
            PHASE_BEGIN
                pg8::DenseSched8 S{ws + AR_F, ws + WOF_T, 1024, 1024, 1024, pg8::TileOrder{NTOK / 256, 4, 1, C.G, C.bx}};
                EpiResidual E{H, C.in[I_FN_BO], DRYS / (FN8_SCALE * W8_SCALE), DRYS};
                pg8::gemm_phase<EpiResidual, pg8::DenseSched8, true, true>(lds, C.tid, S, E);
            PHASE_END
        } else if (layer == 2) {
            PHASE_BEGIN
                pg8::DenseSched8 S{ws + WS_H8, ws + WIN_T, 1024, 1024, 1024, pg8::TileOrder{NTOK / 256, 16, 1, C.G, C.bx}};
                EpiGmlpIn E{SSQ, (bf16*)(ws + AR_U), (bf16*)(ws + AR_V), (float*)(ws + AR_SSQV), 1.0f / (XN8_SCALE * W8_SCALE)};
                pg8::gemm_phase<EpiGmlpIn, pg8::DenseSched8, true, true>(lds, C.tid, S, E);
            PHASE_END
            PHASE_BEGIN spatial_phase(C); PHASE_END
            PHASE_BEGIN
                pg8::DenseSched8 S{ws + AR_G, ws + WOG_T, 2048, 2048, 2048, pg8::TileOrder{NTOK / 256, 4, 1, C.G, C.bx}};
                EpiResidual E{H, nullptr, DRYS / (G8_SCALE * W8_SCALE)};
                pg8::gemm_phase<EpiResidual, pg8::DenseSched8, true, true>(lds, C.tid, S, E);
            PHASE_END
        } else if (layer == 3) {
            PHASE_BEGIN
                pg8::DenseSched8 S{ws + WS_H8, ws + WQKV_T, 1024, 1024, 1024, pg8::TileOrder{NTOK / 256, 18, 1, C.G, C.bx}};
                EpiDilQkv E{SSQ, (bf16*)(ws + AR_QKV), ct, st, 1.0f / (XN8_SCALE * W8_SCALE)};
                pg8::gemm_phase<EpiDilQkv, pg8::DenseSched8, true, true>(lds, C.tid, S, E);
            PHASE_END
            PHASE_BEGIN watt_phase(C); PHASE_END
            PHASE_BEGIN watt_combine(C); PHASE_END
            PHASE_BEGIN
                pg8::DenseSched8 S{ws + AR_OD, ws + WOD_T, 512, 512, 512, pg8::TileOrder{NTOK / 256, 4, 1, C.G, C.bx}};
                EpiResidual E{H, nullptr, DRYS / (OD8_SCALE * W8_SCALE)};
                pg8::gemm_phase<EpiResidual, pg8::DenseSched8, true, true>(lds, C.tid, S, E);
            PHASE_END
        }
        PHASE_BEGIN
            if (layer > 0) { moe_weight_prep(C, layer); __syncthreads(); }
            router_phase(C, layer);
        PHASE_END
        PHASE_BEGIN
            moe_tables(C, layer);
            const LAS int* T = (const LAS int*)(lds + LDS_TAB);
            MoeSched1 S{ws + WS_XN, ws + WS_MOEW1, (const u32x2*)(ws + WS_LIST), T, 1024, 1024, C.G, C.bx};
            EpiMoe1 E{ws + AR_HBUF, T};
            pg8::gemm_phase<EpiMoe1, MoeSched1, true, true>(lds, C.tid, S, E);
#define PP_TAIL(RT0, NRT) { FRESH_CTX const int U1 = __builtin_amdgcn_readfirstlane(((const LAS int*)(lds + LDS_TAB))[64]) * 4, rem = U1 % C.G; int nl = C.G - rem, li = C.bx - rem; if (2 * nl < C.G) { nl = C.G; li = C.bx; } \
              if (li >= 0) { pg8::DenseSched S2{(const bf16*)(ws + WS_PB) + ((size_t)layer * NTOK + (size_t)(RT0) * 256) * 256, (const bf16*)(ws + WP_T) + (size_t)layer * 1024 * 256, 256, 256, 256, pg8::TileOrder{(NRT), 4, 1, nl, li}, 0, 0}; \
                EpiStoreBf16 E2{(bf16*)(ws + WS_PP) + (size_t)(RT0) * 256 * 1024, 1024, 1.0f, 0}; \
                pg8::gemm_phase<EpiStoreBf16, pg8::DenseSched, true>(lds, C.tid, S2, E2); } }
            PP_TAIL(0, PP_SPLIT)
        PHASE_END
        PHASE_BEGIN
            moe_tables(C, layer);
            const LAS int* T = (const LAS int*)(lds + LDS_TAB);
            MoeSched2 S{ws + AR_HBUF, ws + WS_MOEW2, T, 512, 512, C.G, C.bx};
            EpiMoe2 E{(bf16*)(ws + AR_YB), (const u32x2*)(ws + WS_LIST), T};
            pg8::gemm_phase<EpiMoe2, MoeSched2, true, true>(lds, C.tid, S, E);
            PP_TAIL(PP_SPLIT, NTOK / 256 - PP_SPLIT)
        PHASE_END
        PHASE_BEGIN combine_phase(C, C.in[I_PLE_NORM] + layer * 1024, DRYS); PHASE_END
        PHASE_BEGIN
            pg8::DenseSched8 S{ws + WS_XN, ws + WG_T + (size_t)layer * 1024 * 1024, 1024, 1024, 1024, pg8::TileOrder{NTOK / 256, 4, 1, C.G, C.bx}};
            EpiPle E{H, (const bf16*)(ws + WS_PP), (float*)(ws + WS_SSQ), DRYS, (layer == 1 || layer == 2) ? ws + WS_H8 : nullptr, -1.4426950408889634f / (XN8_SCALE * W8_SCALE)};
            pg8::gemm_phase<EpiPle, pg8::DenseSched8, true, true>(lds, C.tid, S, E);
        PHASE_END
    }
    PHASE_BEGIN final_phase(C); PHASE_END
}

#ifndef MK_SPLIT
#define MK_SPLIT 0
#endif
extern "C" void kernel_launch(void* const* d_in, const int* in_sizes, int n_in, void* d_out, int out_size, void* d_ws, size_t ws_size, hipStream_t stream) {
    static int grid = 0;
    if (grid == 0) {
        if (n_in != 30 || in_sizes[0] != NTOK * DM || out_size != NTOK * DM || ws_size < WS_END) { fprintf(stderr, "kernel_launch: shape/workspace mismatch (n_in %d, ws %zu, need %zu)\n", n_in, ws_size, (size_t)WS_END); grid = -1; return; }
        int dev = 0, cus = 0;
        if (hipGetDevice(&dev) != hipSuccess || hipDeviceGetAttribute(&cus, hipDeviceAttributeMultiprocessorCount, dev) != hipSuccess) { grid = -1; return; }
        if (hipFuncSetAttribute((const void*)fwd_kernel, hipFuncAttributeMaxDynamicSharedMemorySize, LDS_BYTES) != hipSuccess) { grid = -1; return; }
        int per_cu = 0;
        if (hipOccupancyMaxActiveBlocksPerMultiprocessor(&per_cu, (const void*)fwd_kernel, NTHR, LDS_BYTES) != hipSuccess || per_cu < 1) fprintf(stderr, "kernel_launch: occupancy query reports %d\n", per_cu);
        (void)hipGetLastError();
        grid = cus;
    }
    if (grid < 0) return;
    hipMemsetAsync((char*)d_ws + WS_CTL, 0, CTL_ZERO_BYTES, stream);
    Args a{};
    for (int i = 0; i < 30; ++i) a.in[i] = (const float*)d_in[i];
    a.out = (float*)d_out; a.ws = (unsigned char*)d_ws;
#if MK_SPLIT
    for (int p = 0; p < N_PHASES; ++p) { a.ph_lo = p; a.ph_hi = p + 1; hipLaunchKernelGGL(fwd_kernel, dim3(grid), dim3(NTHR), LDS_BYTES, stream, a); }
#else
    a.ph_lo = 0; a.ph_hi = N_PHASES;
    hipLaunchKernelGGL(fwd_kernel, dim3(grid), dim3(NTHR), LDS_BYTES, stream, a);
#endif
}
```

```cpp
#include <hip/hip_runtime.h>
#include <cstdio>
#include <cstdint>

#define LAS __attribute__((address_space(3)))
#define GAS __attribute__((address_space(1)))
typedef unsigned short bf16;
typedef short bf16x8 __attribute__((ext_vector_type(8)));
typedef short s16x4 __attribute__((ext_vector_type(4)));
typedef float f32x2 __attribute__((ext_vector_type(2)));
typedef float f32x4 __attribute__((ext_vector_type(4)));
typedef float f32x16 __attribute__((ext_vector_type(16)));
typedef unsigned u32x2 __attribute__((ext_vector_type(2)));
typedef unsigned u32x4 __attribute__((ext_vector_type(4)));

constexpr int DM = 1024, BATCH = 4, SEQ = 8192, NTOK = BATCH * SEQ, DEPTH = 4;
constexpr float EPS = 1e-6f;
constexpr int NWAVES = 8, NTHR = 512;
constexpr int MOE_CAP = 32768;
constexpr int HB_ROWS = 65536 + 32 * 256;

constexpr size_t MiB = 1u << 20;
constexpr size_t WS_CTL = 0, CTL_ZERO_BYTES = 1 * MiB;
constexpr size_t WS_COS = 1 * MiB, WS_SIN = 2 * MiB;
constexpr size_t WS_WPERM = 3 * MiB;
constexpr size_t WS_SSQ = 4 * MiB;
constexpr size_t WS_LIST = 6 * MiB;
constexpr size_t WS_WSM = 14 * MiB;
constexpr size_t WA_T = WS_WSM + 0 * MiB, WUQ_T = WS_WSM + 2 * MiB, WUKV_T = WS_WSM + 4 * MiB, WOM_T = WS_WSM + 5 * MiB, FCH_T = WS_WSM + 7 * MiB, WOF_T = WS_WSM + 8 * MiB,
                 WIN_T = WS_WSM + 10 * MiB, WOG_T = WS_WSM + 18 * MiB, WQKV_T = WS_WSM + 22 * MiB, WOD_T = WS_WSM + 31 * MiB, WG_T = WS_WSM + 32 * MiB, WP_T = WS_WSM + 40 * MiB,
                 FW1_T = WS_WSM + 42 * MiB, FW2_T = WS_WSM + 43 * MiB, FTWC = WS_WSM + 44 * MiB, FTWS = WS_WSM + 45 * MiB;
constexpr size_t WS_MOEW1 = 64 * MiB, WS_MOEW2 = 128 * MiB;
constexpr size_t WS_H8 = 160 * MiB;
constexpr size_t WS_HB = 288 * MiB;
constexpr size_t WS_XN = 352 * MiB;
constexpr size_t WS_PP = 416 * MiB;
constexpr size_t WS_PB = 480 * MiB;
constexpr size_t WS_AR = 544 * MiB;
constexpr size_t WS_END = 1010 * MiB;
constexpr size_t AR_YB = WS_AR + 0 * MiB, AR_HBUF = WS_AR + 128 * MiB;
constexpr size_t AR_CQ = WS_AR + 0 * MiB, AR_CKV = WS_AR + 24 * MiB, AR_KR = WS_AR + 40 * MiB, AR_SSQQ = WS_AR + 44 * MiB, AR_SSQKV = WS_AR + 45 * MiB, AR_Q = WS_AR + 46 * MiB, AR_KN = WS_AR + 96 * MiB, AR_VT = WS_AR + 128 * MiB, AR_O = WS_AR + 160 * MiB;
constexpr size_t AR_TT = WS_AR + 0 * MiB, AR_Z = WS_AR + 128 * MiB, AR_F = WS_AR + 256 * MiB;
constexpr size_t AR_U = WS_AR + 0 * MiB, AR_V = WS_AR + 128 * MiB, AR_G = WS_AR + 256 * MiB, AR_SSQV = WS_AR + 384 * MiB;
constexpr size_t AR_QKV = WS_AR + 0 * MiB, AR_OD = WS_AR + 288 * MiB, AR_OG = WS_AR + 320 * MiB, AR_LSE = WS_AR + 416 * MiB;

constexpr int CW_TMO = 0;
constexpr int CW_BAR = 4096;
constexpr int CW_CNT = 8192;

constexpr int LDS_TAB = 131072;
constexpr int LDS_MISC = 131072 + 8192;
constexpr int LDS_PTRS = 131072 + 4096;
constexpr int LDS_BYTES = 147456;

#define LDS_WAIT() asm volatile("s_waitcnt lgkmcnt(0)" ::: "memory")
#define VM_WAIT() asm volatile("s_waitcnt vmcnt(0)" ::: "memory")
#define SBAR() __builtin_amdgcn_sched_barrier(0)
__device__ __forceinline__ unsigned cvt_pk_bf16(float lo, float hi) { unsigned r; asm volatile("v_cvt_pk_bf16_f32 %0, %1, %2" : "=v"(r) : "v"(lo), "v"(hi)); return r; }
constexpr float ATT8_SCALE = 4.f;
constexpr float K8_SCALE = 0.25f, Q8_SCALE = 0.07216878364870322f * 1.4426950408889634f / K8_SCALE;
constexpr float XN8_SCALE = 8.f, HB8_SCALE = 4.f, W8_SCALE = 64.f, G8_SCALE = 4.f, O8_SCALE = 32.f, FN8_SCALE = 16.f, OD8_SCALE = 32.f, YB8_SCALE = 32.f;
__device__ __forceinline__ unsigned pk_fp8x4(float a, float b, float c, float d) { unsigned w = __builtin_amdgcn_cvt_pk_fp8_f32(a, b, __float_as_uint(a), false); return __builtin_amdgcn_cvt_pk_fp8_f32(c, d, w, true); }
__device__ __forceinline__ float bf2f(unsigned short x) { return __uint_as_float(((unsigned)x) << 16); }
__device__ __forceinline__ float bflo(unsigned w) { return __uint_as_float(w << 16); }
__device__ __forceinline__ float bfhi(unsigned w) { return __uint_as_float(w & 0xffff0000u); }
__device__ __forceinline__ u32x2 pack4(f32x4 v) { u32x2 w; w.x = cvt_pk_bf16(v[0], v[1]); w.y = cvt_pk_bf16(v[2], v[3]); return w; }
__device__ __forceinline__ f32x4 unpack4(u32x2 w) { return (f32x4){bflo(w.x), bfhi(w.x), bflo(w.y), bfhi(w.y)}; }
__device__ __forceinline__ float sumsq4(f32x4 v) { return (v[0] * v[0] + v[1] * v[1]) + (v[2] * v[2] + v[3] * v[3]); }
__device__ __forceinline__ float wave_sum(float v) {
#pragma unroll
    for (int o = 1; o < 64; o <<= 1) v += __shfl_xor(v, o);
    return v;
}
__device__ __forceinline__ float fast_exp2(float x) { return __builtin_amdgcn_exp2f(x); }
__device__ __forceinline__ float fast_rcp(float x) { return __builtin_amdgcn_rcpf(x); }

#define XB_TMO      128
#define XB_XCNT(j)  (256  + 64 * (j))
#define XB_XSUB(j)  (1280 + 64 * (j))
#define XB_XGEN(j)  (2304 + 64 * (j))
#define XB_TOP      3328
#define XB_TOPGEN   3392
#define XCD_BAR_WORDS 3456
#define XB_SPIN_CAP (1u << 20)
__device__ __forceinline__ unsigned xb_ld(unsigned* p)              { return __hip_atomic_load(p, __ATOMIC_RELAXED, __HIP_MEMORY_SCOPE_AGENT); }
__device__ __forceinline__ unsigned xb_add(unsigned* p, unsigned v) { return __hip_atomic_fetch_add(p, v, __ATOMIC_RELAXED, __HIP_MEMORY_SCOPE_AGENT); }
__device__ __forceinline__ unsigned xb_xcc_id() { return (unsigned)__builtin_amdgcn_s_getreg((3 << 11) | 20) & 0xFu; }
#define XB_SPIN(cond, bar) do { unsigned _sp = 0; while (cond) { __builtin_amdgcn_s_sleep(1); \
    if ((++_sp & 255u) == 0u) { if (xb_ld(&(bar)[XB_TMO])) break; if (_sp > XB_SPIN_CAP) { atomicAdd(&(bar)[XB_TMO], 1u); break; } } } } while (0)
struct XcdBarrier { unsigned* bar; unsigned x; volatile LAS unsigned* st; };
__device__ __forceinline__ XcdBarrier xcd_barrier_post(unsigned* bar, volatile LAS unsigned* st) {
    XcdBarrier b; b.bar = bar; b.x = xb_xcc_id(); b.st = st;
    if (threadIdx.x == 0) (void)xb_add(&bar[XB_XCNT(b.x)], 1u);
    return b;
}
__device__ __forceinline__ void xcd_barrier_complete(unsigned* bar, unsigned x, unsigned& nloc, unsigned& nx) {
    const unsigned G = gridDim.x * gridDim.y * gridDim.z;
    unsigned sum, cnt, mine, sp = 0u;
    for (;;) {
        sum = 0u; cnt = 0u; mine = 0u;
        unsigned cj[16];
#pragma unroll
        for (unsigned j = 0; j < 16; ++j) cj[j] = xb_ld(&bar[XB_XCNT(j)]);
#pragma unroll
        for (unsigned j = 0; j < 16; ++j) { const unsigned c = cj[j]; sum += c; cnt += (c > 0u) ? 1u : 0u; mine = (j == x) ? c : mine; }
        if (sum == G) break;
        __builtin_amdgcn_s_sleep(1);
        if ((++sp & 255u) == 0u) { if (xb_ld(&bar[XB_TMO])) break; if (sp > XB_SPIN_CAP) { atomicAdd(&bar[XB_TMO], 1u); break; } }
    }
    nloc = mine > 0u ? mine : 1u; nx = cnt > 0u ? cnt : 1u;
}
__device__ __forceinline__ void xcd_barrier(const XcdBarrier& b, const int tid) {
    asm volatile("s_waitcnt vmcnt(0)" ::: "memory");
    __syncthreads();
    if (tid == 0) {
        unsigned* bar = b.bar;
        __builtin_amdgcn_s_waitcnt(0);
        unsigned nloc = b.st[0], nx = b.st[1];
        if (nloc == 0u) { xcd_barrier_complete(bar, b.x, nloc, nx); b.st[0] = nloc; b.st[1] = nx; }
        const unsigned old = xb_add(&bar[XB_XSUB(b.x)], 1u);
        const unsigned gen = old / nloc;
        if (old + 1u == (gen + 1u) * nloc) {
            __builtin_amdgcn_fence(__ATOMIC_RELEASE, "agent");
            asm volatile("s_waitcnt vmcnt(0)" ::: "memory");
            const unsigned og = xb_add(&bar[XB_TOP], 1u);
            const unsigned tg = og / nx;
            if (og + 1u == (tg + 1u) * nx) xb_add(&bar[XB_TOPGEN], 1u);
            else XB_SPIN(xb_ld(&bar[XB_TOPGEN]) == tg, bar);
            __builtin_amdgcn_fence(__ATOMIC_ACQUIRE, "agent");
            xb_add(&bar[XB_XGEN(b.x)], 1u);
            asm volatile("s_waitcnt vmcnt(0)" ::: "memory");
        } else {
            XB_SPIN(xb_ld(&bar[XB_XGEN(b.x)]) == gen, bar);
            __builtin_amdgcn_fence(__ATOMIC_ACQUIRE, "agent");
            asm volatile("s_waitcnt vmcnt(0)" ::: "memory");
        }
    }
    __syncthreads();
}

namespace pg8 {
constexpr int BM = 256, BK = 64, HALF = 128, HTB = HALF * BK * 2, STAGE_BYTES = 8 * HTB, NXCD = 8, WGM = 8;
__host__ __device__ __forceinline__ int lds_byte(int r, int c) { const int st = (r >> 4) * 2 + (c >> 5), rr = r & 15, cc = c & 31, ob = rr * 64 + cc * 2; return st * 1024 + (ob ^ (((ob >> 9) & 1) << 5)); }
__host__ __device__ __forceinline__ void stage_rc(int b, int& R, int& C) { const int st = b / 1024, sb = b % 1024, swz = sb ^ (((sb >> 9) & 1) << 5); R = (st >> 1) * 16 + swz / 64; C = (st & 1) * 32 + (swz % 64) / 2; }

typedef int v8i32 __attribute__((ext_vector_type(8)));
__device__ __forceinline__ v8i32 cat8(bf16x8 lo, bf16x8 hi) { const u32x4 a = __builtin_bit_cast(u32x4, lo), b = __builtin_bit_cast(u32x4, hi); return (v8i32){(int)a.x, (int)a.y, (int)a.z, (int)a.w, (int)b.x, (int)b.y, (int)b.z, (int)b.w}; }
union Frag { v8i32 v; bf16x8 q[2]; };
struct Unit { const char* a; const char* b; int pm, pn, aux; };

struct TileOrder {
    int nM, nN, nb, G, c;
    __device__ __forceinline__ bool decode(int i, int& bt, int& pm, int& pn) const {
        const int per = nM * nN, total = per * nb; const long L = (long)i * G + c; if (L >= total) return false;
        int wgid = (int)L; { const int q = total / NXCD, r = total % NXCD, xcd = wgid % NXCD, off = wgid / NXCD; wgid = (xcd < r ? xcd * (q + 1) : r * (q + 1) + (xcd - r) * q) + off; }
        bt = wgid / per; const int rem = wgid % per;
        const int nig = WGM * nN, gid = rem / nig, fm = gid * WGM, gsz = (nM - fm) < WGM ? (nM - fm) : WGM;
        pm = fm + ((rem % nig) % gsz); pn = (rem % nig) / gsz; return true;
    }
};

#define PG8_SA(b, h) (((b) * 2 + (h)) * HTB)
#define PG8_SB(b, h) ((4 + (b) * 2 + (h)) * HTB)
#define PG8_WAIT_V(n) asm volatile("s_waitcnt vmcnt(" #n ")" ::: "memory")
#define PG8_WAIT_L(n) asm volatile("s_waitcnt lgkmcnt(" #n ")" ::: "memory")
#define PG8_BAR __builtin_amdgcn_s_barrier()
#define PG8_SCHED __builtin_amdgcn_sched_barrier(0)

template <class Epi, class Sched, bool ALIGN_EPI, bool FP8 = false>
__device__ __forceinline__ void gemm_phase(LAS unsigned char* lds, const int tid, const Sched& S, const Epi& E) {
    const int wid = __builtin_amdgcn_readfirstlane(tid >> 6), lane = tid & 63, wr = wid >> 2, wc = wid & 3, fr = lane & 15, fq = lane >> 4;
    const int K = S.K, nt = K / (FP8 ? 2 * BK : BK);
    int Rs[2], Cs[2]; unsigned voffB[2];
#pragma unroll
    for (int i = 0; i < 2; ++i) { stage_rc(tid * 16 + i * 8192, Rs[i], Cs[i]); voffB[i] = S.boff(Rs[i], Cs[i]); }
    const size_t kstep = (size_t)(BK * 2);
    const size_t hstepB = S.hstepB();
    const unsigned ldsw = (unsigned)wid * 1024u;
    const int aoff = lds_byte(wr * 64 + fr, fq * 8), boff = lds_byte(wc * 32 + fr, fq * 8);
#define PG8_STAGE_B(bufoff, gbase) do { _Pragma("unroll") for (int _i = 0; _i < 2; ++_i) { unsigned vo_ = voffB[_i]; asm volatile("" : "+v"(vo_));     \
        __builtin_amdgcn_global_load_lds((GAS const unsigned*)((GAS const char*)(unsigned long long)(gbase) + vo_), (LAS unsigned*)(lds + (bufoff) + ldsw + _i * 8192), 16, 0, 0); } } while (0)
#define PG8_STAGE_A(bufoff, gbase, vo) do { _Pragma("unroll") for (int _i = 0; _i < 2; ++_i) { unsigned vo_ = (vo)[_i]; asm volatile("" : "+v"(vo_)); \
        __builtin_amdgcn_global_load_lds((GAS const unsigned*)((GAS const char*)(unsigned long long)(gbase) + vo_), (LAS unsigned*)(lds + (bufoff) + ldsw + _i * 8192), 16, 0, 0); } } while (0)
#define PG8_LDA(dst, b, h) do { _Pragma("unroll") for (int m = 0; m < 4; ++m) _Pragma("unroll") for (int k = 0; k < 2; ++k) dst[m].q[k] = *(const LAS bf16x8*)(lds + PG8_SA(b, h) + aoff + m * 2048 + k * 1024); } while (0)
#define PG8_LDB(dst, b, h) do { _Pragma("unroll") for (int n = 0; n < 2; ++n) _Pragma("unroll") for (int k = 0; k < 2; ++k) dst[n].q[k] = *(const LAS bf16x8*)(lds + PG8_SB(b, h) + boff + n * 2048 + k * 1024); } while (0)
#define PG8_MMA(ai, bj, At, Bt) do { __builtin_amdgcn_s_setprio(1); if constexpr (FP8) { _Pragma("unroll") for (int m = 0; m < 4; ++m) _Pragma("unroll") for (int n = 0; n < 2; ++n) \
        asm volatile("v_mfma_f32_16x16x128_f8f6f4 %0, %1, %2, %0" : "+v"(acc[ai][bj][m][n]) : "v"(Bt[n].v), "v"(At[m].v)); }     \
        else { _Pragma("unroll") for (int m = 0; m < 4; ++m) _Pragma("unroll") for (int n = 0; n < 2; ++n) _Pragma("unroll") for (int k = 0; k < 2; ++k) \
        acc[ai][bj][m][n] = __builtin_amdgcn_mfma_f32_16x16x32_bf16(Bt[n].q[k], At[m].q[k], acc[ai][bj][m][n], 0, 0, 0); } __builtin_amdgcn_s_setprio(0); } while (0)
    Unit cur, nxt; int ui = 0;
    if (!S.next(0, cur)) return;
    unsigned cv0[2], cv1[2], nv0[2], nv1[2];
#pragma unroll
    for (int i = 0; i < 2; ++i) { cv0[i] = S.aoff(cur, 0, Rs[i], Cs[i]); cv1[i] = S.aoff(cur, 1, Rs[i], Cs[i]); nv0[i] = cv0[i]; nv1[i] = cv1[i]; }
    f32x4 acc[2][2][4][2];
#pragma unroll
    for (int a = 0; a < 2; ++a)
#pragma unroll
        for (int b = 0; b < 2; ++b)
#pragma unroll
            for (int m = 0; m < 4; ++m)
#pragma unroll
                for (int n = 0; n < 2; ++n) acc[a][b][m][n] = (f32x4){0.f, 0.f, 0.f, 0.f};
    Frag At[4], B0[2], B1[2];
    const char* cA = cur.a; const char* cB = cur.b;
    PG8_STAGE_B(PG8_SB(0, 0), cB); PG8_STAGE_B(PG8_SB(0, 1), cB + hstepB); PG8_STAGE_A(PG8_SA(0, 0), cA, cv0); PG8_STAGE_A(PG8_SA(0, 1), cA, cv1);
    if (wr == 1) PG8_BAR;
    PG8_WAIT_V(2); PG8_BAR;
    constexpr bool BAL = FP8;
    if constexpr (BAL) { PG8_STAGE_B(PG8_SB(1, 0), cB + kstep); PG8_STAGE_B(PG8_SB(1, 1), cB + hstepB + kstep); PG8_WAIT_V(4); }
    else { PG8_STAGE_B(PG8_SB(1, 0), cB + kstep); PG8_STAGE_A(PG8_SA(1, 0), cA + kstep, cv0); PG8_STAGE_B(PG8_SB(1, 1), cB + hstepB + kstep); PG8_WAIT_V(6); }
    PG8_BAR;
    for (;;) {
        const bool has_next = S.next(ui + 1, nxt);
        const char* nA = has_next ? nxt.a : cA; const char* nB = has_next ? nxt.b : cB;
        if (has_next) {
#pragma unroll
            for (int i = 0; i < 2; ++i) { nv0[i] = S.aoff(nxt, 0, Rs[i], Cs[i]); nv1[i] = S.aoff(nxt, 1, Rs[i], Cs[i]); }
        } else {
#pragma unroll
            for (int i = 0; i < 2; ++i) { nv0[i] = cv0[i]; nv1[i] = cv1[i]; }
        }
        for (int t = 0; t < nt; t += 2) {
            const bool last = (t == nt - 2);
            const char* a1 = cA + (size_t)(t + 1) * kstep;
            const char* a2 = last ? nA : cA + (size_t)(t + 2) * kstep; const char* b2 = last ? nB : cB + (size_t)(t + 2) * kstep;
            const char* a3 = a2 + kstep; const char* b3 = b2 + kstep;
            unsigned x0[2], x1[2];
#pragma unroll
            for (int i = 0; i < 2; ++i) { x0[i] = last ? nv0[i] : cv0[i]; x1[i] = last ? nv1[i] : cv1[i]; }
            if constexpr (BAL) {
            PG8_LDB(B0, 0, 0); PG8_LDB(B1, 0, 1); PG8_SCHED; PG8_LDA(At, 0, 0); PG8_STAGE_A(PG8_SA(1, 1), a1, cv1); PG8_STAGE_A(PG8_SA(1, 0), a1, cv0);
            PG8_WAIT_V(10); PG8_WAIT_L(0); PG8_BAR; PG8_MMA(0, 0, At, B0); PG8_MMA(0, 1, At, B1); PG8_BAR; PG8_SCHED;
            PG8_LDA(At, 0, 1); PG8_STAGE_B(PG8_SB(0, 0), b2); PG8_STAGE_B(PG8_SB(0, 1), b2 + hstepB);
            PG8_WAIT_V(4); PG8_WAIT_L(0); PG8_BAR; PG8_MMA(1, 0, At, B0); PG8_MMA(1, 1, At, B1); PG8_BAR; PG8_SCHED;
            PG8_LDB(B0, 1, 0); PG8_LDB(B1, 1, 1); PG8_SCHED; PG8_LDA(At, 1, 0); PG8_STAGE_A(PG8_SA(0, 1), a2, x1); PG8_STAGE_A(PG8_SA(0, 0), a2, x0);
            PG8_WAIT_V(10); PG8_WAIT_L(0); PG8_BAR; PG8_MMA(0, 0, At, B0); PG8_MMA(0, 1, At, B1); PG8_BAR; PG8_SCHED;
            PG8_LDA(At, 1, 1); PG8_STAGE_B(PG8_SB(1, 0), b3); PG8_STAGE_B(PG8_SB(1, 1), b3 + hstepB);
            PG8_WAIT_V(4); PG8_WAIT_L(0); PG8_BAR; PG8_MMA(1, 0, At, B0); PG8_MMA(1, 1, At, B1); PG8_BAR; PG8_SCHED;
            } else {
            PG8_LDB(B0, 0, 0); PG8_LDB(B1, 0, 1); PG8_SCHED; PG8_LDA(At, 0, 0); PG8_STAGE_A(PG8_SA(1, 1), a1, cv1);
            PG8_WAIT_V(8); PG8_WAIT_L(0); PG8_BAR; PG8_MMA(0, 0, At, B0); PG8_MMA(0, 1, At, B1); PG8_BAR; PG8_SCHED;
            PG8_LDA(At, 0, 1); PG8_STAGE_B(PG8_SB(0, 0), b2); PG8_STAGE_B(PG8_SB(0, 1), b2 + hstepB); PG8_STAGE_A(PG8_SA(0, 0), a2, x0);
            PG8_WAIT_V(8); PG8_WAIT_L(0); PG8_BAR; PG8_MMA(1, 0, At, B0); PG8_MMA(1, 1, At, B1); PG8_BAR; PG8_SCHED;
            PG8_LDB(B0, 1, 0); PG8_LDB(B1, 1, 1); PG8_SCHED; PG8_LDA(At, 1, 0); PG8_STAGE_A(PG8_SA(0, 1), a2, x1);
            PG8_WAIT_V(8); PG8_WAIT_L(0); PG8_BAR; PG8_MMA(0, 0, At, B0); PG8_MMA(0, 1, At, B1); PG8_BAR; PG8_SCHED;
            PG8_LDA(At, 1, 1); PG8_STAGE_B(PG8_SB(1, 0), b3); PG8_STAGE_B(PG8_SB(1, 1), b3 + hstepB); PG8_STAGE_A(PG8_SA(1, 0), a3, x0);
            PG8_WAIT_V(8); PG8_WAIT_L(0); PG8_BAR; PG8_MMA(1, 0, At, B0); PG8_MMA(1, 1, At, B1); PG8_BAR; PG8_SCHED;
            }
        }
        if constexpr (FP8) asm volatile("s_nop 15\n\ts_nop 7" ::: "memory");
        if constexpr (ALIGN_EPI) { if (wr == 0) PG8_BAR; }
        E(acc, cur, wr, wc, fr, fq);
        if (!has_next) break;
#pragma unroll
        for (int a = 0; a < 2; ++a)
#pragma unroll
            for (int b = 0; b < 2; ++b)
#pragma unroll
                for (int m = 0; m < 4; ++m)
#pragma unroll
                    for (int n = 0; n < 2; ++n) acc[a][b][m][n] = (f32x4){0.f, 0.f, 0.f, 0.f};
        cur = nxt; cA = nA; cB = nB; ++ui;
#pragma unroll
        for (int i = 0; i < 2; ++i) { cv0[i] = nv0[i]; cv1[i] = nv1[i]; }
        if constexpr (ALIGN_EPI) { if (wr == 1) PG8_BAR; }
    }
    PG8_WAIT_V(0);
    if constexpr (!ALIGN_EPI) { if (wr == 0) PG8_BAR; }
    PG8_BAR;
#undef PG8_STAGE_A
#undef PG8_STAGE_B
#undef PG8_LDA
#undef PG8_LDB
#undef PG8_MMA
}

struct DenseSched {
    const bf16* A; const bf16* Bt; int K, lda, ldb; TileOrder T; size_t a_bstride, b_bstride;
    __device__ __forceinline__ bool next(int i, Unit& u) const {
        int bt, pm, pn; if (!T.decode(i, bt, pm, pn)) return false;
        u.pm = pm; u.pn = pn; u.aux = bt;
        u.a = (const char*)(A + (size_t)bt * a_bstride + (size_t)pm * BM * lda); u.b = (const char*)(Bt + (size_t)bt * b_bstride + (size_t)pn * BM * ldb); return true;
    }
    __device__ __forceinline__ unsigned aoff(const Unit&, int half, int R, int C) const { return (unsigned)((R + HALF * half) * lda + C) * 2u; }
    __device__ __forceinline__ unsigned boff(int R, int C) const { return (unsigned)(R * ldb + C) * 2u; }
    __device__ __forceinline__ size_t hstepB() const { return (size_t)HALF * ldb * 2; }
};
struct DenseSched8 {
    const unsigned char* A; const unsigned char* Bt; int K, lda, ldb; TileOrder T;
    __device__ __forceinline__ bool next(int i, Unit& u) const {
        int bt, pm, pn; if (!T.decode(i, bt, pm, pn)) return false;
        u.pm = pm; u.pn = pn; u.aux = bt; u.a = (const char*)(A + (size_t)pm * BM * lda); u.b = (const char*)(Bt + (size_t)pn * BM * ldb); return true;
    }
    __device__ __forceinline__ unsigned aoff(const Unit&, int half, int R, int C) const { return (unsigned)((R + HALF * half) * lda + 2 * C); }
    __device__ __forceinline__ unsigned boff(int R, int C) const { return (unsigned)(R * ldb + 2 * C); }
    __device__ __forceinline__ size_t hstepB() const { return (size_t)HALF * ldb; }
};
}

#define EPI_LOOP_BEGIN _Pragma("unroll") for (int ai = 0; ai < 2; ++ai) _Pragma("unroll") for (int m = 0; m < 4; ++m) { const int rowt = ai * 128 + wr * 64 + m * 16 + fr;
#define EPI_LOOP_END }

struct Args {
    const float* in[30];
    float* out; unsigned char* ws; int ph_lo, ph_hi;
};
enum { I_X = 0, I_P, I_NORM_MIX, I_NORM_MOE, I_MLA_WA, I_MLA_NQ, I_MLA_NKV, I_MLA_WUQ, I_MLA_WUKV, I_MLA_WO, I_FN_WO, I_FN_BO, I_GM_WIN, I_GM_NV, I_GM_WS, I_GM_BS, I_GM_WO,
       I_DL_WQKV, I_DL_WO, I_MOE_WGRP, I_MOE_BGRP, I_MOE_WEXP, I_MOE_BEXP, I_MOE_WGATE, I_MOE_WUP, I_MOE_WDOWN, I_PLE_NORM, I_PLE_WGATE, I_PLE_WPROJ, I_NORM_FINAL };

struct Ctx {
    LAS unsigned char* lds; unsigned char* ws; float* out;
    int tid, lane, wave, G, bx;
    struct InTab { LAS unsigned char* lds;
        __device__ __forceinline__ const float* operator[](int i) const {
            const u32x2 w = *(const LAS u32x2*)(lds + LDS_PTRS + 8 * i);
            const unsigned long long p = ((unsigned long long)(unsigned)__builtin_amdgcn_readfirstlane((int)w.y) << 32) | (unsigned)__builtin_amdgcn_readfirstlane((int)w.x);
            return (const float*)(GAS const float*)p; } } in;
};

__device__ __forceinline__ int rope_phys(int l) { return (((l & 31) >> 4) << 5) + ((l >> 5) << 4) + (l & 15); }
__device__ __forceinline__ int tr_map(int mode, int n) {
    switch (mode) {
        case 1: return n < 640 ? n : 640 + rope_phys(n - 640);
        case 2: { const int h = n / 192, r = n % 192; return h * 192 + (r < 128 ? r : 128 + rope_phys(r - 128)); }
        case 3: { const int blk = n >> 6, l = n & 63, t = (blk >> 3) % 3; return t < 2 ? (blk << 6) + rope_phys(l) : n; }
        case 4: case 5: { const int pn = n >> 7, wc = (n >> 5) & 3, fq = (n >> 3) & 3, bj = (n >> 2) & 1, i = n & 3; return 256 * pn + 128 * bj + 32 * wc + 16 * (mode - 4) + 4 * fq + i; }
        default: return n;
    }
}
__device__ __forceinline__ void transpose_item(const float* W, int K, int N, bf16* WT, int ldt, const float* gain, int mode, LAS float* scr, int item, int lane) {
    const int nblk = N / 64, kb = item / nblk, nb = item % nblk, k0 = 64 * kb, n0 = 64 * nb;
    const int lr = lane >> 4, lc = (lane & 15) * 4;
    f32x4 v[16];
#pragma unroll
    for (int i = 0; i < 16; ++i) v[i] = *(const f32x4*)(W + (size_t)(k0 + 4 * i + lr) * N + n0 + lc);
    if (gain) { float gv[16];
#pragma unroll
        for (int i = 0; i < 16; ++i) gv[i] = gain[k0 + 4 * i + lr];
#pragma unroll
        for (int i = 0; i < 16; ++i) v[i] *= gv[i];
    }
#pragma unroll
    for (int i = 0; i < 16; ++i) { LAS float* p = scr + (4 * i + lr) * 65 + lc; p[0] = v[i][0]; p[1] = v[i][1]; p[2] = v[i][2]; p[3] = v[i][3]; }
    LDS_WAIT(); asm volatile("" ::: "memory");
    const int c = lane & 7;
#pragma unroll
    for (int j = 0; j < 8; ++j) { const int n = (lane >> 3) + 8 * j; const LAS float* s = scr + (8 * c) * 65 + n;
        u32x4 o; o.x = cvt_pk_bf16(s[0 * 65], s[1 * 65]); o.y = cvt_pk_bf16(s[2 * 65], s[3 * 65]); o.z = cvt_pk_bf16(s[4 * 65], s[5 * 65]); o.w = cvt_pk_bf16(s[6 * 65], s[7 * 65]);
        *(u32x4*)(WT + (size_t)tr_map(mode, n0 + n) * ldt + k0 + 8 * c) = o; }
    LDS_WAIT(); asm volatile("" ::: "memory");
}
__device__ __forceinline__ void transpose_item8(const float* W, int K, int N, unsigned char* WT, int ldt, float scale, int mode, LAS float* scr, int item, int lane, const float* gain = nullptr) {
    const int nblk = N / 64, kb = item / nblk, nb = item % nblk, k0 = 64 * kb, n0 = 64 * nb;
    const int lr = lane >> 4, lc = (lane & 15) * 4;
    f32x4 v[16];
#pragma unroll
    for (int i = 0; i < 16; ++i) v[i] = *(const f32x4*)(W + (size_t)(k0 + 4 * i + lr) * N + n0 + lc);
    float gv[16];
#pragma unroll
    for (int i = 0; i < 16; ++i) gv[i] = gain ? scale * gain[k0 + 4 * i + lr] : scale;
#pragma unroll
    for (int i = 0; i < 16; ++i) { LAS float* p = scr + (4 * i + lr) * 65 + lc; const float sg = gv[i]; p[0] = v[i][0] * sg; p[1] = v[i][1] * sg; p[2] = v[i][2] * sg; p[3] = v[i][3] * sg; }
    LDS_WAIT(); asm volatile("" ::: "memory");
    const int c = lane & 3;
#pragma unroll
    for (int j = 0; j < 4; ++j) { const int n = (lane >> 2) + 16 * j; const LAS float* s = scr + (16 * c) * 65 + n;
        u32x4 o; o.x = pk_fp8x4(s[0 * 65], s[1 * 65], s[2 * 65], s[3 * 65]); o.y = pk_fp8x4(s[4 * 65], s[5 * 65], s[6 * 65], s[7 * 65]);
        o.z = pk_fp8x4(s[8 * 65], s[9 * 65], s[10 * 65], s[11 * 65]); o.w = pk_fp8x4(s[12 * 65], s[13 * 65], s[14 * 65], s[15 * 65]);
        *(u32x4*)(WT + (size_t)tr_map(mode, n0 + n) * ldt + k0 + 16 * c) = o; }
    LDS_WAIT(); asm volatile("" ::: "memory");
}
__device__ __forceinline__ void transpose_matrix(const Ctx& C, const float* W, int K, int N, bf16* WT, int ldt, const float* gain, int mode) {
    LAS float* scr = (LAS float*)(C.lds + C.wave * 16896);
    const int gw = C.bx * NWAVES + C.wave, NGW = C.G * NWAVES, nitems = (K / 64) * (N / 64);
    for (int it = gw; it < nitems; it += NGW) transpose_item(W, K, N, WT, ldt, gain, mode, scr, it, C.lane);
}
__device__ __forceinline__ void moe_weight_prep(const Ctx& C, int layer, int it_lo = 0, int it_hi = 1 << 30, int gwo = -1, int ngwo = 0) {
    LAS float* scr = (LAS float*)(C.lds + C.wave * 16896);
    const int gw = C.bx * NWAVES + C.wave, NGW = C.G * NWAVES;
    const float* wg = C.in[I_MOE_WGATE] + (size_t)layer * 32 * 1024 * 512; const float* wu = C.in[I_MOE_WUP] + (size_t)layer * 32 * 1024 * 512; const float* wd = C.in[I_MOE_WDOWN] + (size_t)layer * 32 * 512 * 1024;
    unsigned char* w1 = C.ws + WS_MOEW1; unsigned char* w2 = C.ws + WS_MOEW2;
    constexpr int IT1 = (1024 / 64) * (512 / 64), IT2 = (512 / 64) * (1024 / 64);
    const int total = 32 * (2 * IT1 + IT2), hi_ = it_hi < total ? it_hi : total;
    for (int it = it_lo + (gwo >= 0 ? gwo : gw); it < hi_; it += (gwo >= 0 ? ngwo : NGW)) {
        const int e = it / (2 * IT1 + IT2); int r = it % (2 * IT1 + IT2);
        if (r < IT1) { transpose_item8(wg + (size_t)e * 1024 * 512, 1024, 512, w1 + (size_t)e * 1024 * 1024, 1024, 64.f, 4, scr, r, C.lane); continue; } r -= IT1;
        if (r < IT1) { transpose_item8(wu + (size_t)e * 1024 * 512, 1024, 512, w1 + (size_t)e * 1024 * 1024, 1024, 64.f, 5, scr, r, C.lane); continue; } r -= IT1;
        transpose_item8(wd + (size_t)e * 512 * 1024, 512, 1024, w2 + (size_t)e * 1024 * 512, 512, 64.f, 0, scr, r, C.lane);
    }
}

__device__ __forceinline__ void prologue(const Ctx& C) {
    const int gw = C.bx * NWAVES + C.wave, NGW = C.G * NWAVES, gt = C.bx * NTHR + C.tid, NGT = C.G * NTHR;
    unsigned char* ws = C.ws;
    for (int i = gt; i < 64 * 1024 / 8; i += NGT) ((u32x4*)(ws + WA_T + (size_t)704 * 1024 * 2))[i] = (u32x4){0u, 0u, 0u, 0u};
    {
        LAS float* scr = (LAS float*)(C.lds + C.wave * 16896);
        constexpr int N_WA = 16 * 11, N_UQ = 6 * 24, N_UKV = 4 * 32, N_SQ = 16 * 16, N_WIN = 16 * 64, N_GWO = 32 * 16, N_QKV = 16 * 72, N_DWO = 8 * 16, N_PP = 4 * 16;
        constexpr int TOTAL = N_WA + N_UQ + N_UKV + 2 * N_SQ + N_WIN + N_GWO + N_QKV + N_DWO + DEPTH * (N_SQ + N_PP);
        for (int it = gw; it < TOTAL; it += NGW) {
            int r = it;
            if (r < N_WA)  { transpose_item(C.in[I_MLA_WA], 1024, 704, (bf16*)(ws + WA_T), 1024, C.in[I_NORM_MIX] + 0 * 1024, 1, scr, r, C.lane); continue; } r -= N_WA;
            if (r < N_UQ)  { transpose_item(C.in[I_MLA_WUQ], 384, 1536, (bf16*)(ws + WUQ_T), 384, C.in[I_MLA_NQ], 2, scr, r, C.lane); continue; } r -= N_UQ;
            if (r < N_UKV) { transpose_item(C.in[I_MLA_WUKV], 256, 2048, (bf16*)(ws + WUKV_T), 256, C.in[I_MLA_NKV], 0, scr, r, C.lane); continue; } r -= N_UKV;
            if (r < N_SQ)  { transpose_item8(C.in[I_MLA_WO], 1024, 1024, ws + WOM_T, 1024, 64.f, 0, scr, r, C.lane); continue; } r -= N_SQ;
            if (r < N_SQ)  { transpose_item8(C.in[I_FN_WO], 1024, 1024, ws + WOF_T, 1024, 64.f, 0, scr, r, C.lane); continue; } r -= N_SQ;
            if (r < N_WIN) { transpose_item8(C.in[I_GM_WIN], 1024, 4096, ws + WIN_T, 1024, 64.f, 0, scr, r, C.lane, C.in[I_NORM_MIX] + 2 * 1024); continue; } r -= N_WIN;
            if (r < N_GWO) { transpose_item8(C.in[I_GM_WO], 2048, 1024, ws + WOG_T, 2048, 64.f, 0, scr, r, C.lane); continue; } r -= N_GWO;
            if (r < N_QKV) { transpose_item8(C.in[I_DL_WQKV], 1024, 4608, ws + WQKV_T, 1024, 64.f, 3, scr, r, C.lane, C.in[I_NORM_MIX] + 3 * 1024); continue; } r -= N_QKV;
            if (r < N_DWO) { transpose_item8(C.in[I_DL_WO], 512, 1024, ws + WOD_T, 512, 64.f, 0, scr, r, C.lane); continue; } r -= N_DWO;
            const int l = r / (N_SQ + N_PP); r -= l * (N_SQ + N_PP);
            if (r < N_SQ)  { transpose_item8(C.in[I_PLE_WGATE] + (size_t)l * 1024 * 1024, 1024, 1024, ws + WG_T + (size_t)l * 1024 * 1024, 1024, 64.f, 0, scr, r, C.lane); continue; } r -= N_SQ;
            transpose_item(C.in[I_PLE_WPROJ] + (size_t)l * 256 * 1024, 256, 1024, (bf16*)(ws + WP_T) + (size_t)l * 1024 * 256, 256, nullptr, 0, scr, r, C.lane);
        }
    }
    {
        const float* gain = C.in[I_NORM_MIX] + 1 * 1024; bf16* F = (bf16*)(ws + FCH_T);
        for (int i = gt; i < 4 * 512 * 256 / 2; i += NGT) {
            const int e = i * 2, k = e & 255, f = (e >> 8) & 511, g = e >> 17;
            float v[2];
#pragma unroll
            for (int j = 0; j < 2; ++j) { const int kk = k + j, ff = f & 255; const float x = (float)((ff * kk) & 255) * (1.0f / 256.0f);
                const float t = f < 256 ? __builtin_amdgcn_cosf(x) : -__builtin_amdgcn_sinf(x); v[j] = t * gain[g * 256 + kk]; }
            ((unsigned*)F)[i] = cvt_pk_bf16(v[0], v[1]);
        }
    }
    {
        bf16* W1 = (bf16*)(ws + FW1_T); bf16* W2 = (bf16*)(ws + FW2_T); float* twc = (float*)(ws + FTWC); float* tws = (float*)(ws + FTWS);
        for (int i = gt; i < 256 * 256; i += NGT) { const int col = i & 255, row = i >> 8, p = col >> 7, s1 = col & 127, pp = row >> 7, k1 = row & 127;
            const float x = (float)((s1 * k1) & 127) * (1.0f / 128.0f); const float cv = __builtin_amdgcn_cosf(x), sv = __builtin_amdgcn_sinf(x);
            const float v = (pp == p) ? cv : (pp == 0 ? sv : -sv); W1[i] = (bf16)(cvt_pk_bf16(v, 0.f) & 0xffffu); }
        for (int i = gt; i < 256 * 128; i += NGT) { const int col = i & 127, row = i >> 7, p = col >> 6, s2 = col & 63;
            float v = 0.f; if (row < 64) { const float x = (float)((s2 * row) & 63) * (1.0f / 64.0f); v = p == 0 ? __builtin_amdgcn_cosf(x) : __builtin_amdgcn_sinf(x); }
            W2[i] = (bf16)(cvt_pk_bf16(v, 0.f) & 0xffffu); }
        for (int i = gt; i < 128 * 64; i += NGT) { const int s2 = i & 63, k1 = i >> 6; const float x = (float)(s2 * k1) * (1.0f / 8192.0f); twc[i] = __builtin_amdgcn_cosf(x); tws[i] = __builtin_amdgcn_sinf(x); }
    }
    {
        float* ct = (float*)(ws + WS_COS); float* st = (float*)(ws + WS_SIN);
        for (int i = gt; i < SEQ * 32; i += NGT) { const int s = i >> 5, j = i & 31; const float inv = exp2f(-13.287712379549449f * ((float)(2 * j) / 64.0f)); const float ang = (float)s * inv;
            const double rv = (double)ang * 0.15915494309189535; const float fr = (float)(rv - floor(rv));
            ct[i] = __builtin_amdgcn_cosf(fr); st[i] = __builtin_amdgcn_sinf(fr); }
    }
    {
        u32x4* wp = (u32x4*)(ws + WS_WPERM);
        for (int i = gt; i < DEPTH * 32 * 64 * 6; i += NGT) {
            const int q = i % 6, l = (i / 6) & 63, st = (i / (6 * 64)) & 31, layer = i / (6 * 64 * 32);
            const int nb = q >> 1, part = q & 1, c = nb * 16 + (l & 15);
            float v[8];
#pragma unroll
            for (int j = 0; j < 8; ++j) { const int k = 32 * st + 8 * (l >> 4) + j; float w = 0.f;
                if (c < 4) w = C.in[I_MOE_WGRP][((size_t)layer * 1024 + k) * 4 + c]; else if (c < 36) w = C.in[I_MOE_WEXP][((size_t)layer * 1024 + k) * 32 + (c - 4)];
                w *= C.in[I_NORM_MOE][layer * 1024 + k];
                const float hi = bflo(cvt_pk_bf16(w, 0.f)); v[j] = part == 0 ? hi : w - hi; }
            wp[i] = (u32x4){cvt_pk_bf16(v[0], v[1]), cvt_pk_bf16(v[2], v[3]), cvt_pk_bf16(v[4], v[5]), cvt_pk_bf16(v[6], v[7])};
        }
    }
    {
        const f32x4* p = (const f32x4*)C.in[I_P]; u32x2* pb = (u32x2*)(ws + WS_PB);
        static_assert((DEPTH * NTOK * 256 / 4) % (8 * 256 * NTHR) == 0, "p conversion batches");
        for (int i = gt; i < DEPTH * NTOK * 256 / 4; i += 8 * NGT) {
            f32x4 v[8];
#pragma unroll
            for (int k = 0; k < 8; ++k) v[k] = p[i + k * NGT];
#pragma unroll
            for (int k = 0; k < 8; ++k) pb[i + k * NGT] = pack4(v[k]); }
    }
    {
        const float* x = C.in[I_X]; bf16* HB = (bf16*)(ws + WS_HB); float* SSQ = (float*)(ws + WS_SSQ);
        for (int r0 = gw; r0 < NTOK; r0 += 4 * NGW) {
            f32x4 xv[4][4];
#pragma unroll
            for (int q = 0; q < 4; ++q) { const f32x4* xr = (const f32x4*)(x + (size_t)(r0 + q * NGW) * DM) + C.lane;
#pragma unroll
                for (int j = 0; j < 4; ++j) xv[q][j] = xr[64 * j]; }
#pragma unroll
            for (int q = 0; q < 4; ++q) { const int r = r0 + q * NGW; u32x2* br = (u32x2*)(HB + (size_t)r * DM) + C.lane;
                float s = 0.f;
#pragma unroll
                for (int j = 0; j < 4; ++j) { const u32x2 w = pack4(xv[q][j]); br[64 * j] = w; s += sumsq4(unpack4(w)); }
                s = wave_sum(s);
                if (C.lane < 16) SSQ[(size_t)r * 16 + C.lane] = C.lane == 0 ? s : 0.f; }
        }
    }
    moe_weight_prep(C, 0, 0, C.G == 256 ? 8192 : (1 << 30));
}

__device__ __forceinline__ float rstd_from_slots16(const float* SSQ, int row) {
    const f32x4* p = (const f32x4*)(SSQ + (size_t)row * 16); const f32x4 a = p[0], b = p[1], c = p[2], d = p[3];
    const float s = ((a[0] + a[1]) + (a[2] + a[3])) + ((b[0] + b[1]) + (b[2] + b[3])) + ((c[0] + c[1]) + (c[2] + c[3])) + ((d[0] + d[1]) + (d[2] + d[3]));
    return __builtin_amdgcn_rsqf(s * (1.0f / 1024.0f) + EPS);
}
__device__ __forceinline__ float rstd_from_slots8(const float* S8, int row, float invn) {
    const f32x4* p = (const f32x4*)(S8 + (size_t)row * 8); const f32x4 a = p[0], b = p[1];
    const float s = ((a[0] + a[1]) + (a[2] + a[3])) + ((b[0] + b[1]) + (b[2] + b[3]));
    return __builtin_amdgcn_rsqf(s * invn + EPS);
}
__device__ __forceinline__ f32x4 slots16_raw(const float* SSQ, int row, int fq) { return ((const f32x4*)(SSQ + (size_t)row * 16))[fq]; }
__device__ __forceinline__ float slots16_finish(float s) { s += __shfl_xor(s, 16); s += __shfl_xor(s, 32); return __builtin_amdgcn_rsqf(s * (1.0f / 1024.0f) + EPS); }
__device__ __forceinline__ f32x4 slots8_raw(const float* S8, int row, int fq) { return ((const f32x4*)(S8 + (size_t)row * 8))[fq & 1]; }
__device__ __forceinline__ float slots8_finish(float s, float invn) { s += __shfl_xor(s, 16); return __builtin_amdgcn_rsqf(s * invn + EPS); }
__device__ __forceinline__ void rope4(f32x4& v0, f32x4& v1, const float* ct, const float* st, int pos, int j0) {
    const f32x4 c = *(const f32x4*)(ct + pos * 32 + j0), s = *(const f32x4*)(st + pos * 32 + j0);
    const f32x4 a = v0 * c - v1 * s, b = v1 * c + v0 * s; v0 = a; v1 = b;
}

typedef f32x4 Acc[2][2][4][2];
using pg8::Unit;

#define WIDE_COL(fq) (16 * ((fq) & 1) + 8 * ((fq) >> 1))
__device__ __forceinline__ u32x4 widen_bf16(u32x2 p0, u32x2 p1) { auto a = __builtin_amdgcn_permlane16_swap(p0.x, p1.x, false, false); auto b = __builtin_amdgcn_permlane16_swap(p0.y, p1.y, false, false); return (u32x4){a[0], b[0], a[1], b[1]}; }
__device__ __forceinline__ u32x2 widen_f8(unsigned w0, unsigned w1) { auto a = __builtin_amdgcn_permlane16_swap(w0, w1, false, false); return (u32x2){a[0], a[1]}; }
struct EpiStoreBf16 {
    bf16* O; int ldc; float scale; size_t bstride;
    __device__ __forceinline__ void operator()(const Acc& acc, const Unit& u, int wr, int wc, int fr, int fq) const {
        bf16* base = O + (size_t)u.aux * bstride;
        EPI_LOOP_BEGIN
            bf16* rp = base + (size_t)(u.pm * 256 + rowt) * ldc + u.pn * 256 + wc * 32 + WIDE_COL(fq);
#pragma unroll
            for (int bj = 0; bj < 2; ++bj) *(u32x4*)(rp + bj * 128) = widen_bf16(pack4(acc[ai][bj][m][0] * scale), pack4(acc[ai][bj][m][1] * scale));
        EPI_LOOP_END
    }
};
struct EpiResidual {
    bf16* H; const float* bias; float scale, bsc;
    __device__ __forceinline__ void operator()(const Acc& acc, const Unit& u, int wr, int wc, int fr, int fq) const {
        const int colw = u.pn * 256 + wc * 32 + 16 * (fq & 1) + 8 * (fq >> 1);
        f32x4 bw[2][2] = {};
        if (bias) {
#pragma unroll
            for (int bj = 0; bj < 2; ++bj) { bw[bj][0] = *(const f32x4*)(bias + colw + bj * 128) * bsc; bw[bj][1] = *(const f32x4*)(bias + colw + bj * 128 + 4) * bsc; } }
#pragma unroll
        for (int ai = 0; ai < 2; ++ai) {
            u32x4 hv[4][2];
#pragma unroll
            for (int m = 0; m < 4; ++m) { const bf16* rp = H + (size_t)(u.pm * 256 + ai * 128 + wr * 64 + m * 16 + fr) * DM + colw;
#pragma unroll
                for (int bj = 0; bj < 2; ++bj) hv[m][bj] = *(const u32x4*)(rp + bj * 128); }
#pragma unroll
            for (int m = 0; m < 4; ++m) { bf16* rp = H + (size_t)(u.pm * 256 + ai * 128 + wr * 64 + m * 16 + fr) * DM + colw;
#pragma unroll
                for (int bj = 0; bj < 2; ++bj) { f32x4 a0 = acc[ai][bj][m][0] * scale, a1 = acc[ai][bj][m][1] * scale;
#pragma unroll
                    for (int i = 0; i < 4; ++i) { auto sw_ = __builtin_amdgcn_permlane16_swap(__float_as_uint(a0[i]), __float_as_uint(a1[i]), false, false); a0[i] = __uint_as_float(sw_[0]); a1[i] = __uint_as_float(sw_[1]); }
                    const u32x4 hw = hv[m][bj];
                    const f32x4 v0 = unpack4((u32x2){hw.x, hw.y}) + a0 + bw[bj][0], v1 = unpack4((u32x2){hw.z, hw.w}) + a1 + bw[bj][1];
                    const u32x2 p0 = pack4(v0), p1 = pack4(v1); *(u32x4*)(rp + bj * 128) = (u32x4){p0.x, p0.y, p1.x, p1.y}; } }
        }
    }
};
struct EpiMlaA {
    const float* SSQ; bf16* CQ; bf16* CKV; bf16* KR; float* SSQQ; float* SSQKV; const float* ct; const float* st;
    __device__ __forceinline__ void operator()(const Acc& acc, const Unit& u, int wr, int wc, int fr, int fq) const {
        float rsv_[2][4]; f32x4 raw_[2][4];
#pragma unroll
        for (int ai = 0; ai < 2; ++ai)
#pragma unroll
            for (int m = 0; m < 4; ++m) { const int row = u.pm * 256 + ai * 128 + wr * 64 + m * 16 + fr; raw_[ai][m] = slots16_raw(SSQ, row, fq); }
        asm volatile("" ::: "memory");
#pragma unroll
        for (int ai = 0; ai < 2; ++ai)
#pragma unroll
            for (int m = 0; m < 4; ++m) rsv_[ai][m] = slots16_finish((raw_[ai][m][0] + raw_[ai][m][1]) + (raw_[ai][m][2] + raw_[ai][m][3]));
        EPI_LOOP_BEGIN
            const int row = u.pm * 256 + rowt; const float rs = rsv_[ai][m];
            float sq = 0.f, skv = 0.f;
#pragma unroll
            for (int bj = 0; bj < 2; ++bj) {
                f32x4 v0 = acc[ai][bj][m][0] * rs, v1 = acc[ai][bj][m][1] * rs; const int col = u.pn * 256 + bj * 128 + wc * 32 + 4 * fq;
                const int seg = u.pn * 2 + bj;
                if (seg < 3) { sq += sumsq4(v0) + sumsq4(v1); bf16* p = CQ + (size_t)row * 384 + (col - 4 * fq + WIDE_COL(fq)); *(u32x4*)p = widen_bf16(pack4(v0), pack4(v1)); }
                else if (seg < 5) { skv += sumsq4(v0) + sumsq4(v1); bf16* p = CKV + (size_t)row * 256 + (col - 384 - 4 * fq + WIDE_COL(fq)); *(u32x4*)p = widen_bf16(pack4(v0), pack4(v1)); }
                else if (wc < 2) { rope4(v0, v1, ct, st, row & (SEQ - 1), wc * 16 + 4 * fq); unsigned char* p = (unsigned char*)KR + (size_t)row * 64 + wc * 32 + WIDE_COL(fq); v0 *= K8_SCALE; v1 *= K8_SCALE;
                    *(u32x2*)p = widen_f8(pk_fp8x4(v0[0], v0[1], v0[2], v0[3]), pk_fp8x4(v1[0], v1[1], v1[2], v1[3])); }
            }
            sq += __shfl_xor(sq, 16); sq += __shfl_xor(sq, 32); skv += __shfl_xor(skv, 16); skv += __shfl_xor(skv, 32);
            if (fq == 0) {
                if (u.pn == 0) SSQQ[(size_t)row * 8 + wc] = sq;
                else if (u.pn == 1) { SSQQ[(size_t)row * 8 + 4 + wc] = sq; SSQKV[(size_t)row * 8 + wc] = skv; }
                else SSQKV[(size_t)row * 8 + 4 + wc] = skv;
            }
        EPI_LOOP_END
    }
};
struct EpiMlaQ {
    const float* SSQQ; bf16* Q; const float* ct; const float* st;
    __device__ __forceinline__ void operator()(const Acc& acc, const Unit& u, int wr, int wc, int fr, int fq) const {
        float rsv_[2][4]; f32x4 raw_[2][4];
#pragma unroll
        for (int ai = 0; ai < 2; ++ai)
#pragma unroll
            for (int m = 0; m < 4; ++m) { const int row = u.pm * 256 + ai * 128 + wr * 64 + m * 16 + fr; raw_[ai][m] = slots8_raw(SSQQ, row, fq); }
        asm volatile("" ::: "memory");
#pragma unroll
        for (int ai = 0; ai < 2; ++ai)
#pragma unroll
            for (int m = 0; m < 4; ++m) rsv_[ai][m] = slots8_finish((raw_[ai][m][0] + raw_[ai][m][1]) + (raw_[ai][m][2] + raw_[ai][m][3]), 1.0f / 384.0f);
        EPI_LOOP_BEGIN
            const int row = u.pm * 256 + rowt; const float rs = rsv_[ai][m];
#pragma unroll
            for (int bj = 0; bj < 2; ++bj) {
                f32x4 v0 = acc[ai][bj][m][0] * rs, v1 = acc[ai][bj][m][1] * rs; const int g32 = u.pn * 8 + bj * 4 + wc, gi = g32 % 6;
                if (gi >= 4) rope4(v0, v1, ct, st, row & (SEQ - 1), (gi - 4) * 16 + 4 * fq);
                unsigned char* p = (unsigned char*)Q + (size_t)row * 1536 + g32 * 32 + WIDE_COL(fq); v0 *= Q8_SCALE; v1 *= Q8_SCALE;
                *(u32x2*)p = widen_f8(pk_fp8x4(v0[0], v0[1], v0[2], v0[3]), pk_fp8x4(v1[0], v1[1], v1[2], v1[3]));
            }
        EPI_LOOP_END
    }
};
struct MlaKnSched { const bf16* A; const bf16* W; int K, ldb, G, c;
    __device__ __forceinline__ bool next(int i, Unit& u) const { const int L = i * G + c; if (L >= 512) return false;
        u.pn = L & 3; u.pm = L >> 2; u.aux = 0; u.a = (const char*)(A + (size_t)u.pm * 256 * 256); u.b = (const char*)(W + (size_t)(2 * u.pn) * 256 * 256); return true; }
    __device__ __forceinline__ unsigned aoff(const Unit&, int half, int R, int Cc) const { return (unsigned)((R + 128 * half) * 256 + Cc) * 2u; }
    __device__ __forceinline__ unsigned boff(int R, int Cc) const { return (unsigned)(R * 256 + Cc) * 2u; }
    __device__ __forceinline__ size_t hstepB() const { return (size_t)256 * 256 * 2; } };
struct EpiMlaKN {
    const float* SSQKV; unsigned char* KN;
    __device__ __forceinline__ void operator()(const Acc& acc, const Unit& u, int wr, int wc, int fr, int fq) const {
        float rsv_[2][4]; f32x4 raw_[2][4];
#pragma unroll
        for (int ai = 0; ai < 2; ++ai)
#pragma unroll
            for (int m = 0; m < 4; ++m) { const int row = u.pm * 256 + ai * 128 + wr * 64 + m * 16 + fr; raw_[ai][m] = slots8_raw(SSQKV, row, fq); }
        asm volatile("" ::: "memory");
#pragma unroll
        for (int ai = 0; ai < 2; ++ai)
#pragma unroll
            for (int m = 0; m < 4; ++m) rsv_[ai][m] = slots8_finish((raw_[ai][m][0] + raw_[ai][m][1]) + (raw_[ai][m][2] + raw_[ai][m][3]), 1.0f / 256.0f) * K8_SCALE;
        EPI_LOOP_BEGIN
            const int row = u.pm * 256 + rowt; const float rs = rsv_[ai][m];
            unsigned char* rp = KN + (size_t)row * 1024 + (2 * u.pn) * 128 + wc * 32 + WIDE_COL(fq);
#pragma unroll
            for (int bj = 0; bj < 2; ++bj) { const f32x4 v0 = acc[ai][bj][m][0] * rs, v1 = acc[ai][bj][m][1] * rs;
                *(u32x2*)(rp + bj * 128) = widen_f8(pk_fp8x4(v0[0], v0[1], v0[2], v0[3]), pk_fp8x4(v1[0], v1[1], v1[2], v1[3])); }
        EPI_LOOP_END
    }
};
struct MlaVtSched { const bf16* W; const bf16* Bm; int K, ldb, G, c;
    __device__ __forceinline__ bool next(int i, Unit& u) const { const int L = i * G + c; if (L >= 512) return false;
        u.pn = L >> 2; u.pm = L & 3; u.aux = 0; u.a = (const char*)(W + ((size_t)(2 * u.pm) * 256 + 128) * 256); u.b = (const char*)(Bm + (size_t)u.pn * 256 * 256); return true; }
    __device__ __forceinline__ unsigned aoff(const Unit&, int half, int R, int Cc) const { return (unsigned)((R + 256 * half) * 256 + Cc) * 2u; }
    __device__ __forceinline__ unsigned boff(int R, int Cc) const { return (unsigned)(R * 256 + Cc) * 2u; }
    __device__ __forceinline__ size_t hstepB() const { return (size_t)128 * 256 * 2; } };
struct EpiMlaVT {
    const float* SSQKV; unsigned char* VT;
    __device__ __forceinline__ void operator()(const Acc& acc, const Unit& u, int wr, int wc, int fr, int fq) const {
        f32x4 rs[2][2];
#pragma unroll
        for (int bj = 0; bj < 2; ++bj)
#pragma unroll
            for (int n = 0; n < 2; ++n)
#pragma unroll
                for (int i = 0; i < 4; ++i) rs[bj][n][i] = rstd_from_slots8(SSQKV, u.pn * 256 + bj * 128 + wc * 32 + n * 16 + 4 * fq + i, 1.0f / 256.0f) * ATT8_SCALE;
        const int tok0 = u.pn * 256 + wc * 32 + 4 * fq, b = tok0 >> 13, s0 = tok0 & (SEQ - 1);
        EPI_LOOP_BEGIN
            const int head = 2 * u.pm + ai, d = wr * 64 + m * 16 + fr;
            unsigned char* rp = VT + ((size_t)(b * 8 + head) * 128 + d) * SEQ + (s0 - 4 * fq + WIDE_COL(fq));
#pragma unroll
            for (int bj = 0; bj < 2; ++bj) { const f32x4 v0 = acc[ai][bj][m][0] * rs[bj][0], v1 = acc[ai][bj][m][1] * rs[bj][1];
                *(u32x2*)(rp + bj * 128) = widen_f8(pk_fp8x4(v0[0], v0[1], v0[2], v0[3]), pk_fp8x4(v1[0], v1[1], v1[2], v1[3])); }
        EPI_LOOP_END
    }
};
struct FnetTSched { const bf16* Fch; const bf16* HB; int K, ldb, G, c;
    __device__ __forceinline__ bool next(int i, Unit& u) const { const int L = i * G + c; if (L >= 1024) return false;
        const int pn = L & 31, pm = (L >> 5) & 1, g = (L >> 6) & 3, b = L >> 8; u.pm = pm; u.pn = pn; u.aux = b * 4 + g;
        u.a = (const char*)(Fch + (size_t)(g * 512 + pm * 256) * 256); u.b = (const char*)(HB + ((size_t)(b * SEQ + pn * 2)) * 1024 + g * 256); return true; }
    __device__ __forceinline__ unsigned aoff(const Unit&, int half, int R, int Cc) const { return (unsigned)((R + 128 * half) * 256 + Cc) * 2u; }
    __device__ __forceinline__ unsigned boff(int R, int Cc) const { return (unsigned)(R * 64 * 1024 + Cc) * 2u; }
    __device__ __forceinline__ size_t hstepB() const { return (size_t)1024 * 2; } };
struct EpiFnetT {
    const float* SSQ; bf16* TT;
    __device__ __forceinline__ void operator()(const Acc& acc, const Unit& u, int wr, int wc, int fr, int fq) const {
        const int b = u.aux >> 2, g = u.aux & 3;
        f32x4 rs[2][2];
#pragma unroll
        for (int bj = 0; bj < 2; ++bj)
#pragma unroll
            for (int n = 0; n < 2; ++n)
#pragma unroll
                for (int i = 0; i < 4; ++i) rs[bj][n][i] = rstd_from_slots16(SSQ, b * SEQ + (wc * 32 + n * 16 + 4 * fq + i) * 64 + u.pn * 2 + bj);
        EPI_LOOP_BEGIN
            const int f = u.pm * 256 + rowt, part = f >> 8, j = f & 255;
#pragma unroll
            for (int bj = 0; bj < 2; ++bj) {
                bf16* rp = TT + (((size_t)(b * 1024 + g * 256 + j) * 64 + u.pn * 2 + bj) * 2 + part) * 128 + wc * 32 + WIDE_COL(fq);
                *(u32x4*)rp = widen_bf16(pack4(acc[ai][bj][m][0] * rs[bj][0]), pack4(acc[ai][bj][m][1] * rs[bj][1])); }
        EPI_LOOP_END
    }
};
struct FnetConstASched { const bf16* W; const bf16* Bm; int K, ldb, nunits, G, c;
    __device__ __forceinline__ bool next(int i, Unit& u) const { const int L = i * G + c; if (L >= nunits) return false;
        u.pm = 0; u.pn = L; u.aux = 0; u.a = (const char*)W; u.b = (const char*)(Bm + (size_t)L * 256 * ldb); return true; }
    __device__ __forceinline__ unsigned aoff(const Unit&, int half, int R, int Cc) const { return (unsigned)((R + 128 * half) * K + Cc) * 2u; }
    __device__ __forceinline__ unsigned boff(int R, int Cc) const { return (unsigned)(R * ldb + Cc) * 2u; }
    __device__ __forceinline__ size_t hstepB() const { return (size_t)128 * ldb * 2; } };
struct EpiFnet1 {
    bf16* Z; const float* twc; const float* tws;
    __device__ __forceinline__ void operator()(const Acc& acc, const Unit& u, int wr, int wc, int fr, int fq) const {
        f32x4 tc_[4][2], tn_[4][2];
#pragma unroll
        for (int m = 0; m < 4; ++m)
#pragma unroll
            for (int n = 0; n < 2; ++n) { const int k1 = wr * 64 + m * 16 + fr, s2 = (wc * 32 + n * 16 + 4 * fq) & 63; tc_[m][n] = *(const f32x4*)(twc + k1 * 64 + s2); tn_[m][n] = *(const f32x4*)(tws + k1 * 64 + s2); }
#pragma unroll
        for (int m = 0; m < 4; ++m) { const int k1 = wr * 64 + m * 16 + fr;
#pragma unroll
            for (int bj = 0; bj < 2; ++bj)
            { u32x2 pr_[2], pi_[2];
#pragma unroll
                for (int n = 0; n < 2; ++n) {
                    const f32x4 cs = tc_[m][n], sn = tn_[m][n];
                    const f32x4 zr = acc[0][bj][m][n], zi = acc[1][bj][m][n];
                    pr_[n] = pack4(zr * cs + zi * sn); pi_[n] = pack4(zi * cs - zr * sn); }
                const int nrow = u.pn * 256 + bj * 128 + wc * 32 + WIDE_COL(fq), s2 = nrow & 63, c = (nrow >> 6) & 1023, b = nrow >> 16;
                bf16* p = Z + ((((size_t)(b * 128 + k1) * 1024 + c) * 2) * 64) + s2;
                *(u32x4*)p = widen_bf16(pr_[0], pr_[1]); *(u32x4*)(p + 64) = widen_bf16(pi_[0], pi_[1]); }
        }
    }
};
struct EpiFnet2 {
    unsigned char* F; float scale;
    __device__ __forceinline__ void operator()(const Acc& acc, const Unit& u, int wr, int wc, int fr, int fq) const {
        if (wr != 0) return;
#pragma unroll
        for (int m = 0; m < 4; ++m) { const int k2 = m * 16 + fr;
#pragma unroll
            for (int bj = 0; bj < 2; ++bj)
            { const int nrow = u.pn * 256 + bj * 128 + wc * 32 + WIDE_COL(fq), c = nrow & 1023, k1 = (nrow >> 10) & 127, b = nrow >> 17;
                const f32x4 v0 = acc[0][bj][m][0] * scale, v1 = acc[0][bj][m][1] * scale;
                *(u32x2*)(F + ((size_t)b * SEQ + k1 + 128 * k2) * 1024 + c) = widen_f8(pk_fp8x4(v0[0], v0[1], v0[2], v0[3]), pk_fp8x4(v1[0], v1[1], v1[2], v1[3])); }
        }
    }
};
__device__ __forceinline__ float gelu_tanh(float x) {
    const float u = x * (0.7978845608028654f + 0.035677408136300125f * x * x);
    return x * fast_rcp(1.0f + fast_exp2(-2.8853900817779268f * u));
}
struct EpiGmlpIn {
    const float* SSQ; bf16* U; bf16* V; float* SSQV; float sc;
    __device__ __forceinline__ void operator()(const Acc& acc, const Unit& u, int wr, int wc, int fr, int fq) const {
        const bool isv = u.pn >= 8; bf16* O = isv ? V : U; const int colt = (isv ? u.pn - 8 : u.pn) * 256 + wc * 32 + 4 * fq;
        float rsv_[2][4]; f32x4 raw_[2][4];
#pragma unroll
        for (int ai = 0; ai < 2; ++ai)
#pragma unroll
            for (int m = 0; m < 4; ++m) { const int row = u.pm * 256 + ai * 128 + wr * 64 + m * 16 + fr; raw_[ai][m] = slots16_raw(SSQ, row, fq); }
        asm volatile("" ::: "memory");
#pragma unroll
        for (int ai = 0; ai < 2; ++ai)
#pragma unroll
            for (int m = 0; m < 4; ++m) rsv_[ai][m] = slots16_finish((raw_[ai][m][0] + raw_[ai][m][1]) + (raw_[ai][m][2] + raw_[ai][m][3])) * sc;
        EPI_LOOP_BEGIN
            const int row = u.pm * 256 + rowt; const float rs = rsv_[ai][m]; float sv = 0.f;
            bf16* rp = O + (size_t)row * 2048 + (colt - 4 * fq + WIDE_COL(fq));
#pragma unroll
            for (int bj = 0; bj < 2; ++bj) { u32x2 pk_[2];
#pragma unroll
                for (int n = 0; n < 2; ++n) { f32x4 v = acc[ai][bj][m][n] * rs;
#pragma unroll
                    for (int i = 0; i < 4; ++i) v[i] = gelu_tanh(v[i]);
                    sv += sumsq4(v); pk_[n] = pack4(v); }
                *(u32x4*)(rp + bj * 128) = widen_bf16(pk_[0], pk_[1]); }
            if (isv) { sv += __shfl_xor(sv, 16); sv += __shfl_xor(sv, 32); if (fq == 0) SSQV[(size_t)row * 32 + (u.pn - 8) * 4 + wc] = sv; }
        EPI_LOOP_END
    }
};
struct EpiDilQkv {
    const float* SSQ; bf16* QKV; const float* ct; const float* st; float sc;
    __device__ __forceinline__ void operator()(const Acc& acc, const Unit& u, int wr, int wc, int fr, int fq) const {
        float rsv_[2][4]; f32x4 raw_[2][4];
#pragma unroll
        for (int ai = 0; ai < 2; ++ai)
#pragma unroll
            for (int m = 0; m < 4; ++m) { const int row = u.pm * 256 + ai * 128 + wr * 64 + m * 16 + fr; raw_[ai][m] = slots16_raw(SSQ, row, fq); }
        asm volatile("" ::: "memory");
#pragma unroll
        for (int ai = 0; ai < 2; ++ai)
#pragma unroll
            for (int m = 0; m < 4; ++m) rsv_[ai][m] = slots16_finish((raw_[ai][m][0] + raw_[ai][m][1]) + (raw_[ai][m][2] + raw_[ai][m][3])) * sc;
        const int tq = (u.pn >> 1) % 3;
        f32x4 rc_[2][4], rn_[2][4];
        if (tq < 2) {
#pragma unroll
            for (int ai = 0; ai < 2; ++ai)
#pragma unroll
                for (int m = 0; m < 4; ++m) { const int pos = (u.pm * 256 + ai * 128 + wr * 64 + m * 16 + fr) & (SEQ - 1), j0 = (wc & 1) * 16 + 4 * fq; rc_[ai][m] = *(const f32x4*)(ct + pos * 32 + j0); rn_[ai][m] = *(const f32x4*)(st + pos * 32 + j0); }
        }
        EPI_LOOP_BEGIN
            const int row = u.pm * 256 + rowt; const float rs = rsv_[ai][m];
#pragma unroll
            for (int bj = 0; bj < 2; ++bj) {
                f32x4 v0 = acc[ai][bj][m][0] * rs, v1 = acc[ai][bj][m][1] * rs; const int g32 = u.pn * 8 + bj * 4 + wc;
                if (tq < 2) { const f32x4 a_ = v0 * rc_[ai][m] - v1 * rn_[ai][m], b_ = v1 * rc_[ai][m] + v0 * rn_[ai][m]; v0 = a_; v1 = b_; if (tq == 0) { v0 *= 0.125f; v1 *= 0.125f; } }
                bf16* p = QKV + (size_t)row * 4608 + g32 * 32 + WIDE_COL(fq); *(u32x4*)p = widen_bf16(pack4(v0), pack4(v1));
            }
        EPI_LOOP_END
    }
};
struct EpiPle {
    bf16* H; const bf16* PP; float* SSQ; float scale; unsigned char* H8; float asc;
    __device__ __forceinline__ void operator()(const Acc& acc, const Unit& u, int wr, int wc, int fr, int fq) const {
        const int colw = u.pn * 256 + wc * 32 + 16 * (fq & 1) + 8 * (fq >> 1);
#pragma unroll
        for (int ai = 0; ai < 2; ++ai) {
            u32x4 hv[4][2], pv[4][2];
#pragma unroll
            for (int m = 0; m < 4; ++m) { const size_t ro = (size_t)(u.pm * 256 + ai * 128 + wr * 64 + m * 16 + fr) * DM + colw;
#pragma unroll
                for (int bj = 0; bj < 2; ++bj) { hv[m][bj] = *(const u32x4*)(H + ro + bj * 128); pv[m][bj] = *(const u32x4*)(PP + ro + bj * 128); } }
#pragma unroll
            for (int m = 0; m < 4; ++m) { const int row = u.pm * 256 + ai * 128 + wr * 64 + m * 16 + fr; float ss = 0.f;
#pragma unroll
                for (int bj = 0; bj < 2; ++bj) {
                    const size_t o = (size_t)row * DM + colw + bj * 128; f32x4 a0 = acc[ai][bj][m][0], a1 = acc[ai][bj][m][1];
#pragma unroll
                    for (int i = 0; i < 4; ++i) { auto sw_ = __builtin_amdgcn_permlane16_swap(__float_as_uint(a0[i]), __float_as_uint(a1[i]), false, false); a0[i] = __uint_as_float(sw_[0]); a1[i] = __uint_as_float(sw_[1]); }
                    const u32x4 hq = hv[m][bj], pq = pv[m][bj];
                    const f32x4 p0 = unpack4((u32x2){pq.x, pq.y}), p1 = unpack4((u32x2){pq.z, pq.w}); f32x4 h0 = unpack4((u32x2){hq.x, hq.y}), h1 = unpack4((u32x2){hq.z, hq.w});
#pragma unroll
                    for (int i = 0; i < 4; ++i) { h0[i] += scale * p0[i] * fast_rcp(1.0f + fast_exp2(asc * a0[i])); h1[i] += scale * p1[i] * fast_rcp(1.0f + fast_exp2(asc * a1[i])); }
                    const u32x2 w0 = pack4(h0), w1 = pack4(h1); *(u32x4*)(H + o) = (u32x4){w0.x, w0.y, w1.x, w1.y}; ss += sumsq4(unpack4(w0)) + sumsq4(unpack4(w1));
                    if (H8) *(u32x2*)(H8 + o) = (u32x2){pk_fp8x4(h0[0] * XN8_SCALE, h0[1] * XN8_SCALE, h0[2] * XN8_SCALE, h0[3] * XN8_SCALE), pk_fp8x4(h1[0] * XN8_SCALE, h1[1] * XN8_SCALE, h1[2] * XN8_SCALE, h1[3] * XN8_SCALE)};
                }
                ss += __shfl_xor(ss, 16); ss += __shfl_xor(ss, 32);
                if (fq == 0) SSQ[(size_t)row * 16 + u.pn * 4 + wc] = ss; }
        }
    }
};

__device__ __forceinline__ void moe_tables(const Ctx& C, int layer) {
    LAS int* T = (LAS int*)(C.lds + LDS_TAB);
    if (C.tid < 32) T[C.tid] = (int)__hip_atomic_load((unsigned*)(C.ws + WS_CTL) + CW_CNT + layer * 32 + C.tid, __ATOMIC_RELAXED, __HIP_MEMORY_SCOPE_AGENT);
    __syncthreads();
    if (C.tid == 0) { int s = 0; for (int e = 0; e < 32; ++e) { T[32 + e] = s; s += (T[e] + 255) >> 8; } T[64] = s; }
    __syncthreads();
    for (int tile = C.tid; tile < T[64]; tile += NTHR) { int e = 0;
#pragma unroll
        for (int j = 16; j >= 1; j >>= 1) if (e + j < 32 && T[32 + e + j] <= tile) e += j;
        T[80 + tile] = e; }
    __syncthreads();
}
struct MoeSched1 {
    const unsigned char* XN; const unsigned char* W1; const u32x2* LIST; const LAS int* T; int K, ldb, G, c;
    __device__ __forceinline__ bool next(int i, Unit& u) const {
        const int L = i * G + c, ntile = __builtin_amdgcn_readfirstlane(T[64]); if (L >= ntile * 4) return false;
        const int tile = L >> 2; u.pn = L & 3; int e = T[80 + tile];
        e = __builtin_amdgcn_readfirstlane(e); const int t0 = __builtin_amdgcn_readfirstlane(T[32 + e]);
        u.aux = e; u.pm = tile - t0; u.a = (const char*)XN; u.b = (const char*)(W1 + (size_t)e * 1024 * 1024 + (size_t)u.pn * 256 * 1024); return true;
    }
    __device__ __forceinline__ unsigned aoff(const Unit& u, int half, int R, int C) const {
        const int r = u.pm * 256 + R + 128 * half; unsigned tok = 0; if (r < T[u.aux]) tok = LIST[(size_t)u.aux * MOE_CAP + r].x >> 1;
        return tok * 1024u + 2u * (unsigned)C;
    }
    __device__ __forceinline__ unsigned boff(int R, int C) const { return (unsigned)(R * 1024 + 2 * C); }
    __device__ __forceinline__ size_t hstepB() const { return (size_t)128 * 1024; }
};
struct EpiMoe1 {
    unsigned char* HBUF; const LAS int* T;
    __device__ __forceinline__ void operator()(const Acc& acc, const Unit& u, int wr, int wc, int fr, int fq) const {
        unsigned char* base = HBUF + (size_t)__builtin_amdgcn_readfirstlane(T[32 + u.aux] + u.pm) * (256 * 512) + 128 * u.pn; constexpr float sc = 1.0f / (XN8_SCALE * W8_SCALE);
        const unsigned lo = (unsigned)(32 * wc + 8 * fq);
        EPI_LOOP_BEGIN
            unsigned w[2];
#pragma unroll
            for (int bj = 0; bj < 2; ++bj) { const f32x4 g = acc[ai][bj][m][0] * sc, up = acc[ai][bj][m][1] * (sc * HB8_SCALE); f32x4 h;
#pragma unroll
                for (int i = 0; i < 4; ++i) h[i] = g[i] * fast_rcp(1.0f + fast_exp2(-1.4426950408889634f * g[i])) * up[i];
                w[bj] = pk_fp8x4(h[0], h[1], h[2], h[3]); }
            *(u32x2*)(base + ((unsigned)rowt * 512u + lo)) = (u32x2){w[0], w[1]};
        EPI_LOOP_END
    }
};
struct MoeSched2 {
    const unsigned char* HBUF; const unsigned char* W2; const LAS int* T; int K, ldb, G, c;
    __device__ __forceinline__ bool next(int i, Unit& u) const {
        const int L = i * G + c, ntile = __builtin_amdgcn_readfirstlane(T[64]); if (L >= ntile * 4) return false;
        const int tile = L >> 2; u.pn = L & 3; int e = T[80 + tile];
        e = __builtin_amdgcn_readfirstlane(e); const int t0 = __builtin_amdgcn_readfirstlane(T[32 + e]);
        u.aux = e; u.pm = tile - t0; u.a = (const char*)(HBUF + (size_t)tile * 256 * 512); u.b = (const char*)(W2 + (size_t)e * 1024 * 512 + (size_t)u.pn * 256 * 512); return true;
    }
    __device__ __forceinline__ unsigned aoff(const Unit&, int half, int R, int C) const { return (unsigned)((R + 128 * half) * 512 + 2 * C); }
    __device__ __forceinline__ unsigned boff(int R, int C) const { return (unsigned)(R * 512 + 2 * C); }
    __device__ __forceinline__ size_t hstepB() const { return (size_t)128 * 512; }
};
struct EpiMoe2 {
    bf16* YB; const u32x2* LIST; const LAS int* T;
    __device__ __forceinline__ void operator()(const Acc& acc, const Unit& u, int wr, int wc, int fr, int fq) const {
        const int cnt = T[u.aux];
        u32x2 ents[2][4];
#pragma unroll
        for (int ai = 0; ai < 2; ++ai)
#pragma unroll
            for (int m = 0; m < 4; ++m) { const int r = u.pm * 256 + ai * 128 + wr * 64 + m * 16 + fr; ents[ai][m] = LIST[(size_t)u.aux * MOE_CAP + (r < cnt ? r : 0)]; }
        const bool upper = fq >= 2;
#pragma unroll
        for (int ai = 0; ai < 2; ++ai)
#pragma unroll
            for (int mp = 0; mp < 4; mp += 2) {
                u32x2 wq[2][2];
#pragma unroll
                for (int q = 0; q < 2; ++q) { const float w = __uint_as_float(ents[ai][mp + q].y) * (YB8_SCALE / (HB8_SCALE * W8_SCALE));
#pragma unroll
                    for (int bj = 0; bj < 2; ++bj) { const f32x4 a0 = acc[ai][bj][mp + q][0] * w, a1 = acc[ai][bj][mp + q][1] * w; wq[q][bj] = widen_f8(pk_fp8x4(a0[0], a0[1], a0[2], a0[3]), pk_fp8x4(a1[0], a1[1], a1[2], a1[3])); } }
                const int rsel = u.pm * 256 + ai * 128 + wr * 64 + (mp + (upper ? 1 : 0)) * 16 + fr;
                const unsigned tokslot = upper ? ents[ai][mp + 1].x : ents[ai][mp].x;
                unsigned char* rp = (unsigned char*)YB + (size_t)tokslot * 1024 + u.pn * 256 + wc * 32 + 16 * (fq & 1);
#pragma unroll
                for (int bj = 0; bj < 2; ++bj) {
                    auto sx = __builtin_amdgcn_permlane32_swap(wq[0][bj].x, wq[1][bj].x, false, false); auto sy = __builtin_amdgcn_permlane32_swap(wq[0][bj].y, wq[1][bj].y, false, false);
                    if (rsel < cnt) *(u32x4*)(rp + bj * 128) = (u32x4){sx[0], sy[0], sx[1], sy[1]}; }
            }
    }
};

__device__ __forceinline__ void router_phase(const Ctx& C, int layer, const bool dry = false) {
    const bf16* H = (const bf16*)(C.ws + WS_HB); unsigned char* XN = C.ws + WS_XN; const u32x4* wp = (const u32x4*)(C.ws + WS_WPERM) + (size_t)layer * 32 * 64 * 6;
    const float* gain = C.in[I_NORM_MOE] + layer * 1024; const float* bgrp = C.in[I_MOE_BGRP] + layer * 4; const float* bexp = C.in[I_MOE_BEXP] + layer * 32;
    u32x2* LIST = (u32x2*)(C.ws + WS_LIST); unsigned* CNT = (unsigned*)(C.ws + WS_CTL) + CW_CNT + layer * 32;
    LAS float* lg = (LAS float*)(C.lds);
    LAS float* sq = (LAS float*)(C.lds + 32768);
    LAS int* hist = (LAS int*)(C.lds + 36864);
    LAS int* tk = (LAS int*)(C.lds + 40960);
    const int lane = C.lane, wave = C.wave;
    for (int chunk = C.bx; chunk < NTOK / 128; chunk += C.G) {
        const int tok0 = chunk * 128 + wave * 16;
        if (C.tid < 64) hist[C.tid] = 0;
        f32x4 acc0 = {0.f, 0.f, 0.f, 0.f}, acc1 = acc0, acc2 = acc0; float ss = 0.f;
        const bf16* hrow = H + (size_t)(tok0 + (lane & 15)) * DM + 8 * (lane >> 4);
        const u32x4* wl = wp + lane * 6;
#pragma unroll 1
        for (int half = 0; half < 2; ++half) {
            u32x4 hws[16];
#pragma unroll
            for (int s_ = 0; s_ < 16; ++s_) hws[s_] = *(const u32x4*)(hrow + (half * 16 + s_) * 32);
#pragma unroll
            for (int s4 = 0; s4 < 16; s4 += 4) {
                u32x4 wq[4][6];
#pragma unroll
                for (int q = 0; q < 4; ++q) { const u32x4* w6 = wl + (half * 16 + s4 + q) * 384;
#pragma unroll
                    for (int i = 0; i < 6; ++i) wq[q][i] = w6[i]; }
                asm volatile("" ::: "memory");
#pragma unroll
                for (int q = 0; q < 4; ++q) { const u32x4 hw = hws[s4 + q]; const bf16x8 hv = __builtin_bit_cast(bf16x8, hw);
                    ss += (bflo(hw.x) * bflo(hw.x) + bfhi(hw.x) * bfhi(hw.x)) + (bflo(hw.y) * bflo(hw.y) + bfhi(hw.y) * bfhi(hw.y)) + (bflo(hw.z) * bflo(hw.z) + bfhi(hw.z) * bfhi(hw.z)) + (bflo(hw.w) * bflo(hw.w) + bfhi(hw.w) * bfhi(hw.w));
                    acc0 = __builtin_amdgcn_mfma_f32_16x16x32_bf16(hv, __builtin_bit_cast(bf16x8, wq[q][0]), acc0, 0, 0, 0); acc0 = __builtin_amdgcn_mfma_f32_16x16x32_bf16(hv, __builtin_bit_cast(bf16x8, wq[q][1]), acc0, 0, 0, 0);
                    acc1 = __builtin_amdgcn_mfma_f32_16x16x32_bf16(hv, __builtin_bit_cast(bf16x8, wq[q][2]), acc1, 0, 0, 0); acc1 = __builtin_amdgcn_mfma_f32_16x16x32_bf16(hv, __builtin_bit_cast(bf16x8, wq[q][3]), acc1, 0, 0, 0);
                    acc2 = __builtin_amdgcn_mfma_f32_16x16x32_bf16(hv, __builtin_bit_cast(bf16x8, wq[q][4]), acc2, 0, 0, 0); acc2 = __builtin_amdgcn_mfma_f32_16x16x32_bf16(hv, __builtin_bit_cast(bf16x8, wq[q][5]), acc2, 0, 0, 0); }
            }
        }
        ss += __shfl_xor(ss, 16); ss += __shfl_xor(ss, 32);
        LAS float* lgw = lg + wave * 16 * 48;
#pragma unroll
        for (int r = 0; r < 4; ++r) { const int t = (lane >> 4) * 4 + r; lgw[t * 48 + (lane & 15)] = acc0[r]; lgw[t * 48 + 16 + (lane & 15)] = acc1[r]; lgw[t * 48 + 32 + (lane & 15)] = acc2[r]; }
        if (lane < 16) sq[wave * 16 + lane] = ss;
        __syncthreads();
        if (lane < 16) {
            const int t = lane; const float rs = __builtin_amdgcn_rsqf(sq[wave * 16 + t] * (1.0f / 1024.0f) + EPS); const LAS float* L = lgw + t * 48;
            float pgv[4]; float mx = -3.0e38f; int g = 0;
#pragma unroll
            for (int j = 0; j < 4; ++j) { pgv[j] = L[j] * rs + bgrp[j]; if (pgv[j] > mx) { mx = pgv[j]; g = j; } }
            float den = 0.f;
#pragma unroll
            for (int j = 0; j < 4; ++j) den += __expf(pgv[j] - mx);
            const float ggate = 1.0f / den;
            float v0 = -3.0e38f, v1 = -3.0e38f; int i0 = 0, i1 = 0;
#pragma unroll
            for (int j = 0; j < 8; ++j) { const float le = L[4 + g * 8 + j] * rs + bexp[g * 8 + j];
                if (le > v0) { v1 = v0; i1 = i0; v0 = le; i0 = j; } else if (le > v1) { v1 = le; i1 = j; } }
            const float e1 = __expf(v1 - v0); const float w0 = ggate / (1.0f + e1), w1 = ggate * e1 / (1.0f + e1);
            const int ex0 = g * 8 + i0, ex1 = g * 8 + i1;
            const int r0 = __hip_atomic_fetch_add(&hist[ex0], 1, __ATOMIC_RELAXED, __HIP_MEMORY_SCOPE_WORKGROUP), r1 = __hip_atomic_fetch_add(&hist[ex1], 1, __ATOMIC_RELAXED, __HIP_MEMORY_SCOPE_WORKGROUP);
            LAS int* T = tk + (wave * 16 + t) * 8; T[0] = ex0; T[1] = ex1; T[2] = r0; T[3] = r1; T[4] = (int)__float_as_uint(w0); T[5] = (int)__float_as_uint(w1);
            sq[wave * 16 + t] = rs;
        }
        __syncthreads();
        if (C.tid < 32) { const int n = hist[C.tid]; hist[32 + C.tid] = (n && !dry) ? (int)__hip_atomic_fetch_add(CNT + C.tid, (unsigned)n, __ATOMIC_RELAXED, __HIP_MEMORY_SCOPE_AGENT) : 0; }
        __syncthreads();
        if (C.tid < 128 && !dry) { const LAS int* T = tk + C.tid * 8; const unsigned tokid = (unsigned)(chunk * 128 + C.tid);
            LIST[(size_t)T[0] * MOE_CAP + hist[32 + T[0]] + T[2]] = (u32x2){tokid * 2u, (unsigned)T[4]};
            LIST[(size_t)T[1] * MOE_CAP + hist[32 + T[1]] + T[3]] = (u32x2){tokid * 2u + 1u, (unsigned)T[5]}; }
        { const f32x4* gr = (const f32x4*)gain + lane; const f32x4 g0 = gr[0], g1 = gr[64], g2 = gr[128], g3 = gr[192];
#pragma unroll 1
          for (int t = 0; t < 16; t += 4) {
            u32x2 hv[4][4];
#pragma unroll
            for (int tt = 0; tt < 4; ++tt) { const u32x2* hr = (const u32x2*)(H + (size_t)(tok0 + t + tt) * DM) + lane;
#pragma unroll
                for (int j = 0; j < 4; ++j) hv[tt][j] = hr[64 * j]; }
#pragma unroll
            for (int tt = 0; tt < 4; ++tt) { const float rs8 = sq[wave * 16 + t + tt] * XN8_SCALE; unsigned* xr = (unsigned*)(XN + (size_t)(tok0 + t + tt) * DM) + lane;
                const f32x4 a = unpack4(hv[tt][0]) * g0 * rs8, b = unpack4(hv[tt][1]) * g1 * rs8, c = unpack4(hv[tt][2]) * g2 * rs8, d = unpack4(hv[tt][3]) * g3 * rs8;
                xr[0] = pk_fp8x4(a[0], a[1], a[2], a[3]); xr[64] = pk_fp8x4(b[0], b[1], b[2], b[3]); xr[128] = pk_fp8x4(c[0], c[1], c[2], c[3]); xr[192] = pk_fp8x4(d[0], d[1], d[2], d[3]); }
          } }
        __syncthreads();
    }
}
__device__ __forceinline__ void combine_phase(const Ctx& C, const float* gain, const float scale) {
    bf16* H = (bf16*)(C.ws + WS_HB); unsigned char* XN = C.ws + WS_XN; const bf16* YB = (const bf16*)(C.ws + AR_YB);
    const int gw = C.bx * NWAVES + C.wave, NGW = C.G * NWAVES;
    const f32x4* gr = (const f32x4*)gain + C.lane; const f32x4 g0 = gr[0], g1 = gr[64], g2 = gr[128], g3 = gr[192];
    for (int row = gw; row < NTOK; row += 2 * NGW) {
        u32x2 hin[2][4]; unsigned ya[2][4], yb[2][4];
#pragma unroll
        for (int q = 0; q < 2; ++q) { const int rw = row + q * NGW; const u32x2* hr = (const u32x2*)(H + (size_t)rw * DM) + C.lane; const unsigned* y0 = (const unsigned*)((const unsigned char*)YB + (size_t)rw * 2048) + C.lane;
#pragma unroll
            for (int j = 0; j < 4; ++j) { hin[q][j] = hr[64 * j]; ya[q][j] = y0[64 * j]; yb[q][j] = y0[256 + 64 * j]; } }
#pragma unroll
        for (int q = 0; q < 2; ++q) { const int rw = row + q * NGW; u32x2* hr = (u32x2*)(H + (size_t)rw * DM) + C.lane; unsigned* xr = (unsigned*)(XN + (size_t)rw * DM) + C.lane;
            f32x4 v[4]; float s = 0.f;
#pragma unroll
            for (int j = 0; j < 4; ++j) { const unsigned a_ = ya[q][j], b_ = yb[q][j]; const f32x4 ys = {__builtin_amdgcn_cvt_f32_fp8(a_, 0) + __builtin_amdgcn_cvt_f32_fp8(b_, 0), __builtin_amdgcn_cvt_f32_fp8(a_, 1) + __builtin_amdgcn_cvt_f32_fp8(b_, 1), __builtin_amdgcn_cvt_f32_fp8(a_, 2) + __builtin_amdgcn_cvt_f32_fp8(b_, 2), __builtin_amdgcn_cvt_f32_fp8(a_, 3) + __builtin_amdgcn_cvt_f32_fp8(b_, 3)};
                const u32x2 hw = pack4(unpack4(hin[q][j]) + ys * (scale / YB8_SCALE)); hr[64 * j] = hw; v[j] = unpack4(hw); s += sumsq4(v[j]); }
            const float rs = __builtin_amdgcn_rsqf(wave_sum(s) * (1.0f / 1024.0f) + EPS) * XN8_SCALE;
            const f32x4 a = v[0] * g0 * rs, b = v[1] * g1 * rs, c = v[2] * g2 * rs, d = v[3] * g3 * rs;
            xr[0] = pk_fp8x4(a[0], a[1], a[2], a[3]); xr[64] = pk_fp8x4(b[0], b[1], b[2], b[3]); xr[128] = pk_fp8x4(c[0], c[1], c[2], c[3]); xr[192] = pk_fp8x4(d[0], d[1], d[2], d[3]); }
    }
}
__device__ __forceinline__ void final_phase(const Ctx& C) {
    const bf16* H = (const bf16*)(C.ws + WS_HB); const float* gain = C.in[I_NORM_FINAL];
    const int gw = C.bx * NWAVES + C.wave, NGW = C.G * NWAVES;
    const f32x4* gr = (const f32x4*)gain + C.lane; const f32x4 g0 = gr[0], g1 = gr[64], g2 = gr[128], g3 = gr[192];
    for (int row0 = gw; row0 < NTOK; row0 += 4 * NGW) {
        u32x2 hv[4][4];
#pragma unroll
        for (int q = 0; q < 4; ++q) { const u32x2* hr = (const u32x2*)(H + (size_t)(row0 + q * NGW) * DM) + C.lane;
#pragma unroll
            for (int j = 0; j < 4; ++j) hv[q][j] = hr[64 * j]; }
#pragma unroll
        for (int q = 0; q < 4; ++q) { f32x4* o = (f32x4*)(C.out + (size_t)(row0 + q * NGW) * DM) + C.lane;
            f32x4 v[4]; float s = 0.f;
#pragma unroll
            for (int j = 0; j < 4; ++j) { v[j] = unpack4(hv[q][j]); s += sumsq4(v[j]); }
            const float rs = __builtin_amdgcn_rsqf(wave_sum(s) * (1.0f / 1024.0f) + EPS);
            o[0] = v[0] * g0 * rs; o[64] = v[1] * g1 * rs; o[128] = v[2] * g2 * rs; o[192] = v[3] * g3 * rs; }
    }
}
template <int OFF> __device__ __forceinline__ s16x4 tr_read_a(int addr) { s16x4 r; asm volatile("ds_read_b64_tr_b16 %0, %1 offset:%2" : "=&v"(r) : "v"(addr), "i"(OFF) : "memory"); return r; }
__device__ __forceinline__ void spatial_phase(const Ctx& C) {
    const bf16* U = (const bf16*)(C.ws + AR_U); const bf16* V = (const bf16*)(C.ws + AR_V); unsigned char* Gt = C.ws + AR_G; const float* SSQV = (const float*)(C.ws + AR_SSQV);
    const float* Ws = C.in[I_GM_WS]; const float* bs = C.in[I_GM_BS]; const float* nv = C.in[I_GM_NV];
    const int g = C.bx & 15, tid = C.tid, lane = C.lane, fr = lane & 15, fq = lane >> 4, wp = C.wave >> 1, wd = C.wave & 1;
    bf16x8 Af[2][4];
    { f32x4 wx[2][4], wy[2][4];
#pragma unroll
      for (int m = 0; m < 2; ++m)
#pragma unroll
        for (int ks = 0; ks < 4; ++ks) { const f32x4* src = (const f32x4*)(Ws + (size_t)g * 16384 + (32 * wp + 16 * m + fr) * 128 + 32 * ks + 8 * fq); wx[m][ks] = src[0]; wy[m][ks] = src[1]; }
      asm volatile("" ::: "memory");
#pragma unroll
      for (int m = 0; m < 2; ++m)
#pragma unroll
        for (int ks = 0; ks < 4; ++ks) { const f32x4 x = wx[m][ks], y = wy[m][ks];
            u32x4 w = {cvt_pk_bf16(x[0], x[1]), cvt_pk_bf16(x[2], x[3]), cvt_pk_bf16(y[0], y[1]), cvt_pk_bf16(y[2], y[3])}; Af[m][ks] = *reinterpret_cast<bf16x8*>(&w); } }
    f32x4 nvv[4];
#pragma unroll
    for (int n = 0; n < 4; ++n) nvv[n] = *(const f32x4*)(nv + g * 128 + 64 * wd + 16 * fq + 4 * n);
    const float bias0 = bs[g * 128 + 32 * wp + fr], bias1 = bs[g * 128 + 32 * wp + 16 + fr];
    const int qq = fr >> 2, pcol = fr & 3;
    int tra[4];
#pragma unroll
    for (int n = 0; n < 4; ++n) tra[n] = (int)(uintptr_t)C.lds + (8 * fq + qq) * 256 + ((128 * wd + 32 * pcol + 8 * n) ^ ((qq << 3) | ((fq & 1) << 7)));
    const int sq = tid >> 2, sc0 = (tid & 3) * 4, sswz = ((sq & 3) << 3) | (((sq >> 3) & 1) << 7);
    u32x4 vreg[4]; float rsv;
#define SP_LOAD(chunk) do { const int tok_ = (chunk) * 128 + sq; const f32x4* sp_ = (const f32x4*)(SSQV + (size_t)tok_ * 32) + (tid & 3) * 2; const f32x4 a_ = sp_[0], b_ = sp_[1]; \
        float s_ = ((a_[0] + a_[1]) + (a_[2] + a_[3])) + ((b_[0] + b_[1]) + (b_[2] + b_[3])); s_ += __shfl_xor(s_, 1); s_ += __shfl_xor(s_, 2); rsv = __builtin_amdgcn_rsqf(s_ * (1.0f / 2048.0f) + EPS); \
        const u32x4* vp_ = (const u32x4*)(V + (size_t)tok_ * 2048 + g * 128 + sc0 * 8); _Pragma("unroll") for (int j = 0; j < 4; ++j) vreg[j] = vp_[j]; } while (0)
#define SP_WRITE() do { _Pragma("unroll") for (int j = 0; j < 4; ++j) { const u32x4 w_ = vreg[j]; \
        const u32x2 lo_ = {cvt_pk_bf16(bflo(w_.x) * rsv, bfhi(w_.x) * rsv), cvt_pk_bf16(bflo(w_.y) * rsv, bfhi(w_.y) * rsv)}, hi_ = {cvt_pk_bf16(bflo(w_.z) * rsv, bfhi(w_.z) * rsv), cvt_pk_bf16(bflo(w_.w) * rsv, bfhi(w_.w) * rsv)}; \
        const int cb_ = (sc0 + j) * 16; *(LAS u32x2*)(C.lds + sq * 256 + (cb_ ^ sswz)) = lo_; *(LAS u32x2*)(C.lds + sq * 256 + ((cb_ + 8) ^ sswz)) = hi_; } } while (0)
    int chunk = C.bx >> 4; const int cstep = C.G >> 4;
    if (chunk < NTOK / 128) SP_LOAD(chunk);
    for (; chunk < NTOK / 128; chunk += cstep) {
        __syncthreads();
        SP_WRITE();
        __syncthreads();
        if (chunk + cstep < NTOK / 128) SP_LOAD(chunk + cstep);
        f32x4 acc[2][4];
#pragma unroll
        for (int m = 0; m < 2; ++m)
#pragma unroll
            for (int n = 0; n < 4; ++n) acc[m][n] = (f32x4){0.f, 0.f, 0.f, 0.f};
#define SP_KS(KS) do { bf16x8 Bf[4]; _Pragma("unroll") for (int n = 0; n < 4; ++n) { const s16x4 l_ = tr_read_a<(KS) * 8192>(tra[n]), h_ = tr_read_a<(KS) * 8192 + 1024>(tra[n]); \
            Bf[n] = (bf16x8){l_[0], l_[1], l_[2], l_[3], h_[0], h_[1], h_[2], h_[3]}; } \
        asm volatile("s_waitcnt lgkmcnt(0)" ::: "memory"); SBAR(); \
        _Pragma("unroll") for (int m = 0; m < 2; ++m) _Pragma("unroll") for (int n = 0; n < 4; ++n) acc[m][n] = __builtin_amdgcn_mfma_f32_16x16x32_bf16(Bf[n], Af[m][KS], acc[m][n], 0, 0, 0); } while (0)
        SP_KS(0); SP_KS(1); SP_KS(2); SP_KS(3);
#undef SP_KS
#pragma unroll
        for (int m = 0; m < 2; ++m) { const int p = 32 * wp + 16 * m + fr; const float bias = m == 0 ? bias0 : bias1;
            const size_t o = (size_t)(chunk * 128 + p) * 2048 + g * 128 + 64 * wd + 16 * fq;
            const u32x4 u0 = *(const u32x4*)(U + o), u1 = *(const u32x4*)(U + o + 8);
            const f32x4 s0 = (acc[m][0] * nvv[0] + bias) * G8_SCALE, s1 = (acc[m][1] * nvv[1] + bias) * G8_SCALE, s2 = (acc[m][2] * nvv[2] + bias) * G8_SCALE, s3 = (acc[m][3] * nvv[3] + bias) * G8_SCALE;
            const u32x4 o8 = {pk_fp8x4(bflo(u0.x) * s0[0], bfhi(u0.x) * s0[1], bflo(u0.y) * s0[2], bfhi(u0.y) * s0[3]), pk_fp8x4(bflo(u0.z) * s1[0], bfhi(u0.z) * s1[1], bflo(u0.w) * s1[2], bfhi(u0.w) * s1[3]),
                              pk_fp8x4(bflo(u1.x) * s2[0], bfhi(u1.x) * s2[1], bflo(u1.y) * s2[2], bfhi(u1.y) * s2[3]), pk_fp8x4(bflo(u1.z) * s3[0], bfhi(u1.z) * s3[1], bflo(u1.w) * s3[2], bfhi(u1.w) * s3[3])};
            *(u32x4*)(Gt + o) = o8; }
    }
#undef SP_LOAD
#undef SP_WRITE
    __syncthreads();
}

namespace mla {
constexpr int DQK = 192, DV = 128, KVBLK = 64;
constexpr float SCALE = 0.07216878364870322f;
constexpr float THR = 8.f;
constexpr int SHM_V = KVBLK * DV * 2, SHM_K = KVBLK * DQK * 2;
#define KSWZ(row, colB) ((row) * 384 + ((colB) ^ ((((row) >> 1) & 7) << 4)))
__device__ __forceinline__ int crow(int r, int hi) { return (r & 3) + 8 * (r >> 2) + 4 * hi; }
__device__ __forceinline__ void partialSM(f32x16& p0, f32x16& p1, float& m_reg, float& mn, float& alpha) {
    constexpr float Cc = SCALE * 1.4426950408889634f;
    float pmax = p0[0];
#pragma unroll
    for (int r = 1; r < 16; ++r) pmax = fmaxf(pmax, p0[r]);
#pragma unroll
    for (int r = 0; r < 16; ++r) pmax = fmaxf(pmax, p1[r]);
    { auto rr = __builtin_amdgcn_permlane32_swap(__float_as_uint(pmax), __float_as_uint(pmax), false, false); pmax = fmaxf(__uint_as_float(rr[0]), __uint_as_float(rr[1])); }
    if (__builtin_expect(__all(pmax - m_reg <= THR / SCALE), 1)) { mn = m_reg; alpha = 1.f; }
    else { mn = fmaxf(m_reg, pmax); alpha = __builtin_amdgcn_exp2f((m_reg - mn) * Cc); m_reg = mn; }
    const float mnC = -mn * Cc;
#pragma unroll
    for (int r = 0; r < 16; ++r) p0[r] = fmaf(p0[r], Cc, mnC);
#pragma unroll
    for (int r = 0; r < 16; ++r) p1[r] = fmaf(p1[r], Cc, mnC);
#pragma unroll
    for (int r = 0; r < 16; ++r) p0[r] = __builtin_amdgcn_exp2f(p0[r]);
}
__device__ __forceinline__ void finishSM(f32x16& p0, f32x16& p1, float alpha, float& l_reg, bf16x8& pa0, bf16x8& pa1, bf16x8& pa2, bf16x8& pa3) {
#pragma unroll
    for (int r = 0; r < 16; ++r) p1[r] = __builtin_amdgcn_exp2f(p1[r]);
    float ps = 0;
#pragma unroll
    for (int r = 0; r < 16; ++r) ps += p0[r];
#pragma unroll
    for (int r = 0; r < 16; ++r) ps += p1[r];
    { auto rr = __builtin_amdgcn_permlane32_swap(__float_as_uint(ps), __float_as_uint(ps), false, false); ps = __uint_as_float(rr[0]) + __uint_as_float(rr[1]); }
    l_reg = l_reg * alpha + ps;
#define PK4(P, BASE, OUT) do { unsigned a0 = cvt_pk_bf16(P[BASE + 0], P[BASE + 1]), a1 = cvt_pk_bf16(P[BASE + 2], P[BASE + 3]);   \
    unsigned b0 = cvt_pk_bf16(P[BASE + 4], P[BASE + 5]), b1 = cvt_pk_bf16(P[BASE + 6], P[BASE + 7]);                              \
    auto r0 = __builtin_amdgcn_permlane32_swap(a0, b0, false, false); auto r1 = __builtin_amdgcn_permlane32_swap(a1, b1, false, false); \
    u32x4 w = {r0[0], r1[0], r0[1], r1[1]}; OUT = *reinterpret_cast<bf16x8*>(&w); } while (0)
    PK4(p0, 0, pa0); PK4(p0, 8, pa1); PK4(p1, 0, pa2); PK4(p1, 8, pa3);
#undef PK4
}
__device__ __forceinline__ void qkt(f32x16& p0, f32x16& p1, const char* Ks, const bf16x8* qr, int r32, int hi) {
    p0 = f32x16{}; p1 = f32x16{};
#pragma unroll
    for (int d0 = 0; d0 < 12; ++d0) { const int cb = (d0 * 16 + hi * 8) * 2;
        const bf16x8 b0 = *reinterpret_cast<const bf16x8*>(Ks + KSWZ(r32, cb));
        const bf16x8 b1 = *reinterpret_cast<const bf16x8*>(Ks + KSWZ(32 + r32, cb));
        p0 = __builtin_amdgcn_mfma_f32_32x32x16_bf16(b0, qr[d0], p0, 0, 0, 0);
        p1 = __builtin_amdgcn_mfma_f32_32x32x16_bf16(b1, qr[d0], p1, 0, 0, 0); }
}
__device__ __forceinline__ int v_st(int k, int c) { const int kk = (k & ~0xC) | ((k & 4) << 1) | ((k & 8) >> 1); return ((kk >> 3) * 4 + (c >> 5)) * 512 + ((kk & 7) * 32 + (c & 31)) * 2; }
__device__ __forceinline__ int v_rd_base(int lane) { return ((lane & 3) << 3) | (((lane >> 2) & 3) << 6) | (((lane >> 4) & 1) << 5) | (((lane >> 5) & 1) << 8); }
constexpr int v_rd_off(int d0, int ks, int half) { return d0 * 512 + ks * 4096 + half * 2048; }
template <int OFF> __device__ __forceinline__ s16x4 tr_read(int vb) { s16x4 r; asm volatile("ds_read_b64_tr_b16 %0, %1 offset:%2" : "=&v"(r) : "v"(vb), "i"(OFF) : "memory"); return r; }
template <int D0> __device__ __forceinline__ void pv_one(f32x16& od, int vb, bf16x8 pa0, bf16x8 pa1, bf16x8 pa2, bf16x8 pa3) {
    const s16x4 l0 = tr_read<v_rd_off(D0, 0, 0)>(vb), h0 = tr_read<v_rd_off(D0, 0, 1)>(vb), l1 = tr_read<v_rd_off(D0, 1, 0)>(vb), h1 = tr_read<v_rd_off(D0, 1, 1)>(vb);
    const s16x4 l2 = tr_read<v_rd_off(D0, 2, 0)>(vb), h2 = tr_read<v_rd_off(D0, 2, 1)>(vb), l3 = tr_read<v_rd_off(D0, 3, 0)>(vb), h3 = tr_read<v_rd_off(D0, 3, 1)>(vb);
    asm volatile("s_waitcnt lgkmcnt(0)" ::: "memory"); SBAR();
#define PK(L, H) (bf16x8){L[0], L[1], L[2], L[3], H[0], H[1], H[2], H[3]}
    od = __builtin_amdgcn_mfma_f32_32x32x16_bf16(pa0, PK(l0, h0), od, 0, 0, 0);
    od = __builtin_amdgcn_mfma_f32_32x32x16_bf16(pa1, PK(l1, h1), od, 0, 0, 0);
    od = __builtin_amdgcn_mfma_f32_32x32x16_bf16(pa2, PK(l2, h2), od, 0, 0, 0);
    od = __builtin_amdgcn_mfma_f32_32x32x16_bf16(pa3, PK(l3, h3), od, 0, 0, 0);
#undef PK
}
__device__ __forceinline__ void pv_d0(f32x16* o, int vb, bf16x8 pa0, bf16x8 pa1, bf16x8 pa2, bf16x8 pa3) {
    pv_one<0>(o[0], vb, pa0, pa1, pa2, pa3); pv_one<1>(o[1], vb, pa0, pa1, pa2, pa3); pv_one<2>(o[2], vb, pa0, pa1, pa2, pa3); pv_one<3>(o[3], vb, pa0, pa1, pa2, pa3);
}
__device__ __forceinline__ void attn_unit(const int tid, const bf16* Q, const bf16* KV, const bf16* KR, bf16* O, int b, int h, int qb, char* lds) {
    const int wid = tid >> 6, lane = tid & 63, r32 = lane & 31, hi = lane >> 5;
    char* V_lds = lds; char* K_lds = lds + 2 * SHM_V;
    float* ws = (float*)(lds + 2 * SHM_V + 2 * SHM_K) + wid * 64; float* li_l = ws; float* al_l = ws + 32;
    float m_reg = -1e30f, l_reg = 0; f32x16 o[4] = {}; bf16x8 qr[12];
    const size_t tokb = (size_t)b * SEQ;
    { const char* Qw = (const char*)(Q + (tokb + qb * 256 + __builtin_amdgcn_readfirstlane(wid) * 32) * 1536 + h * 192); const unsigned qo = (unsigned)(r32 * 1536 + hi * 8) * 2u;
#pragma unroll
      for (int d0 = 0; d0 < 12; ++d0) qr[d0] = *reinterpret_cast<const bf16x8*>(Qw + qo + d0 * 32); }
    const int sr = tid >> 4, sc = (tid & 15) * 8, vst0 = v_st(sr, sc), vst1 = v_st(32 + sr, sc);
    const int rr = tid >> 3, rc = (tid & 7) * 8;
    const int vb0 = (int)(uintptr_t)V_lds + v_rd_base(lane);
    const char* Kn = (const char*)(KV + tokb * 2048 + h * 256); const char* Kr = (const char*)(KR + tokb * 64);
    const unsigned ko0 = (unsigned)(sr * 2048 + sc) * 2u, ko1 = ko0 + 32u * 2048u * 2u, kro = (unsigned)(rr * 64 + rc) * 2u;
    bf16x8 sv0, sv1, sk0, sk1, skr;
#define SLOAD(k0) do { const char* kb_ = Kn + (size_t)(k0) * 4096; const char* rb_ = Kr + (size_t)(k0) * 128; \
    sv0 = *reinterpret_cast<const bf16x8*>(kb_ + 256 + ko0); sv1 = *reinterpret_cast<const bf16x8*>(kb_ + 256 + ko1); \
    sk0 = *reinterpret_cast<const bf16x8*>(kb_ + ko0); sk1 = *reinterpret_cast<const bf16x8*>(kb_ + ko1); \
    skr = *reinterpret_cast<const bf16x8*>(rb_ + kro); } while (0)
#define SWRITE(bb) do { *(bf16x8*)(V_lds + (bb) * SHM_V + vst0) = sv0; *(bf16x8*)(V_lds + (bb) * SHM_V + vst1) = sv1; const int kc = sc * 2; \
    *(bf16x8*)(K_lds + (bb) * SHM_K + KSWZ(sr, kc)) = sk0; *(bf16x8*)(K_lds + (bb) * SHM_K + KSWZ(32 + sr, kc)) = sk1; \
    *(bf16x8*)(K_lds + (bb) * SHM_K + KSWZ(rr, 256 + rc * 2)) = skr; } while (0)
#define RESC(a) do { if (__any((a) < 1.f)) { if (hi == 0) al_l[r32] = (a); asm volatile("s_waitcnt lgkmcnt(0)" ::: "memory"); \
    _Pragma("unroll") for (int d = 0; d < 4; ++d) _Pragma("unroll") for (int r = 0; r < 16; ++r) o[d][r] *= al_l[crow(r, hi)]; } } while (0)
    f32x16 p0, p1; float mn, al; bf16x8 pa0, pa1, pa2, pa3; constexpr int NT = SEQ / KVBLK;
    SLOAD(0); asm volatile("s_waitcnt vmcnt(0)" ::: "memory"); SWRITE(0); __syncthreads();
#pragma unroll 1
    for (int j = 0; j < NT; j += 2) {
        SLOAD((j + 1) * KVBLK); SBAR();
        qkt(p0, p1, K_lds, qr, r32, hi); partialSM(p0, p1, m_reg, mn, al); RESC(al);
        finishSM(p0, p1, al, l_reg, pa0, pa1, pa2, pa3); SBAR();
        pv_d0(o, vb0, pa0, pa1, pa2, pa3);
        asm volatile("s_waitcnt vmcnt(0)" ::: "memory"); SWRITE(1); __syncthreads();
        if (j + 2 < NT) SLOAD((j + 2) * KVBLK); SBAR();
        qkt(p0, p1, K_lds + SHM_K, qr, r32, hi); partialSM(p0, p1, m_reg, mn, al); RESC(al);
        finishSM(p0, p1, al, l_reg, pa0, pa1, pa2, pa3); SBAR();
        pv_d0(o, vb0 + SHM_V, pa0, pa1, pa2, pa3);
        if (j + 2 < NT) { asm volatile("s_waitcnt vmcnt(0)" ::: "memory"); SWRITE(0); } __syncthreads();
    }
    if (hi == 0) li_l[r32] = l_reg; asm volatile("s_waitcnt lgkmcnt(0)" ::: "memory");
    char* Ow = (char*)(O + (tokb + qb * 256 + __builtin_amdgcn_readfirstlane(wid) * 32) * 1024 + h * 128);
    const unsigned oo = (unsigned)(4 * hi * 1024 + r32) * 2u;
#pragma unroll
    for (int r = 0; r < 16; ++r) { const float rl = __builtin_amdgcn_rcpf(li_l[crow(r, hi)]);
#pragma unroll
        for (int d0 = 0; d0 < 4; ++d0) { const unsigned w = cvt_pk_bf16(o[d0][r] * rl, 0.f); *(bf16*)(Ow + oo + (unsigned)((((r & 3) + 8 * (r >> 2)) * 1024 + d0 * 32) * 2)) = (bf16)(w & 0xffffu); } }
    __syncthreads();
#undef SLOAD
#undef SWRITE
#undef RESC
}
constexpr int SLOT = SHM_K + SHM_V;
__device__ __forceinline__ void qkt_l(f32x16& p0, f32x16& p1, const LAS char* Ks, const bf16x8* qr, int r32, int hi) {
    p0 = f32x16{}; p1 = f32x16{};
#pragma unroll
    for (int d0 = 0; d0 < 12; ++d0) { const int cb = (d0 * 16 + hi * 8) * 2;
        const bf16x8 b0 = *reinterpret_cast<const LAS bf16x8*>(Ks + KSWZ(r32, cb));
        const bf16x8 b1 = *reinterpret_cast<const LAS bf16x8*>(Ks + KSWZ(32 + r32, cb));
        p0 = __builtin_amdgcn_mfma_f32_32x32x16_bf16(b0, qr[d0], p0, 0, 0, 0);
        p1 = __builtin_amdgcn_mfma_f32_32x32x16_bf16(b1, qr[d0], p1, 0, 0, 0); }
}
#define WAITBAR(N) asm volatile("s_waitcnt vmcnt(" #N ") lgkmcnt(0)\n\ts_barrier" ::: "memory")
__device__ __forceinline__ void attn_unit_g(const int tid, const bf16* Q, const bf16* KV, const bf16* KR, bf16* O, int b, int h, int qb, LAS char* lds) {
    const int wid = __builtin_amdgcn_readfirstlane(tid >> 6), lane = tid & 63, r32 = lane & 31, hi = lane >> 5;
    LAS float* wsc = (LAS float*)(lds + 3 * SLOT) + wid * 64; LAS float* li_l = wsc; LAS float* al_l = wsc + 32;
    float m_reg = -1e30f, l_reg = 0; f32x16 o[4] = {}; bf16x8 qr[12];
    const size_t tokb = (size_t)b * SEQ;
    { const char* Qw = (const char*)(Q + (tokb + qb * 256 + wid * 32) * 1536 + h * 192); const unsigned qo = (unsigned)(r32 * 1536 + hi * 8) * 2u;
#pragma unroll
      for (int d0 = 0; d0 < 12; ++d0) qr[d0] = *reinterpret_cast<const bf16x8*>(Qw + qo + d0 * 32); }
    const char* Kn = (const char*)(KV + tokb * 2048 + h * 256); const char* Kr = (const char*)(KR + tokb * 64);
    unsigned koff[3], voff[2]; bool krope[3];
#pragma unroll
    for (int t = 0; t < 3; ++t) { const int p = (wid * 3 + t) * 64 + lane, row = p / 24, cp = p % 24, c = (cp & ~7) | ((cp ^ (row >> 1)) & 7);
        krope[t] = c >= 16; koff[t] = krope[t] ? (unsigned)(row * 128 + (c - 16) * 16) : (unsigned)(row * 4096 + c * 16); }
#pragma unroll
    for (int t = 0; t < 2; ++t) { const int p = (wid * 2 + t) * 64 + lane, sub = p >> 5, w = p & 31, kk = (sub >> 2) * 8 + (w >> 2), c = (sub & 3) * 32 + (w & 3) * 8;
        const int k = (kk & ~0xC) | ((kk & 4) << 1) | ((kk & 8) >> 1); voff[t] = (unsigned)(k * 4096 + 256 + c * 2); }
#define GLDS(k0, slot) do { const char* kb_ = Kn + (size_t)(k0) * 4096; const char* rb_ = Kr + (size_t)(k0) * 128; LAS char* kd_ = lds + (slot) * SLOT + wid * 3072; LAS char* vd_ = lds + (slot) * SLOT + SHM_K + wid * 2048; \
    _Pragma("unroll") for (int t_ = 0; t_ < 3; ++t_) { const char* src_ = (krope[t_] ? rb_ : kb_) + koff[t_]; __builtin_amdgcn_global_load_lds((const unsigned*)src_, (LAS unsigned*)(kd_ + t_ * 1024), 16, 0, 0); } \
    _Pragma("unroll") for (int t_ = 0; t_ < 2; ++t_) __builtin_amdgcn_global_load_lds((const unsigned*)(kb_ + voff[t_]), (LAS unsigned*)(vd_ + t_ * 1024), 16, 0, 0); } while (0)
#define RESC(a) do { if (__any((a) < 1.f)) { if (hi == 0) al_l[r32] = (a); asm volatile("s_waitcnt lgkmcnt(0)" ::: "memory"); \
    _Pragma("unroll") for (int d = 0; d < 4; ++d) _Pragma("unroll") for (int r = 0; r < 16; ++r) o[d][r] *= al_l[crow(r, hi)]; } } while (0)
    f32x16 pA0, pA1, pB0, pB1; float mnA, mnB, alA, alB; bf16x8 pa0, pa1, pa2, pa3; constexpr int NT = SEQ / KVBLK;
    const int vrb = (int)(uintptr_t)lds + SHM_K + v_rd_base(lane);
    int s0 = 0, s1 = 1, s2 = 2;
    GLDS(0, 0); GLDS(KVBLK, 1);
    WAITBAR(5);
    qkt_l(pA0, pA1, lds, qr, r32, hi); partialSM(pA0, pA1, m_reg, mnA, alA);
    WAITBAR(2);
#pragma unroll 1
    for (int j = 0; j < NT; j += 2) {
        const bool more1 = j + 2 < NT;
        if (more1) GLDS((j + 2) * KVBLK, s2);
        SBAR(); qkt_l(pB0, pB1, lds + s1 * SLOT, qr, r32, hi);
        finishSM(pA0, pA1, alA, l_reg, pa0, pa1, pa2, pa3); SBAR();
        pv_d0(o, vrb + s0 * SLOT, pa0, pa1, pa2, pa3); partialSM(pB0, pB1, m_reg, mnB, alB);
        if (more1) WAITBAR(2); else WAITBAR(0);
        RESC(alB);
        { const int t_ = s0; s0 = s1; s1 = s2; s2 = t_; }
        const bool more2 = j + 3 < NT;
        if (more2) GLDS((j + 3) * KVBLK, s2);
        SBAR(); if (more1) qkt_l(pA0, pA1, lds + s1 * SLOT, qr, r32, hi);
        finishSM(pB0, pB1, alB, l_reg, pa0, pa1, pa2, pa3); SBAR();
        pv_d0(o, vrb + s0 * SLOT, pa0, pa1, pa2, pa3); if (more1) partialSM(pA0, pA1, m_reg, mnA, alA);
        if (more2) WAITBAR(2); else WAITBAR(0);
        if (more1) RESC(alA);
        { const int t_ = s0; s0 = s1; s1 = s2; s2 = t_; }
    }
    if (hi == 0) li_l[r32] = l_reg; asm volatile("s_waitcnt lgkmcnt(0)" ::: "memory");
    char* Ow = (char*)(O + (tokb + qb * 256 + wid * 32) * 1024 + h * 128);
    const unsigned oo = (unsigned)(4 * hi * 1024 + r32) * 2u;
#pragma unroll
    for (int r = 0; r < 16; ++r) { const float rl = __builtin_amdgcn_rcpf(li_l[crow(r, hi)]);
#pragma unroll
        for (int d0 = 0; d0 < 4; ++d0) { const unsigned w = cvt_pk_bf16(o[d0][r] * rl, 0.f); *(bf16*)(Ow + oo + (unsigned)((((r & 3) + 8 * (r >> 2)) * 1024 + d0 * 32) * 2)) = (bf16)(w & 0xffffu); } }
    WAITBAR(0);
#undef GLDS
#undef RESC
}
constexpr int F8_SK = 64 * 192, F8_SV = 128 * 64, F8_SLOT = F8_SK + F8_SV;
typedef int v8i32 __attribute__((ext_vector_type(8)));
__device__ __forceinline__ v8i32 ld32(const LAS char* p0, const LAS char* p1) { const u32x4 a = *(const LAS u32x4*)p0, b = *(const LAS u32x4*)p1; return (v8i32){(int)a.x, (int)a.y, (int)a.z, (int)a.w, (int)b.x, (int)b.y, (int)b.z, (int)b.w}; }
__device__ __forceinline__ void attn_unit_f8(const int tid, const unsigned char* Q8, const unsigned char* KN8, const unsigned char* KR8, const unsigned char* VT8, unsigned char* O, int b, int h, int qb, LAS char* lds) {
    const int wid = __builtin_amdgcn_readfirstlane(tid >> 6), lane = tid & 63, r32 = lane & 31, hi = lane >> 5;
    LAS float* wsc = (LAS float*)(lds + 6 * F8_SLOT) + wid * 64; LAS float* al_l = wsc + 32;
    constexpr float TAU = 1.0f;
    f32x16 o[4] = {}, osum = {}, minit = {}; v8i32 qr[3];
    LAS char* const onep = lds + 6 * F8_SLOT + 2048;
    if (tid < 4) ((LAS unsigned*)onep)[tid] = 0x38383838u;
    const size_t tokb = (size_t)b * SEQ;
    { const unsigned char* Qw = Q8 + (tokb + qb * 256 + wid * 32) * 1536 + h * 192; const unsigned qo = (unsigned)(r32 * 1536 + hi * 32);
#pragma unroll
      for (int st = 0; st < 3; ++st) { const u32x4 x = *(const u32x4*)(Qw + qo + st * 64), y = *(const u32x4*)(Qw + qo + st * 64 + 16); qr[st] = (v8i32){(int)x.x, (int)x.y, (int)x.z, (int)x.w, (int)y.x, (int)y.y, (int)y.z, (int)y.w}; } }
    const unsigned char* Knb = KN8 + tokb * 1024 + h * 128; const unsigned char* Krb = KR8 + tokb * 64; const unsigned char* Vtb = VT8 + (size_t)(b * 8 + h) * 128 * SEQ;
    unsigned koff[3], voff; bool krope[3]; int kdst[3];
#pragma unroll
    for (int t = 0; t < 3; ++t) { const int q = wid + 8 * t, tl = q / 12, pc = q % 12, p = pc * 64 + lane, row = p / 12, cp = p % 12, c = (cp & ~3) | ((cp ^ (row >> 2)) & 3);
        krope[t] = c >= 8; koff[t] = krope[t] ? (unsigned)((tl * 64 + row) * 64 + (c - 8) * 16) : (unsigned)((tl * 64 + row) * 1024 + c * 16); kdst[t] = tl * F8_SLOT + pc * 1024; }
    { const int p = wid * 64 + lane, d = p >> 2, cp = p & 3, c = cp ^ ((d >> 2) & 3); voff = (unsigned)(d * SEQ + c * 16); }
#define GLDS8(k0, slot) do { const unsigned char* kb_ = Knb + (size_t)(k0) * 1024; const unsigned char* rb_ = Krb + (size_t)(k0) * 64; LAS char* kd_ = lds + (slot) * (2 * F8_SLOT); \
    _Pragma("unroll") for (int t_ = 0; t_ < 3; ++t_) { const unsigned char* s_ = (krope[t_] ? rb_ : kb_) + koff[t_]; __builtin_amdgcn_global_load_lds((const unsigned*)s_, (LAS unsigned*)(kd_ + kdst[t_]), 16, 0, 0); } \
    _Pragma("unroll") for (int t_ = 0; t_ < 2; ++t_) __builtin_amdgcn_global_load_lds((const unsigned*)(Vtb + (k0) + t_ * 64 + voff), (LAS unsigned*)(kd_ + t_ * F8_SLOT + F8_SK + wid * 1024), 16, 0, 0); } while (0)
    const int krow = 16 * ((r32 >> 2) & 1) + 4 * (r32 >> 3) + (r32 & 3), kx = (krow >> 2) & 3;
    const int ka0 = krow * 192 + 16 * ((2 * hi) ^ kx), ka1 = krow * 192 + 16 * ((2 * hi + 1) ^ kx);
    const int vx = (r32 >> 2) & 3, va0 = F8_SK + r32 * 64 + 16 * (hi ^ vx), va1 = F8_SK + r32 * 64 + 16 * ((2 + hi) ^ vx);
#define QKT8(P0, P1, Ks) do { _Pragma("unroll") for (int st = 0; st < 3; ++st) { \
        const v8i32 k0_ = ld32((Ks) + ka0 + st * 64, (Ks) + ka1 + st * 64), k1_ = ld32((Ks) + ka0 + st * 64 + 32 * 192, (Ks) + ka1 + st * 64 + 32 * 192); \
        P0 = __builtin_amdgcn_mfma_scale_f32_32x32x64_f8f6f4(k0_, qr[st], st == 0 ? minit : P0, 0, 0, 0, 0, 0, 0); P1 = __builtin_amdgcn_mfma_scale_f32_32x32x64_f8f6f4(k1_, qr[st], st == 0 ? minit : P1, 0, 0, 0, 0, 0, 0); } } while (0)
#define PV8_LOAD(Vs) do { vfr[0] = ld32((Vs) + va0, (Vs) + va1); } while (0)
#define PV8_MMA(Vs) do { const v8i32 v1_ = ld32((Vs) + va0 + 1 * 2048, (Vs) + va1 + 1 * 2048), v2_ = ld32((Vs) + va0 + 2 * 2048, (Vs) + va1 + 2 * 2048), v3_ = ld32((Vs) + va0 + 3 * 2048, (Vs) + va1 + 3 * 2048); \
        o[0] = __builtin_amdgcn_mfma_scale_f32_32x32x64_f8f6f4(pa, vfr[0], o[0], 0, 0, 0, 0, 0, 0); o[1] = __builtin_amdgcn_mfma_scale_f32_32x32x64_f8f6f4(pa, v1_, o[1], 0, 0, 0, 0, 0, 0); \
        o[2] = __builtin_amdgcn_mfma_scale_f32_32x32x64_f8f6f4(pa, v2_, o[2], 0, 0, 0, 0, 0, 0); o[3] = __builtin_amdgcn_mfma_scale_f32_32x32x64_f8f6f4(pa, v3_, o[3], 0, 0, 0, 0, 0, 0); \
        osum = __builtin_amdgcn_mfma_scale_f32_32x32x64_f8f6f4(pa, ld32(onep, onep), osum, 0, 0, 0, 0, 0, 0); } while (0)
#define PSM8(P0, P1, PM) do { float pm_ = P0[0]; _Pragma("unroll") for (int r = 1; r < 16; ++r) pm_ = fmaxf(pm_, P0[r]); _Pragma("unroll") for (int r = 0; r < 16; ++r) pm_ = fmaxf(pm_, P1[r]); \
        { auto rr_ = __builtin_amdgcn_permlane32_swap(__float_as_uint(pm_), __float_as_uint(pm_), false, false); PM = fmaxf(__uint_as_float(rr_[0]), __uint_as_float(rr_[1])); } \
        _Pragma("unroll") for (int r = 0; r < 16; ++r) P0[r] = __builtin_amdgcn_exp2f(P0[r]); } while (0)
#define PSM8_FIRST(P0, P1) do { float pm_ = P0[0]; _Pragma("unroll") for (int r = 1; r < 16; ++r) pm_ = fmaxf(pm_, P0[r]); _Pragma("unroll") for (int r = 0; r < 16; ++r) pm_ = fmaxf(pm_, P1[r]); \
        { auto rr_ = __builtin_amdgcn_permlane32_swap(__float_as_uint(pm_), __float_as_uint(pm_), false, false); pm_ = fmaxf(__uint_as_float(rr_[0]), __uint_as_float(rr_[1])); } \
        const float dl_ = pm_ - 7.0f; _Pragma("unroll") for (int r = 0; r < 16; ++r) { P0[r] = __builtin_amdgcn_exp2f(P0[r] - dl_); P1[r] -= dl_; minit[r] = -dl_; } } while (0)
#define FSM8(P0, P1) do { _Pragma("unroll") for (int r = 0; r < 16; ++r) P1[r] = __builtin_amdgcn_exp2f(P1[r]); \
        pa = (v8i32){(int)pk_fp8x4(P0[0], P0[1], P0[2], P0[3]), (int)pk_fp8x4(P0[4], P0[5], P0[6], P0[7]), (int)pk_fp8x4(P0[8], P0[9], P0[10], P0[11]), (int)pk_fp8x4(P0[12], P0[13], P0[14], P0[15]), \
                     (int)pk_fp8x4(P1[0], P1[1], P1[2], P1[3]), (int)pk_fp8x4(P1[4], P1[5], P1[6], P1[7]), (int)pk_fp8x4(P1[8], P1[9], P1[10], P1[11]), (int)pk_fp8x4(P1[12], P1[13], P1[14], P1[15])}; } while (0)
#define RESC(P0, P1, PM) do { if (__any((PM) > 7.0f + TAU)) { const float dl_ = (PM) > 7.0f + TAU ? (PM) - 7.0f : 0.f, a_ = __builtin_amdgcn_exp2f(-dl_); \
    if (hi == 0) al_l[r32] = a_; \
    _Pragma("unroll") for (int r = 0; r < 16; ++r) { P0[r] *= a_; P1[r] -= dl_; minit[r] -= dl_; } \
    asm volatile("s_waitcnt lgkmcnt(0)" ::: "memory"); \
    _Pragma("unroll") for (int r = 0; r < 16; ++r) { const float f_ = al_l[crow(r, hi)]; osum[r] *= f_; _Pragma("unroll") for (int d = 0; d < 4; ++d) o[d][r] *= f_; } } } while (0)
#define SGB_QK() do { _Pragma("unroll") for (int i_ = 0; i_ < 6; ++i_) { __builtin_amdgcn_sched_group_barrier(0x100, 2, 0); __builtin_amdgcn_sched_group_barrier(0x008, 1, 0); __builtin_amdgcn_sched_group_barrier(0x402, 12, 0); } } while (0)
#define SGB_PV() do { _Pragma("unroll") for (int i_ = 0; i_ < 4; ++i_) { __builtin_amdgcn_sched_group_barrier(0x100, 2, 0); __builtin_amdgcn_sched_group_barrier(0x008, 1, 0); __builtin_amdgcn_sched_group_barrier(0x402, 26, 0); } } while (0)
    f32x16 pA0, pA1, pB0, pB1; float pmA, pmB; v8i32 pa, vfr[1]; constexpr int NT = SEQ / KVBLK;
    int s0 = 0, s1 = 1, s2 = 2;
    GLDS8(0, 0); GLDS8(2 * KVBLK, 1);
    WAITBAR(5);
    QKT8(pA0, pA1, lds); PSM8_FIRST(pA0, pA1);
    WAITBAR(2);
#pragma unroll 1
    for (int j = 0; j < NT; j += 2) {
        const bool more = j + 4 < NT;
        if (more) GLDS8((j + 4) * KVBLK, s2);
        LAS char* const t0 = lds + s0 * (2 * F8_SLOT); LAS char* const t1 = t0 + F8_SLOT; LAS char* const t2 = lds + s1 * (2 * F8_SLOT);
        SBAR(); PV8_LOAD(t0); QKT8(pB0, pB1, t1);
        FSM8(pA0, pA1); SBAR();
        PV8_MMA(t0); PSM8(pB0, pB1, pmB); SBAR();
        RESC(pB0, pB1, pmB);
        SBAR(); PV8_LOAD(t1); QKT8(pA0, pA1, t2);
        FSM8(pB0, pB1); SBAR();
        PV8_MMA(t1); PSM8(pA0, pA1, pmA); SBAR();
        if (more) WAITBAR(2); else WAITBAR(0);
        if (j + 2 < NT) RESC(pA0, pA1, pmA);
        { const int t_ = s0; s0 = s1; s1 = s2; s2 = t_; }
    }
    unsigned char* Ow = O + (tokb + qb * 256 + wid * 32) * 1024 + h * 128;
    const unsigned oo = (unsigned)(4 * hi * 1024 + r32);
#pragma unroll
    for (int r = 0; r < 16; ++r) { const float rl = __builtin_amdgcn_rcpf(osum[r] * ATT8_SCALE) * O8_SCALE;
        const unsigned w = pk_fp8x4(o[0][r] * rl, o[1][r] * rl, o[2][r] * rl, o[3][r] * rl);
#pragma unroll
        for (int d0 = 0; d0 < 4; ++d0) Ow[oo + (unsigned)(((r & 3) + 8 * (r >> 2)) * 1024 + d0 * 32)] = (unsigned char)(w >> (8 * d0)); }
    WAITBAR(0);
#undef GLDS8
#undef QKT8
#undef PV8_LOAD
#undef PV8_MMA
#undef PSM8
#undef PSM8_FIRST
#undef FSM8
#undef RESC
}
}

namespace watt {
constexpr float C2 = 1.4426950408889634f;
constexpr int WLDS = 16384 + 256;
__device__ __forceinline__ void unit(const bf16* QKV, bf16* OG, float* LSE, int g, int b, int r, int h, int qb, LAS char* wl, int lane) {
    const int r32 = lane & 31, hi = lane >> 5, sh = 2 * g, L = SEQ >> sh, l0 = qb * 64;
    LAS float* scr = (LAS float*)(wl + 16384);
    const size_t tokb = (size_t)b * SEQ + r;
    const char* base = (const char*)QKV + (size_t)(((g * 3) * 8 + h) * 64) * 2;
    bf16x8 qf[2][4];
#pragma unroll
    for (int qs = 0; qs < 2; ++qs) { const char* p = base + (tokb + ((size_t)(l0 + 32 * qs + r32) << sh)) * 9216 + hi * 16;
#pragma unroll
        for (int d0 = 0; d0 < 4; ++d0) qf[qs][d0] = *reinterpret_cast<const bf16x8*>(p + d0 * 32); }
    f32x16 o[2][2] = {}; float m[2] = {-1e30f, -1e30f}, l[2] = {0.f, 0.f};
    const int vb = (int)(uintptr_t)wl + mla::v_rd_base(lane);
#pragma unroll
    for (int tt = 0; tt < 3; ++tt) {
        const int t = tt == 0 ? 1 : (tt == 1 ? 0 : 2);
        const int lk0 = l0 - 64 + 64 * t;
        bf16x8 kf[2][4];
#pragma unroll
        for (int half = 0; half < 2; ++half) { int lk = lk0 + 32 * half + r32; lk = lk < 0 ? 0 : (lk >= L ? L - 1 : lk);
            const char* p = base + 1024 + (tokb + ((size_t)lk << sh)) * 9216 + hi * 16;
#pragma unroll
            for (int d0 = 0; d0 < 4; ++d0) kf[half][d0] = *reinterpret_cast<const bf16x8*>(p + d0 * 32); }
        bf16x8 vs[8];
#pragma unroll
        for (int i = 0; i < 8; ++i) { int lk = lk0 + i * 8 + (lane >> 3); lk = lk < 0 ? 0 : (lk >= L ? L - 1 : lk);
            vs[i] = *reinterpret_cast<const bf16x8*>(base + 2048 + (tokb + ((size_t)lk << sh)) * 9216 + (lane & 7) * 16); }
#pragma unroll
        for (int i = 0; i < 8; ++i) *(LAS bf16x8*)(wl + mla::v_st(i * 8 + (lane >> 3), (lane & 7) * 8)) = vs[i];
#pragma unroll
        for (int qs = 0; qs < 2; ++qs) {
            f32x16 p0 = {}, p1 = {};
#pragma unroll
            for (int d0 = 0; d0 < 4; ++d0) { p0 = __builtin_amdgcn_mfma_f32_32x32x16_bf16(kf[0][d0], qf[qs][d0], p0, 0, 0, 0); p1 = __builtin_amdgcn_mfma_f32_32x32x16_bf16(kf[1][d0], qf[qs][d0], p1, 0, 0, 0); }
            const int lq = l0 + 32 * qs + r32; float pmax = -INFINITY;
#pragma unroll
            for (int rr = 0; rr < 16; ++rr) { const int k0 = lk0 + mla::crow(rr, hi), k1 = k0 + 32;
                const bool v0 = (k0 >= 0) && (k0 < L) && (k0 - lq <= 64) && (lq - k0 <= 64), v1 = (k1 >= 0) && (k1 < L) && (k1 - lq <= 64) && (lq - k1 <= 64);
                p0[rr] = v0 ? p0[rr] : -INFINITY; p1[rr] = v1 ? p1[rr] : -INFINITY; pmax = fmaxf(pmax, fmaxf(p0[rr], p1[rr])); }
            { auto sw = __builtin_amdgcn_permlane32_swap(__float_as_uint(pmax), __float_as_uint(pmax), false, false); pmax = fmaxf(__uint_as_float(sw[0]), __uint_as_float(sw[1])); }
            const float mn = fmaxf(m[qs], pmax), alpha = __builtin_amdgcn_exp2f((m[qs] - mn) * C2), mnC = -mn * C2; m[qs] = mn;
            float ps = 0.f;
#pragma unroll
            for (int rr = 0; rr < 16; ++rr) { p0[rr] = __builtin_amdgcn_exp2f(fmaf(p0[rr], C2, mnC)); p1[rr] = __builtin_amdgcn_exp2f(fmaf(p1[rr], C2, mnC)); ps += p0[rr] + p1[rr]; }
            { auto sw = __builtin_amdgcn_permlane32_swap(__float_as_uint(ps), __float_as_uint(ps), false, false); ps = __uint_as_float(sw[0]) + __uint_as_float(sw[1]); }
            l[qs] = l[qs] * alpha + ps;
            bf16x8 pa0, pa1, pa2, pa3;
#define PK4(P, BASE, OUT) do { unsigned a0 = cvt_pk_bf16(P[BASE + 0], P[BASE + 1]), a1 = cvt_pk_bf16(P[BASE + 2], P[BASE + 3]);   \
    unsigned b0 = cvt_pk_bf16(P[BASE + 4], P[BASE + 5]), b1 = cvt_pk_bf16(P[BASE + 6], P[BASE + 7]);                              \
    auto r0 = __builtin_amdgcn_permlane32_swap(a0, b0, false, false); auto r1 = __builtin_amdgcn_permlane32_swap(a1, b1, false, false); \
    u32x4 w = {r0[0], r1[0], r0[1], r1[1]}; OUT = *reinterpret_cast<bf16x8*>(&w); } while (0)
            PK4(p0, 0, pa0); PK4(p0, 8, pa1); PK4(p1, 0, pa2); PK4(p1, 8, pa3);
#undef PK4
            if (tt > 0) { if (__any(alpha < 1.f)) { if (hi == 0) scr[r32] = alpha; asm volatile("s_waitcnt lgkmcnt(0)" ::: "memory");
#pragma unroll
                for (int d = 0; d < 2; ++d)
#pragma unroll
                    for (int rr = 0; rr < 16; ++rr) o[qs][d][rr] *= scr[mla::crow(rr, hi)]; } }
            mla::pv_one<0>(o[qs][0], vb, pa0, pa1, pa2, pa3); mla::pv_one<1>(o[qs][1], vb, pa0, pa1, pa2, pa3);
        }
    }
#pragma unroll
    for (int qs = 0; qs < 2; ++qs) {
        if (hi == 0) { scr[r32] = l[qs]; LSE[((size_t)g * NTOK + tokb + ((size_t)(l0 + 32 * qs + r32) << sh)) * 8 + h] = m[qs] + __logf(l[qs]); }
        asm volatile("s_waitcnt lgkmcnt(0)" ::: "memory");
#pragma unroll
        for (int rr = 0; rr < 16; ++rr) { const int qi = mla::crow(rr, hi); const float rl = __builtin_amdgcn_rcpf(scr[qi]);
            bf16* op = OG + ((size_t)g * NTOK + tokb + ((size_t)(l0 + 32 * qs + qi) << sh)) * 512 + h * 64 + r32;
#pragma unroll
            for (int d = 0; d < 2; ++d) { const unsigned w = cvt_pk_bf16(o[qs][d][rr] * rl, 0.f); op[d * 32] = (bf16)(w & 0xffffu); } }
        asm volatile("s_waitcnt lgkmcnt(0)" ::: "memory");
    }
}
}
__device__ __forceinline__ void watt_phase(const Ctx& C) {
    const bf16* QKV = (const bf16*)(C.ws + AR_QKV); bf16* OG = (bf16*)(C.ws + AR_OG); float* LSE = (float*)(C.ws + AR_LSE);
    LAS char* wl = (LAS char*)C.lds + C.wave * watt::WLDS;
    for (int u = C.bx * NWAVES + C.wave; u < 12288; u += C.G * NWAVES) {
        const int g = u >> 12, v = u & 4095, sh = 2 * g, nqb = 128 >> sh, qb = v & (nqb - 1), w2 = v >> (7 - sh), h = w2 & 7, w3 = w2 >> 3, r = w3 & ((1 << sh) - 1), b = w3 >> sh;
        watt::unit(QKV, OG, LSE, g, b, r, h, qb, wl, C.lane);
    }
}
__device__ __forceinline__ void watt_combine(const Ctx& C) {
    const bf16* OG = (const bf16*)(C.ws + AR_OG); const float* LSE = (const float*)(C.ws + AR_LSE); unsigned char* O = C.ws + AR_OD;
    for (int it0 = C.bx * NTHR + C.tid; it0 < NTOK * 64; it0 += 4 * C.G * NTHR) {
      float lq[4][3]; u32x4 oq[4][3];
#pragma unroll
      for (int q = 0; q < 4; ++q) { const int it = it0 + q * C.G * NTHR, tok = it >> 6, c = it & 63, h = c >> 3;
#pragma unroll
          for (int g = 0; g < 3; ++g) { lq[q][g] = LSE[((size_t)g * NTOK + tok) * 8 + h]; oq[q][g] = *(const u32x4*)(OG + ((size_t)g * NTOK + tok) * 512 + c * 8); } }
#pragma unroll
      for (int q = 0; q < 4; ++q) {
        const int it = it0 + q * C.G * NTHR, tok = it >> 6, c = it & 63;
        const float l0 = lq[q][0], l1 = lq[q][1], l2 = lq[q][2];
        const float mx = fmaxf(l0, fmaxf(l1, l2)); float w0 = __expf(l0 - mx), w1 = __expf(l1 - mx), w2 = __expf(l2 - mx); const float inv = 1.0f / (w0 + w1 + w2); w0 *= inv; w1 *= inv; w2 *= inv;
        const u32x4 a = oq[q][0], bq = oq[q][1], cq = oq[q][2];
        w0 *= OD8_SCALE; w1 *= OD8_SCALE; w2 *= OD8_SCALE;
        float e[8];
#pragma unroll
        for (int j = 0; j < 4; ++j) { e[2 * j] = w0 * bflo(a[j]) + w1 * bflo(bq[j]) + w2 * bflo(cq[j]); e[2 * j + 1] = w0 * bfhi(a[j]) + w1 * bfhi(bq[j]) + w2 * bfhi(cq[j]); }
        *(u32x2*)(O + (size_t)tok * 512 + c * 8) = (u32x2){pk_fp8x4(e[0], e[1], e[2], e[3]), pk_fp8x4(e[4], e[5], e[6], e[7])};
      }
    }
}

constexpr int N_PHASES = 64;
constexpr int PP_SPLIT = 100;
__global__ void __launch_bounds__(NTHR, 2) fwd_kernel(Args args) {
    extern __shared__ __attribute__((aligned(16))) unsigned char lds_raw[];
    volatile LAS unsigned* MISC = (volatile LAS unsigned*)((LAS unsigned char*)lds_raw + LDS_MISC);
    if (threadIdx.x < 64) MISC[threadIdx.x] = 0u;
    if (threadIdx.x == 0) {
#pragma unroll
        for (int i = 0; i < 30; ++i) *(LAS unsigned long long*)((LAS unsigned char*)lds_raw + LDS_PTRS + 8 * i) = (unsigned long long)args.in[i];
    }
    __syncthreads();
    XcdBarrier bar = xcd_barrier_post((unsigned*)(args.ws + WS_CTL) + CW_BAR, MISC + 8);
    const int lo = args.ph_lo, hi = args.ph_hi; int ph = 0;
    const int wave_s = __builtin_amdgcn_readfirstlane(threadIdx.x >> 6);
#define FRESH_CTX Ctx C; { unsigned on_ = ~0u; asm volatile("" : "+s"(on_)); int t_ = wave_s * 64 + (int)__builtin_amdgcn_mbcnt_hi(on_, __builtin_amdgcn_mbcnt_lo(on_, 0u)), bx_ = blockIdx.x, g_ = gridDim.x; unsigned char* ws_ = args.ws; float* out_ = args.out; \
        asm volatile("" : "+v"(t_)); asm volatile("" : "+s"(bx_), "+s"(g_), "+s"(ws_), "+s"(out_)); \
        C.lds = (LAS unsigned char*)lds_raw; C.ws = (unsigned char*)(GAS unsigned char*)(unsigned long long)ws_; C.in.lds = C.lds; C.out = (float*)(GAS float*)(unsigned long long)out_;       C.tid = t_; C.lane = t_ & 63; C.wave = __builtin_amdgcn_readfirstlane(t_ >> 6); C.G = g_; C.bx = bx_; } \
        unsigned char* ws = C.ws; LAS unsigned char* lds = C.lds; const float* SSQ = (const float*)(ws + WS_SSQ); bf16* H = (bf16*)(ws + WS_HB); const bf16* HB = (const bf16*)(ws + WS_HB); \
        const float* ct = (const float*)(ws + WS_COS); const float* st = (const float*)(ws + WS_SIN); (void)SSQ; (void)H; (void)HB; (void)ct; (void)st; (void)lds;
#ifndef PROBE_MASK
#define PROBE_MASK 0ull
#endif
#ifndef PROBE_DRY
#define PROBE_DRY 0ull
#endif
#define PHASE_BEGIN if (lo <= ph && ph < hi) { const int nrep_ = (((PROBE_MASK | PROBE_DRY) >> ph) & 1ull) ? 2 : 1; for (int rep_ = 0; rep_ < nrep_; ++rep_) { const float DRYS = (((PROBE_DRY >> ph) & 1ull) && rep_ == 0) ? 0.0f : 1.0f; (void)DRYS; FRESH_CTX
#define PHASE_END   } if (ph + 1 < hi) { unsigned on_ = ~0u; asm volatile("" : "+s"(on_)); xcd_barrier(bar, wave_s * 64 + (int)__builtin_amdgcn_mbcnt_hi(on_, __builtin_amdgcn_mbcnt_lo(on_, 0u))); } } ++ph;
#define DENSE(name, Aptr, Btptr, Kv, ldav, ldbv, nMv, nNv, nbv, abs_, bbs_) pg8::DenseSched name{Aptr, Btptr, Kv, ldav, ldbv, pg8::TileOrder{nMv, nNv, nbv, C.G, C.bx}, abs_, bbs_}

    PHASE_BEGIN prologue(C); PHASE_END

    PHASE_BEGIN
        DENSE(S, HB, (const bf16*)(ws + WA_T), 1024, 1024, 1024, NTOK / 256, 3, 1, 0, 0);
        EpiMlaA E{SSQ, (bf16*)(ws + AR_CQ), (bf16*)(ws + AR_CKV), (bf16*)(ws + AR_KR), (float*)(ws + AR_SSQQ), (float*)(ws + AR_SSQKV), ct, st};
        pg8::gemm_phase<EpiMlaA, pg8::DenseSched, true>(lds, C.tid, S, E);
        if (C.G == 256 && C.bx >= 128) { __syncthreads(); moe_weight_prep(C, 0, 8192, 1 << 30, (C.bx - 128) * NWAVES + C.wave, 128 * NWAVES); __syncthreads(); }
    PHASE_END
    PHASE_BEGIN
        { DENSE(S, (const bf16*)(ws + AR_CQ), (const bf16*)(ws + WUQ_T), 384, 384, 384, NTOK / 256, 6, 1, 0, 0);
          EpiMlaQ E{(const float*)(ws + AR_SSQQ), (bf16*)(ws + AR_Q), ct, st};
          pg8::gemm_phase<EpiMlaQ, pg8::DenseSched, true>(lds, C.tid, S, E); }
        { FRESH_CTX MlaKnSched S{(const bf16*)(ws + AR_CKV), (const bf16*)(ws + WUKV_T), 256, 256, C.G, C.bx};
          EpiMlaKN E{(const float*)(ws + AR_SSQKV), ws + AR_KN};
          pg8::gemm_phase<EpiMlaKN, MlaKnSched, true>(lds, C.tid, S, E); }
        { FRESH_CTX MlaVtSched S{(const bf16*)(ws + WUKV_T), (const bf16*)(ws + AR_CKV), 256, 256, C.G, C.bx};
          EpiMlaVT E{(const float*)(ws + AR_SSQKV), ws + AR_VT};
          pg8::gemm_phase<EpiMlaVT, MlaVtSched, true>(lds, C.tid, S, E); }
    PHASE_END
    PHASE_BEGIN
        for (int i = 0; ; ++i) { const int bh = i * 8 + (C.bx & 7), qb = C.bx >> 3; if (bh >= 32 || C.G != 256) break;
            mla::attn_unit_f8(C.tid, ws + AR_Q, ws + AR_KN, ws + AR_KR, ws + AR_VT, ws + AR_O, bh >> 3, bh & 7, qb, (LAS char*)lds); }
    PHASE_END
    PHASE_BEGIN
        pg8::DenseSched8 S{ws + AR_O, ws + WOM_T, 1024, 1024, 1024, pg8::TileOrder{NTOK / 256, 4, 1, C.G, C.bx}};
        EpiResidual E{H, nullptr, DRYS / (O8_SCALE * W8_SCALE)};
        pg8::gemm_phase<EpiResidual, pg8::DenseSched8, true, true>(lds, C.tid, S, E);
    PHASE_END

#pragma unroll 1
    for (int layer = 0; layer < DEPTH; ++layer) {
        if (layer == 1) {
            PHASE_BEGIN
                FnetTSched S{(const bf16*)(ws + FCH_T), HB, 256, 1024, C.G, C.bx};
                EpiFnetT E{SSQ, (bf16*)(ws + AR_TT)};
                pg8::gemm_phase<EpiFnetT, FnetTSched, true>(lds, C.tid, S, E);
            PHASE_END
            PHASE_BEGIN
                FnetConstASched S{(const bf16*)(ws + FW1_T), (const bf16*)(ws + AR_TT), 256, 256, 1024, C.G, C.bx};
                EpiFnet1 E{(bf16*)(ws + AR_Z), (const float*)(ws + FTWC), (const float*)(ws + FTWS)};
                pg8::gemm_phase<EpiFnet1, FnetConstASched, true>(lds, C.tid, S, E);
            PHASE_END
            PHASE_BEGIN
                FnetConstASched S{(const bf16*)(ws + FW2_T), (const bf16*)(ws + AR_Z), 128, 128, 2048, C.G, C.bx};
                EpiFnet2 E{ws + AR_F, 6.905339660024878e-4f * FN8_SCALE};
                pg8::gemm_phase<EpiFnet2, FnetConstASched, true>(lds, C.tid, S, E);
            PHASE_END
            PHASE_BEGIN
                pg8::DenseSched8 S{ws + AR_F, ws + WOF_T, 1024, 1024, 1024, pg8::TileOrder{NTOK / 256, 4, 1, C.G, C.bx}};
                EpiResidual E{H, C.in[I_FN_BO], DRYS / (FN8_SCALE * W8_SCALE), DRYS};
                pg8::gemm_phase<EpiResidual, pg8::DenseSched8, true, true>(lds, C.tid, S, E);
            PHASE_END
        } else if (layer == 2) {
            PHASE_BEGIN
                pg8::DenseSched8 S{ws + WS_H8, ws + WIN_T, 1024, 1024, 1024, pg8::TileOrder{NTOK / 256, 16, 1, C.G, C.bx}};
                EpiGmlpIn E{SSQ, (bf16*)(ws + AR_U), (bf16*)(ws + AR_V), (float*)(ws + AR_SSQV), 1.0f / (XN8_SCALE * W8_SCALE)};
                pg8::gemm_phase<EpiGmlpIn, pg8::DenseSched8, true, true>(lds, C.tid, S, E);
            PHASE_END
            PHASE_BEGIN spatial_phase(C); PHASE_END
            PHASE_BEGIN
                pg8::DenseSched8 S{ws + AR_G, ws + WOG_T, 2048, 2048, 2048, pg8::TileOrder{NTOK / 256, 4, 1, C.G, C.bx}};
                EpiResidual E{H, nullptr, DRYS / (G8_SCALE * W8_SCALE)};
                pg8::gemm_phase<EpiResidual, pg8::DenseSched8, true, true>(lds, C.tid, S, E);
            PHASE_END
        } else if (layer == 3) {
            PHASE_BEGIN
                pg8::DenseSched8 S{ws + WS_H8, ws + WQKV_T, 1024, 1024, 1024, pg8::TileOrder{NTOK / 256, 18, 1, C.G, C.bx}};
                EpiDilQkv E{SSQ, (bf16*)(ws + AR_QKV), ct, st, 1.0f / (XN8_SCALE * W8_SCALE)};
                pg8::gemm_phase<EpiDilQkv, pg8::DenseSched8, true, true>(lds, C.tid, S, E);
            PHASE_END
            PHASE_BEGIN watt_phase(C); PHASE_END
            PHASE_BEGIN watt_combine(C); PHASE_END
            PHASE_BEGIN
                pg8::DenseSched8 S{ws + AR_OD, ws + WOD_T, 512, 512, 512, pg8::TileOrder{NTOK / 256, 4, 1, C.G, C.bx}};
                EpiResidual E{H, nullptr, DRYS / (OD8_SCALE * W8_SCALE)};
                pg8::gemm_phase<EpiResidual, pg8::DenseSched8, true, true>(lds, C.tid, S, E);
            PHASE_END
        }
        PHASE_BEGIN
            if (layer > 0) { moe_weight_prep(C, layer); __syncthreads(); }
            router_phase(C, layer);
        PHASE_END
        PHASE_BEGIN
            moe_tables(C, layer);
            const LAS int* T = (const LAS int*)(lds + LDS_TAB);
            MoeSched1 S{ws + WS_XN, ws + WS_MOEW1, (const u32x2*)(ws + WS_LIST), T, 1024, 1024, C.G, C.bx};
            EpiMoe1 E{ws + AR_HBUF, T};
            pg8::gemm_phase<EpiMoe1, MoeSched1, true, true>(lds, C.tid, S, E);
#define PP_TAIL(RT0, NRT) { FRESH_CTX const int U1 = __builtin_amdgcn_readfirstlane(((const LAS int*)(lds + LDS_TAB))[64]) * 4, rem = U1 % C.G; int nl = C.G - rem, li = C.bx - rem; if (2 * nl < C.G) { nl = C.G; li = C.bx; } \
              if (li >= 0) { pg8::DenseSched S2{(const bf16*)(ws + WS_PB) + ((size_t)layer * NTOK + (size_t)(RT0) * 256) * 256, (const bf16*)(ws + WP_T) + (size_t)layer * 1024 * 256, 256, 256, 256, pg8::TileOrder{(NRT), 4, 1, nl, li}, 0, 0}; \
                EpiStoreBf16 E2{(bf16*)(ws + WS_PP) + (size_t)(RT0) * 256 * 1024, 1024, 1.0f, 0}; \
                pg8::gemm_phase<EpiStoreBf16, pg8::DenseSched, true>(lds, C.tid, S2, E2); } }
            PP_TAIL(0, PP_SPLIT)
        PHASE_END
        PHASE_BEGIN
            const LAS int* T = (const LAS int*)(lds + LDS_TAB);
            MoeSched2 S{ws + AR_HBUF, ws + WS_MOEW2, T, 512, 512, C.G, C.bx};
            EpiMoe2 E{(bf16*)(ws + AR_YB), (const u32x2*)(ws + WS_LIST), T};
            pg8::gemm_phase<EpiMoe2, MoeSched2, true, true>(lds, C.tid, S, E);
            PP_TAIL(PP_SPLIT, NTOK / 256 - PP_SPLIT)
        PHASE_END
        PHASE_BEGIN combine_phase(C, C.in[I_PLE_NORM] + layer * 1024, DRYS); PHASE_END
        PHASE_BEGIN
            pg8::DenseSched8 S{ws + WS_XN, ws + WG_T + (size_t)layer * 1024 * 1024, 1024, 1024, 1024, pg8::TileOrder{NTOK / 256, 4, 1, C.G, C.bx}};
            EpiPle E{H, (const bf16*)(ws + WS_PP), (float*)(ws + WS_SSQ), DRYS, (layer == 1 || layer == 2) ? ws + WS_H8 : nullptr, -1.4426950408889634f / (XN8_SCALE * W8_SCALE)};
            pg8::gemm_phase<EpiPle, pg8::DenseSched8, true, true>(lds, C.tid, S, E);
        PHASE_END
    }
    PHASE_BEGIN final_phase(C); PHASE_END
}

#ifndef MK_SPLIT
#define MK_SPLIT 0
#endif
extern "C" void kernel_launch(void* const* d_in, const int* in_sizes, int n_in, void* d_out, int out_size, void* d_ws, size_t ws_size, hipStream_t stream) {
    static int grid = 0;
    if (grid == 0) {
        if (n_in != 30 || in_sizes[0] != NTOK * DM || out_size != NTOK * DM || ws_size < WS_END) { fprintf(stderr, "kernel_launch: shape/workspace mismatch (n_in %d, ws %zu, need %zu)\n", n_in, ws_size, (size_t)WS_END); grid = -1; return; }
        int dev = 0, cus = 0;
        if (hipGetDevice(&dev) != hipSuccess || hipDeviceGetAttribute(&cus, hipDeviceAttributeMultiprocessorCount, dev) != hipSuccess) { grid = -1; return; }
        if (hipFuncSetAttribute((const void*)fwd_kernel, hipFuncAttributeMaxDynamicSharedMemorySize, LDS_BYTES) != hipSuccess) { grid = -1; return; }
        int per_cu = 0;
        if (hipOccupancyMaxActiveBlocksPerMultiprocessor(&per_cu, (const void*)fwd_kernel, NTHR, LDS_BYTES) != hipSuccess || per_cu < 1) fprintf(stderr, "kernel_launch: occupancy query reports %d\n", per_cu);
        (void)hipGetLastError();
        grid = cus;
    }
    if (grid < 0) return;
    hipMemsetAsync((char*)d_ws + WS_CTL, 0, CTL_ZERO_BYTES, stream);
    Args a{};
    for (int i = 0; i < 30; ++i) a.in[i] = (const float*)d_in[i];
    a.out = (float*)d_out; a.ws = (unsigned char*)d_ws;
#if MK_SPLIT
    for (int p = 0; p < N_PHASES; ++p) { a.ph_lo = p; a.ph_hi = p + 1; hipLaunchKernelGGL(fwd_kernel, dim3(grid), dim3(NTHR), LDS_BYTES, stream, a); }
#else
    a.ph_lo = 0; a.ph_hi = N_PHASES;
    hipLaunchKernelGGL(fwd_kernel, dim3(grid), dim3(NTHR), LDS_BYTES, stream, a);
#endif
}
```
